# Optimizing an MI355X kernel written in HIP

```python
import math
import jax, jax.numpy as jnp
from jax import lax
import numpy as np

D_MODEL = 4096
BATCH = 4
SEQ = 2048
DEPTH = 1
DEC_BATCH = 128
DEC_SEQ = 1
PAST_LEN = 8192
PAGE_SIZE = 128

N_HEADS = 32
N_KV_HEADS = 8
HEAD_DIM = 64
GROUP = N_HEADS // N_KV_HEADS
ATTN_W = N_HEADS * HEAD_DIM
KV_W = N_KV_HEADS * HEAD_DIM
CONV_W = D_MODEL // 2
CONV_GROUPS = 16
CONV_K = 3
WINDOW = 128
Q_BLOCK = 128
N_BUCKETS = 32
MAX_DISTANCE = 128
D_FF = 11008
FFN_CONV_K = 3
EPS = 1e-5
NEG = -1e30
IN_W = 3 * CONV_W + ATTN_W + 2 * KV_W + 2 * D_MODEL

kernel_name = "hybrid_gated_conv_swa_convffn_step"


def rmsnorm(x, g):
    xf = x.astype(jnp.float32)
    r = lax.rsqrt(jnp.mean(xf * xf, axis=-1, keepdims=True) + EPS)
    return (xf * r).astype(x.dtype) * g


def t5_bucket(dist):
    max_exact = N_BUCKETS // 2
    d = jnp.maximum(dist, 0)
    df = jnp.maximum(d, 1).astype(jnp.float32)
    large = max_exact + (jnp.log(df / max_exact) / math.log(MAX_DISTANCE / max_exact)
                         * (N_BUCKETS - max_exact)).astype(jnp.int32)
    large = jnp.minimum(large, N_BUCKETS - 1)
    return jnp.where(d < max_exact, d, large)


def rel_bias_heads(rel_bias, dist):
    b = rel_bias[t5_bucket(dist)].astype(jnp.float32)
    b = jnp.transpose(b, (2, 0, 1))
    return b.reshape(N_KV_HEADS, GROUP, dist.shape[0], dist.shape[1])


def sink_softmax(s, sinks):
    sk = sinks.astype(jnp.float32).reshape(N_KV_HEADS, GROUP)[:, :, None, None]
    m = jnp.maximum(jnp.max(s, axis=-1, keepdims=True), sk)
    e = jnp.exp(s - m)
    denom = jnp.sum(e, axis=-1, keepdims=True) + jnp.exp(sk - m)
    return e / denom


def causal_dwconv(buf, u, w):
    k_w = w.shape[0]
    t = u.shape[1]
    ext = jnp.concatenate([buf, u], axis=1)
    y = w[0] * ext[:, 0:t]
    for j in range(1, k_w):
        y = y + w[j] * ext[:, j:j + t]
    return y, ext[:, ext.shape[1] - (k_w - 1):]


def swa_prompt(q, k, v, sinks, rel_bias):
    b, s_len = q.shape[0], q.shape[1]
    nb = s_len // Q_BLOCK
    qb = q.reshape(b, nb, Q_BLOCK, N_KV_HEADS, GROUP, HEAD_DIM)
    kb = k.reshape(b, nb, Q_BLOCK, N_KV_HEADS, HEAD_DIM)
    vb = v.reshape(b, nb, Q_BLOCK, N_KV_HEADS, HEAD_DIM)
    pad = ((0, 0), (1, 0), (0, 0), (0, 0), (0, 0))
    kband = jnp.concatenate([jnp.pad(kb, pad)[:, :-1], kb], axis=2)
    vband = jnp.concatenate([jnp.pad(vb, pad)[:, :-1], vb], axis=2)
    scale = HEAD_DIM ** -0.5
    sc = jnp.einsum('bnqkgd,bnjkd->bnkgqj', qb, kband,
                    preferred_element_type=jnp.float32) * scale
    qi = jnp.arange(Q_BLOCK)[:, None]
    kj = jnp.arange(2 * Q_BLOCK)[None, :]
    dist = qi + Q_BLOCK - kj
    sc = sc + rel_bias_heads(rel_bias, dist)
    kpos = (jnp.arange(nb)[:, None] - 1) * Q_BLOCK + jnp.arange(2 * Q_BLOCK)[None, :]
    valid = ((dist >= 0) & (dist <= WINDOW))[None] & (kpos >= 0)[:, None, :]
    sc = jnp.where(valid[None, :, None, None], sc, NEG)
    p = sink_softmax(sc, sinks).astype(v.dtype)
    o = jnp.einsum('bnkgqj,bnjkd->bnqkgd', p, vband).reshape(b, s_len, ATTN_W)
    lw = min(WINDOW, s_len)
    return o, k[:, s_len - lw:], v[:, s_len - lw:]


def swa_sample(q, k, v, k_buf, v_buf, sinks, rel_bias):
    db, t = q.shape[0], q.shape[1]
    lb = k_buf.shape[1]
    kall = jnp.concatenate([k_buf, k], axis=1)
    vall = jnp.concatenate([v_buf, v], axis=1)
    qpos = PAST_LEN + jnp.arange(t)
    kpos = PAST_LEN - lb + jnp.arange(lb + t)
    dist = qpos[:, None] - kpos[None, :]
    valid = (dist >= 0) & (dist <= WINDOW)
    qg = q.reshape(db, t, N_KV_HEADS, GROUP, HEAD_DIM)
    scale = HEAD_DIM ** -0.5
    sc = jnp.einsum('btkgd,bjkd->bkgtj', qg, kall,
                    preferred_element_type=jnp.float32) * scale
    sc = sc + rel_bias_heads(rel_bias, dist)
    sc = jnp.where(valid, sc, NEG)
    p = sink_softmax(sc, sinks).astype(v.dtype)
    o = jnp.einsum('bkgtj,bjkd->btkgd', p, vall).reshape(db, t, ATTN_W)
    return o, kall[:, t:], vall[:, t:]


def decoder_layer(x, conv_buf, ffn_buf, attend, attn_norm_g, w_in, conv_w, w_branch_a,
                  w_branch_b, w_out, ffn_norm_g, w_ffn_gate, w_ffn_up, ffn_conv_w,
                  ffn_conv_b, w_ffn_down):
    b, t, _ = x.shape
    h = rmsnorm(x, attn_norm_g)
    proj = h @ w_in
    splits = np.cumsum([CONV_W, CONV_W, CONV_W, ATTN_W, KV_W, KV_W, D_MODEL]).tolist()
    cb, cc, ch, q, k, v, ga, gb = jnp.split(proj, splits, axis=-1)
    z, conv_state = causal_dwconv(conv_buf, cc * ch, conv_w)
    branch_a = (cb * z) @ w_branch_a
    o, k_state, v_state = attend(q.reshape(b, t, N_HEADS, HEAD_DIM),
                                 k.reshape(b, t, N_KV_HEADS, HEAD_DIM),
                                 v.reshape(b, t, N_KV_HEADS, HEAD_DIM))
    branch_b = o @ w_branch_b
    merged = jax.nn.sigmoid(ga) * branch_a + jax.nn.sigmoid(gb) * branch_b
    x = x + merged @ w_out
    h2 = rmsnorm(x, ffn_norm_g)
    gc, ffn_state = causal_dwconv(ffn_buf, h2 @ w_ffn_gate, ffn_conv_w)
    f = jax.nn.silu(gc + ffn_conv_b) * (h2 @ w_ffn_up)
    x = x + f @ w_ffn_down
    return x, k_state, v_state, conv_state, ffn_state


def setup_inputs(seed: int = 0) -> dict:
    key = jax.random.key(seed)
    ks = jax.random.split(key, 24)
    f32 = jnp.float32
    win_buf = min(WINDOW, PAST_LEN)

    def nrm(k, shape, scale):
        return jax.random.normal(k, shape, f32) * scale

    return {
        "x_prompt": nrm(ks[0], (BATCH, SEQ, D_MODEL), 1.0),
        "x_sample": nrm(ks[1], (DEC_BATCH, DEC_SEQ, D_MODEL), 1.0),
        "state_k_window": nrm(ks[2], (DEPTH, DEC_BATCH, win_buf, N_KV_HEADS, HEAD_DIM), 1.0),
        "state_v_window": nrm(ks[3], (DEPTH, DEC_BATCH, win_buf, N_KV_HEADS, HEAD_DIM), 1.0),
        "state_conv": nrm(ks[4], (DEPTH, DEC_BATCH, CONV_K - 1, CONV_W), 1.0),
        "state_ffn_conv": nrm(ks[5], (DEPTH, DEC_BATCH, FFN_CONV_K - 1, D_FF), 1.0),
        "attn_norm_g": 1.0 + nrm(ks[6], (DEPTH, D_MODEL), 0.02),
        "w_in": nrm(ks[7], (DEPTH, D_MODEL, IN_W), D_MODEL ** -0.5),
        "conv_w": nrm(ks[8], (DEPTH, CONV_K, CONV_W), CONV_K ** -0.5),
        "w_branch_a": nrm(ks[9], (DEPTH, CONV_W, D_MODEL), CONV_W ** -0.5),
        "w_branch_b": nrm(ks[10], (DEPTH, ATTN_W, D_MODEL), ATTN_W ** -0.5),
        "sinks": nrm(ks[11], (DEPTH, N_HEADS), 1.0),
        "w_out": nrm(ks[12], (DEPTH, D_MODEL, D_MODEL), D_MODEL ** -0.5),
        "ffn_norm_g": 1.0 + nrm(ks[13], (DEPTH, D_MODEL), 0.02),
        "w_ffn_gate": nrm(ks[14], (DEPTH, D_MODEL, D_FF), D_MODEL ** -0.5),
        "w_ffn_up": nrm(ks[15], (DEPTH, D_MODEL, D_FF), D_MODEL ** -0.5),
        "ffn_conv_w": nrm(ks[16], (DEPTH, FFN_CONV_K, D_FF), FFN_CONV_K ** -0.5),
        "ffn_conv_b": nrm(ks[17], (DEPTH, D_FF), 0.01),
        "w_ffn_down": nrm(ks[18], (DEPTH, D_FF, D_MODEL), D_FF ** -0.5),
        "rel_bias": nrm(ks[19], (N_BUCKETS, N_HEADS), 0.5),
        "final_norm_g": 1.0 + nrm(ks[20], (D_MODEL,), 0.02),
    }


def reference(x_prompt, x_sample, state_k_window, state_v_window, state_conv, state_ffn_conv,
              attn_norm_g, w_in, conv_w, w_branch_a, w_branch_b, sinks, w_out, ffn_norm_g,
              w_ffn_gate, w_ffn_up, ffn_conv_w, ffn_conv_b, w_ffn_down, rel_bias,
              final_norm_g):
    xp, xs = x_prompt, x_sample
    pk, pv, pc, pf = [], [], [], []
    sk, sv, sc, sf = [], [], [], []
    for l in range(DEPTH):
        weights = (attn_norm_g[l], w_in[l], conv_w[l], w_branch_a[l], w_branch_b[l], w_out[l],
                   ffn_norm_g[l], w_ffn_gate[l], w_ffn_up[l], ffn_conv_w[l], ffn_conv_b[l],
                   w_ffn_down[l])
        sinks_l = sinks[l]
        zc = jnp.zeros((xp.shape[0], CONV_K - 1, CONV_W), xp.dtype)
        zf = jnp.zeros((xp.shape[0], FFN_CONV_K - 1, D_FF), xp.dtype)
        attend_p = lambda q, k, v, s_=sinks_l: swa_prompt(q, k, v, s_, rel_bias)
        xp, k1, v1, c1, f1 = decoder_layer(xp, zc, zf, attend_p, *weights)
        pk.append(k1); pv.append(v1); pc.append(c1); pf.append(f1)
        kb_l, vb_l = state_k_window[l], state_v_window[l]
        attend_s = lambda q, k, v, s_=sinks_l, kb=kb_l, vb=vb_l: swa_sample(q, k, v, kb, vb, s_, rel_bias)
        xs, k2, v2, c2, f2 = decoder_layer(xs, state_conv[l], state_ffn_conv[l], attend_s, *weights)
        sk.append(k2); sv.append(v2); sc.append(c2); sf.append(f2)
    y_prompt = rmsnorm(xp, final_norm_g)
    y_sample = rmsnorm(xs, final_norm_g)
    return (y_prompt, y_sample, jnp.stack(pk), jnp.stack(pv), jnp.stack(pc), jnp.stack(pf),
            jnp.stack(sk), jnp.stack(sv), jnp.stack(sc), jnp.stack(sf))
```

```cpp
#include <hip/hip_runtime.h>
#include <cstdio>
#include <cstdint>
#include <cmath>
namespace pg8 {
#define PG8_LAS __attribute__((address_space(3)))
typedef unsigned short bf16_t;
typedef short bf16x8 __attribute__((ext_vector_type(8)));
typedef float f32x4 __attribute__((ext_vector_type(4)));
typedef unsigned u32x4 __attribute__((ext_vector_type(4)));
constexpr int BM = 256, BK = 64, HALF = 128, HTB = HALF * BK * 2  , STAGE_BYTES = 8 * HTB, NXCD = 8, WGM = 8;

__host__ __device__ __forceinline__ int lds_byte(int r, int c) { const int st = (r >> 4) * 2 + (c >> 5), rr = r & 15, cc = c & 31, ob = rr * 64 + cc * 2; return st * 1024 + (ob ^ (((ob >> 9) & 1) << 5)); }
__host__ __device__ __forceinline__ void stage_rc(int b, int& R, int& C) { const int st = b / 1024, sb = b % 1024, swz = sb ^ (((sb >> 9) & 1) << 5); R = (st >> 1) * 16 + swz / 64; C = (st & 1) * 32 + (swz % 64) / 2; }
__host__ __device__ __forceinline__ int perm32(int rho) { const int n = rho >> 4, i = rho & 15; return 8 * (i >> 2) + 4 * n + (i & 3); }

struct Unit { int pm, pn; };
struct Gemm { const bf16_t* A; const bf16_t* Bt; int M, N, K; };

struct StaticOrder {
    int nM, nN, nwg, G, c;
    __host__ __device__ void init(int M, int N, int G_, int c_) { nM = M / BM; nN = N / BM; nwg = nM * nN; G = G_; c = c_; }
    __host__ __device__ bool next(int i, Unit& u) const {
        const long L = (long)i * G + c; if (L >= nwg) return false;
        int wgid = (int)L; { const int q = nwg / NXCD, r = nwg % NXCD, xcd = wgid % NXCD, off = wgid / NXCD; wgid = (xcd < r ? xcd * (q + 1) : r * (q + 1) + (xcd - r) * q) + off; }
        const int nig = WGM * nN, gid = wgid / nig, fm = gid * WGM, gsz = (nM - fm) < WGM ? (nM - fm) : WGM;
        u.pm = fm + ((wgid % nig) % gsz); u.pn = (wgid % nig) / gsz; return true;
    }
    __device__ __forceinline__ void a_ready(const Unit&) const {}
    __device__ __forceinline__ void done(const Unit&) const {}
};

__device__ __forceinline__ unsigned cvt_pk_bf16(float lo, float hi) { unsigned r; asm volatile("v_cvt_pk_bf16_f32 %0, %1, %2" : "=v"(r) : "v"(lo), "v"(hi)); return r; }
typedef float f32x2 __attribute__((ext_vector_type(2)));

#define PG8_GAS __attribute__((address_space(1)))
constexpr int ROWS_P = 8192, ROWS_R = 8320, ROWS_PAD = 8448, PAN_S = 32;
constexpr size_t O_YP = 0, O_YS = 33554432, O_PK = 34078720, O_PV = 34340864, O_PC = 34603008, O_PF = 34619392, O_SK = 34707456, O_SV = 43096064, O_SC = 51484672, O_SF = 52008960, O_END = 54827008;

__device__ __forceinline__ u32x4 pack8(const f32x4 a, const f32x4 b) { u32x4 w; w.x = cvt_pk_bf16(a[0], a[1]); w.y = cvt_pk_bf16(a[2], a[3]); w.z = cvt_pk_bf16(b[0], b[1]); w.w = cvt_pk_bf16(b[2], b[3]); return w; }
__device__ __forceinline__ float bf_lo(unsigned w) { return __uint_as_float(w << 16); }
__device__ __forceinline__ float bf_hi(unsigned w) { return __uint_as_float(w & 0xffff0000u); }
__device__ __forceinline__ void st16(void* p, u32x4 v) { *(PG8_GAS u32x4*)p = v; }
__device__ __forceinline__ void st16f(float* p, f32x4 v) { *(PG8_GAS f32x4*)p = v; }
__device__ __forceinline__ u32x4 ld16(const void* p) { return *(const PG8_GAS u32x4*)p; }
__device__ __forceinline__ f32x4 ld16f(const float* p) { return *(const PG8_GAS f32x4*)p; }
__device__ __forceinline__ float fast_exp(float x) { return __builtin_amdgcn_exp2f(x * 1.4426950408889634f); }

struct EpiProj {
    static constexpr bool PERM = true, AFTER_DRAIN = false, MIDK = false;
    bf16_t *CB, *UU, *Q, *KB, *VT, *RAT, *SGB; float* out;
    __device__ __forceinline__ void mid(f32x4 (&)[2][2][4][2], const Unit&, int, int, int, int) const {}
    __device__ __forceinline__ void operator()(const f32x4 (&acc)[2][2][4][2], const Unit& u, int wr, int wc, int fr, int fq) const {
        const int pn = u.pn, pm = u.pm;
        const int rbase = pm * BM + wr * 64 + fr;
        const int cl = wc * 32 + 8 * fq;
        const int nai = (pm == PAN_S) ? 1 : 2;
        const bool winp = ((pm & 7) == 7) && (pm < PAN_S);
        if (pn < 8 || (pn >= 24 && pn < 34)) {
            bf16_t* base; int ld, c0;
            if (pn < 8) { base = CB; ld = 2048; c0 = pn * 256; }
            else if (pn < 32) { base = Q; ld = 2048; c0 = (pn - 24) * 256; }
            else { base = KB; ld = 512; c0 = (pn - 32) * 256; }
#pragma unroll
            for (int ai = 0; ai < 2; ++ai) if (ai < nai)
#pragma unroll
                for (int m = 0; m < 4; ++m) { const int row = rbase + ai * HALF + m * 16;
#pragma unroll
                    for (int bj = 0; bj < 2; ++bj) st16(base + (size_t)row * ld + c0 + bj * HALF + cl, pack8(acc[ai][bj][m][0], acc[ai][bj][m][1])); }
            if (pn >= 32) {
                if (pm == PAN_S) {
#pragma unroll
                    for (int m = 0; m < 4; ++m) { const int b = rbase + m * 16 - ROWS_P;
#pragma unroll
                        for (int bj = 0; bj < 2; ++bj) { float* d = out + O_SK + ((size_t)b * 128 + 127) * 512 + c0 + bj * HALF + cl; st16f(d, acc[0][bj][m][0]); st16f(d + 4, acc[0][bj][m][1]); } }
                } else if (winp) {
#pragma unroll
                    for (int m = 0; m < 4; ++m) { const int row = rbase + HALF + m * 16, b = row >> 11, j = (row & 2047) - 1920;
#pragma unroll
                        for (int bj = 0; bj < 2; ++bj) { float* d = out + O_PK + ((size_t)b * 128 + j) * 512 + c0 + bj * HALF + cl; st16f(d, acc[1][bj][m][0]); st16f(d + 4, acc[1][bj][m][1]); } }
                }
            }
        } else if (pn < 24) {
            const int c0 = (pn - 8) * 128 + cl;
#pragma unroll
            for (int ai = 0; ai < 2; ++ai) if (ai < nai)
#pragma unroll
                for (int m = 0; m < 4; ++m) { const int row = rbase + ai * HALF + m * 16;
                    const f32x4 u0 = acc[ai][0][m][0] * acc[ai][1][m][0], u1 = acc[ai][0][m][1] * acc[ai][1][m][1];
                    st16(UU + (size_t)row * 2048 + c0, pack8(u0, u1));
                    if (pm == PAN_S) { float* d = out + O_SC + ((size_t)(row - ROWS_P) * 2 + 1) * 2048 + c0; st16f(d, u0); st16f(d + 4, u1); }
                    else if (winp && ai == 1 && m == 3 && wr == 1 && fr >= 14) { float* d = out + O_PC + ((size_t)(row >> 11) * 2 + (fr - 14)) * 2048 + c0; st16f(d, u0); st16f(d + 4, u1); }
                }
        } else if (pn < 36) {
            const int c0 = (pn - 34) * 256;
            if (pm < PAN_S) {
#pragma unroll
                for (int ai = 0; ai < 2; ++ai)
#pragma unroll
                    for (int m = 0; m < 4; ++m) { const int row = rbase + ai * HALF + m * 16;
#pragma unroll
                        for (int bj = 0; bj < 2; ++bj)
#pragma unroll
                            for (int n = 0; n < 2; ++n) { const f32x4 v = acc[ai][bj][m][n]; const unsigned w0 = cvt_pk_bf16(v[0], v[1]), w1 = cvt_pk_bf16(v[2], v[3]);
                                PG8_GAS bf16_t* d = (PG8_GAS bf16_t*)(VT + (size_t)(c0 + bj * HALF + cl + 4 * n) * ROWS_PAD + row);
                                d[0] = (bf16_t)(w0 & 0xffffu); d[ROWS_PAD] = (bf16_t)(w0 >> 16); d[2 * ROWS_PAD] = (bf16_t)(w1 & 0xffffu); d[3 * ROWS_PAD] = (bf16_t)(w1 >> 16); } }
            }
            if (pm == PAN_S) {
#pragma unroll
                for (int m = 0; m < 4; ++m) { const int b = rbase + m * 16 - ROWS_P;
#pragma unroll
                    for (int bj = 0; bj < 2; ++bj) { float* d = out + O_SV + ((size_t)b * 128 + 127) * 512 + c0 + bj * HALF + cl; st16f(d, acc[0][bj][m][0]); st16f(d + 4, acc[0][bj][m][1]); } }
            } else if (winp) {
#pragma unroll
                for (int m = 0; m < 4; ++m) { const int row = rbase + HALF + m * 16, b = row >> 11, j = (row & 2047) - 1920;
#pragma unroll
                    for (int bj = 0; bj < 2; ++bj) { float* d = out + O_PV + ((size_t)b * 128 + j) * 512 + c0 + bj * HALF + cl; st16f(d, acc[1][bj][m][0]); st16f(d + 4, acc[1][bj][m][1]); } }
            }
        } else {
            const int c0 = (pn - 36) * 128 + cl;
#pragma unroll
            for (int ai = 0; ai < 2; ++ai) if (ai < nai)
#pragma unroll
                for (int m = 0; m < 4; ++m) { const int row = rbase + ai * HALF + m * 16;
                    f32x4 rt[2], sb[2];
#pragma unroll
                    for (int n = 0; n < 2; ++n)
#pragma unroll
                        for (int e = 0; e < 4; ++e) { const float ea = 1.0f + fast_exp(-acc[ai][0][m][n][e]), eb = 1.0f + fast_exp(-acc[ai][1][m][n][e]);
                            sb[n][e] = __builtin_amdgcn_rcpf(eb); rt[n][e] = eb * __builtin_amdgcn_rcpf(ea); }
                    st16(RAT + (size_t)row * 4096 + c0, pack8(rt[0], rt[1])); st16(SGB + (size_t)row * 4096 + c0, pack8(sb[0], sb[1])); }
        }
    }
};

struct EpiMerged {
    static constexpr bool PERM = true, AFTER_DRAIN = false, MIDK = true;
    const bf16_t *RAT, *SGB; bf16_t* MG;
    __device__ __forceinline__ void scale(f32x4 (&acc)[2][2][4][2], const bf16_t* S, const Unit& u, int wr, int wc, int fr, int fq) const {
        int rbase = u.pm * BM + wr * 64 + fr; const int c0 = u.pn * BM + wc * 32 + 8 * fq, nai = (u.pm == PAN_S) ? 1 : 2;
        asm volatile("" : "+v"(rbase));
#pragma unroll
        for (int ai = 0; ai < 2; ++ai) if (ai < nai)
#pragma unroll
            for (int m = 0; m < 4; ++m) { const int row = rbase + ai * HALF + m * 16;
#pragma unroll
                for (int bj = 0; bj < 2; ++bj) { const u32x4 r = ld16(S + (size_t)row * 4096 + c0 + bj * HALF);
                    acc[ai][bj][m][0] *= (f32x4){bf_lo(r.x), bf_hi(r.x), bf_lo(r.y), bf_hi(r.y)}; acc[ai][bj][m][1] *= (f32x4){bf_lo(r.z), bf_hi(r.z), bf_lo(r.w), bf_hi(r.w)}; }
                if (m & 1) asm volatile("" ::: "memory"); }
    }
    __device__ __forceinline__ void mid(f32x4 (&acc)[2][2][4][2], const Unit& u, int wr, int wc, int fr, int fq) const { scale(acc, RAT, u, wr, wc, fr, fq); }
    __device__ __forceinline__ void operator()(f32x4 (&acc)[2][2][4][2], const Unit& u, int wr, int wc, int fr, int fq) const {
        scale(acc, SGB, u, wr, wc, fr, fq);
        const int rbase = u.pm * BM + wr * 64 + fr, c0 = u.pn * BM + wc * 32 + 8 * fq, nai = (u.pm == PAN_S) ? 1 : 2;
#pragma unroll
        for (int ai = 0; ai < 2; ++ai) if (ai < nai)
#pragma unroll
            for (int m = 0; m < 4; ++m) { const int row = rbase + ai * HALF + m * 16;
#pragma unroll
                for (int bj = 0; bj < 2; ++bj) st16(MG + (size_t)row * 4096 + c0 + bj * HALF, pack8(acc[ai][bj][m][0], acc[ai][bj][m][1])); }
    }
};

struct EpiResid {
    static constexpr bool PERM = false, AFTER_DRAIN = false, MIDK = false;
    const float *xp, *xs; float* X1;
    __device__ __forceinline__ void mid(f32x4 (&)[2][2][4][2], const Unit&, int, int, int, int) const {}
    __device__ __forceinline__ void operator()(const f32x4 (&acc)[2][2][4][2], const Unit& u, int wr, int wc, int fr, int fq) const {
        const int rbase = u.pm * BM + wr * 64 + fr, c0 = u.pn * BM + wc * 32 + 4 * fq, nai = (u.pm == PAN_S) ? 1 : 2;
#pragma unroll
        for (int ai = 0; ai < 2; ++ai) if (ai < nai)
#pragma unroll
            for (int m = 0; m < 4; ++m) { const int row = rbase + ai * HALF + m * 16;
                const float* src = (row < ROWS_P) ? xp + (size_t)row * 4096 : xs + (size_t)(row - ROWS_P) * 4096;
                f32x4 xv[2][2];
#pragma unroll
                for (int bj = 0; bj < 2; ++bj)
#pragma unroll
                    for (int n = 0; n < 2; ++n) xv[bj][n] = ld16f(src + c0 + bj * HALF + n * 16);
#pragma unroll
                for (int bj = 0; bj < 2; ++bj)
#pragma unroll
                    for (int n = 0; n < 2; ++n) st16f(X1 + (size_t)row * 4096 + c0 + bj * HALF + n * 16, xv[bj][n] + acc[ai][bj][m][n]); }
    }
};

struct EpiGateUp {
    static constexpr bool PERM = true, AFTER_DRAIN = false, MIDK = false;
    bf16_t *G, *U; float* out;
    __device__ __forceinline__ void mid(f32x4 (&)[2][2][4][2], const Unit&, int, int, int, int) const {}
    __device__ __forceinline__ void operator()(const f32x4 (&acc)[2][2][4][2], const Unit& u, int wr, int wc, int fr, int fq) const {
        const int pn = u.pn, pm = u.pm;
        const int rbase = pm * BM + wr * 64 + fr, nai = (pm == PAN_S) ? 1 : 2;
        const bool gate = pn < 43;
        bf16_t* base = gate ? G : U; const int c0 = (gate ? pn : pn - 43) * 256 + wc * 32 + 8 * fq;
        const bool winp = ((pm & 7) == 7) && (pm < PAN_S);
#pragma unroll
        for (int ai = 0; ai < 2; ++ai) if (ai < nai)
#pragma unroll
            for (int m = 0; m < 4; ++m) { const int row = rbase + ai * HALF + m * 16;
#pragma unroll
                for (int bj = 0; bj < 2; ++bj) { st16(base + (size_t)row * 11008 + c0 + bj * HALF, pack8(acc[ai][bj][m][0], acc[ai][bj][m][1]));
                    if (gate) {
                        if (pm == PAN_S) { float* d = out + O_SF + ((size_t)(row - ROWS_P) * 2 + 1) * 11008 + c0 + bj * HALF; st16f(d, acc[ai][bj][m][0]); st16f(d + 4, acc[ai][bj][m][1]); }
                        else if (winp && ai == 1 && m == 3 && wr == 1 && fr >= 14) { float* d = out + O_PF + ((size_t)(row >> 11) * 2 + (fr - 14)) * 11008 + c0 + bj * HALF; st16f(d, acc[ai][bj][m][0]); st16f(d + 4, acc[ai][bj][m][1]); }
                    } } }
    }
};
template <class Epi, class Sched, bool ALIGN_EPI = false, bool SP2 = false>
__device__ __forceinline__ void gemm_phase(PG8_LAS unsigned char* lds, const Gemm g, const Sched& S, const Epi& E) {
    int tid_ = threadIdx.x; asm volatile("" : "+v"(tid_));
    const int tid = tid_, wid = __builtin_amdgcn_readfirstlane(tid >> 6), lane = tid & 63, wr = wid >> 2, wc = wid & 3, fr = lane & 15, fq = lane >> 4;
    const int K = g.K, nt = K / BK;
    unsigned voffA[2], voffB[2];
#pragma unroll
    for (int i = 0; i < 2; ++i) { int R, C; stage_rc(tid * 16 + i * 8192, R, C); const int Rb = Epi::PERM ? ((R & ~31) + perm32(R & 31)) : R;
        voffA[i] = (unsigned)(R * K + C) * 2u; voffB[i] = (unsigned)(Rb * K + C) * 2u; }
    const size_t kstep = (size_t)(BK * 2);
    const size_t hstep = (size_t)HALF * K * 2;
    const size_t tstep = 2 * hstep;
    const unsigned ldsw = (unsigned)wid * 1024u;
    const int aoff = lds_byte(wr * 64 + fr, fq * 8), boff = lds_byte(wc * 32 + fr, fq * 8);
#define PG8_SA(b, h) (((b) * 2 + (h)) * HTB)
#define PG8_SB(b, h) ((4 + (b) * 2 + (h)) * HTB)
#define PG8_STAGE(bufoff, gbase, voff) do { _Pragma("unroll") for (int _i = 0; _i < 2; ++_i) \
        __builtin_amdgcn_global_load_lds((const unsigned*)((const char*)(gbase) + (voff)[_i]), (PG8_LAS unsigned*)(lds + (bufoff) + ldsw + _i * 8192), 16, 0, 0); } while (0)
#define PG8_LDA(dst, b, h) do { _Pragma("unroll") for (int m = 0; m < 4; ++m) _Pragma("unroll") for (int k = 0; k < 2; ++k) dst[m][k] = *(const PG8_LAS bf16x8*)(lds + PG8_SA(b, h) + aoff + m * 2048 + k * 1024); } while (0)
#define PG8_LDB(dst, b, h) do { _Pragma("unroll") for (int n = 0; n < 2; ++n) _Pragma("unroll") for (int k = 0; k < 2; ++k) dst[n][k] = *(const PG8_LAS bf16x8*)(lds + PG8_SB(b, h) + boff + n * 2048 + k * 1024); } while (0)
#define PG8_MMA(ai, bj, At, Bt) do { __builtin_amdgcn_s_setprio(1); _Pragma("unroll") for (int m = 0; m < 4; ++m) _Pragma("unroll") for (int n = 0; n < 2; ++n) _Pragma("unroll") for (int k = 0; k < 2; ++k) \
        acc[ai][bj][m][n] = __builtin_amdgcn_mfma_f32_16x16x32_bf16(Bt[n][k], At[m][k], acc[ai][bj][m][n], 0, 0, 0); __builtin_amdgcn_s_setprio(0); } while (0)
#define PG8_WAIT_V(n) asm volatile("s_waitcnt vmcnt(" #n ")" ::: "memory")
#define PG8_WAIT_L(n) asm volatile("s_waitcnt lgkmcnt(" #n ")" ::: "memory")
#define PG8_BAR __builtin_amdgcn_s_barrier()
#define PG8_SCHED __builtin_amdgcn_sched_barrier(0)
    Unit cur, nxt; int ui = 0;
    if (!S.next(0, cur)) return;
    f32x4 acc[2][2][4][2];
#pragma unroll
    for (int a = 0; a < 2; ++a)
#pragma unroll
        for (int b = 0; b < 2; ++b)
#pragma unroll
            for (int m = 0; m < 4; ++m)
#pragma unroll
                for (int n = 0; n < 2; ++n) acc[a][b][m][n] = (f32x4){0.f, 0.f, 0.f, 0.f};
    bf16x8 At[4][2], B0[2][2], B1[2][2];
    const char* cA = (const char*)g.A + (size_t)cur.pm * tstep; const char* cB = (const char*)g.Bt + (size_t)cur.pn * tstep;
    S.a_ready(cur);
    if constexpr (SP2) {
        PG8_STAGE(PG8_SB(0, 0), cB, voffB); PG8_STAGE(PG8_SB(0, 1), cB + hstep, voffB); PG8_STAGE(PG8_SA(0, 0), cA, voffA); PG8_STAGE(PG8_SA(0, 1), cA + hstep, voffA);
        if (wr == 1) PG8_BAR;
        PG8_WAIT_V(2); PG8_BAR;
        PG8_STAGE(PG8_SB(1, 0), cB + kstep, voffB); PG8_STAGE(PG8_SA(1, 0), cA + kstep, voffA); PG8_STAGE(PG8_SB(1, 1), cB + hstep + kstep, voffB);
        PG8_WAIT_V(6); PG8_BAR;
    } else {
        PG8_STAGE(PG8_SB(0, 0), cB, voffB); PG8_STAGE(PG8_SA(0, 0), cA, voffA); PG8_STAGE(PG8_SB(0, 1), cB + hstep, voffB); PG8_STAGE(PG8_SA(0, 1), cA + hstep, voffA);
        if (wr == 1) PG8_BAR;
        PG8_WAIT_V(4); PG8_BAR;
        PG8_STAGE(PG8_SB(1, 0), cB + kstep, voffB); PG8_STAGE(PG8_SA(1, 0), cA + kstep, voffA); PG8_STAGE(PG8_SB(1, 1), cB + hstep + kstep, voffB);
        PG8_WAIT_V(6); PG8_BAR;
    }
    for (;;) {
        const bool has_next = S.next(ui + 1, nxt);
        const char* nA = has_next ? (const char*)g.A + (size_t)nxt.pm * tstep : cA; const char* nB = has_next ? (const char*)g.Bt + (size_t)nxt.pn * tstep : cB;
        for (int t = 0; t < nt; t += 2) {
            if constexpr (Epi::MIDK) { if (t == (nt >> 1)) E.mid(acc, cur, wr, wc, fr, fq); }
            const bool last = (t == nt - 2);
            const char* a1 = cA + (size_t)(t + 1) * kstep;
            const char* a2 = last ? nA : cA + (size_t)(t + 2) * kstep; const char* b2 = last ? nB : cB + (size_t)(t + 2) * kstep;
            const char* a3 = a2 + kstep; const char* b3 = b2 + kstep;
            if (last && has_next) S.a_ready(nxt);
            if constexpr (SP2) {
            PG8_LDB(B0, 0, 0); PG8_LDB(B1, 0, 1); PG8_SCHED; PG8_LDA(At, 0, 0); PG8_STAGE(PG8_SA(1, 1), a1 + hstep, voffA);
            PG8_WAIT_V(8); PG8_WAIT_L(0); PG8_BAR; PG8_MMA(0, 0, At, B0); PG8_MMA(0, 1, At, B1); PG8_BAR; PG8_SCHED;
            PG8_LDA(At, 0, 1); PG8_STAGE(PG8_SB(0, 0), b2, voffB); PG8_STAGE(PG8_SB(0, 1), b2 + hstep, voffB); PG8_STAGE(PG8_SA(0, 0), a2, voffA);
            PG8_WAIT_V(8); PG8_WAIT_L(0); PG8_BAR; PG8_MMA(1, 0, At, B0); PG8_MMA(1, 1, At, B1); PG8_BAR; PG8_SCHED;
            PG8_LDB(B0, 1, 0); PG8_LDB(B1, 1, 1); PG8_SCHED; PG8_LDA(At, 1, 0); PG8_STAGE(PG8_SA(0, 1), a2 + hstep, voffA);
            PG8_WAIT_V(8); PG8_WAIT_L(0); PG8_BAR; PG8_MMA(0, 0, At, B0); PG8_MMA(0, 1, At, B1); PG8_BAR; PG8_SCHED;
            PG8_LDA(At, 1, 1); PG8_STAGE(PG8_SB(1, 0), b3, voffB); PG8_STAGE(PG8_SB(1, 1), b3 + hstep, voffB); PG8_STAGE(PG8_SA(1, 0), a3, voffA);
            PG8_WAIT_V(8); PG8_WAIT_L(0); PG8_BAR; PG8_MMA(1, 0, At, B0); PG8_MMA(1, 1, At, B1); PG8_BAR; PG8_SCHED;
            } else {
            PG8_LDB(B0, 0, 0); PG8_SCHED; PG8_LDA(At, 0, 0); PG8_STAGE(PG8_SA(1, 1), a1 + hstep, voffA);
            PG8_WAIT_L(8); PG8_BAR; PG8_WAIT_L(0); PG8_MMA(0, 0, At, B0); PG8_BAR; PG8_SCHED;
            PG8_LDB(B1, 0, 1); PG8_STAGE(PG8_SB(0, 0), b2, voffB);
            PG8_BAR; PG8_WAIT_L(0); PG8_MMA(0, 1, At, B1); PG8_BAR;
            PG8_LDA(At, 0, 1); PG8_STAGE(PG8_SA(0, 0), a2, voffA);
            PG8_BAR; PG8_WAIT_L(0); PG8_MMA(1, 0, At, B0); PG8_BAR; PG8_SCHED;
            PG8_STAGE(PG8_SB(0, 1), b2 + hstep, voffB);
            PG8_WAIT_V(6); PG8_BAR; PG8_MMA(1, 1, At, B1); PG8_BAR;
            PG8_LDB(B0, 1, 0); PG8_SCHED; PG8_LDA(At, 1, 0); PG8_STAGE(PG8_SA(0, 1), a2 + hstep, voffA);
            PG8_WAIT_L(8); PG8_BAR; PG8_WAIT_L(0); PG8_MMA(0, 0, At, B0); PG8_BAR; PG8_SCHED;
            PG8_LDB(B1, 1, 1); PG8_STAGE(PG8_SB(1, 0), b3, voffB);
            PG8_BAR; PG8_WAIT_L(0); PG8_MMA(0, 1, At, B1); PG8_BAR;
            PG8_LDA(At, 1, 1); PG8_STAGE(PG8_SA(1, 0), a3, voffA);
            PG8_BAR; PG8_WAIT_L(0); PG8_MMA(1, 0, At, B0); PG8_BAR; PG8_SCHED;
            PG8_STAGE(PG8_SB(1, 1), b3 + hstep, voffB);
            PG8_WAIT_V(6); PG8_BAR; PG8_MMA(1, 1, At, B1); PG8_BAR;
            }
        }
        if constexpr (ALIGN_EPI) { if (wr == 0) PG8_BAR; }
        if constexpr (!Epi::AFTER_DRAIN) { E(acc, cur, wr, wc, fr, fq); S.done(cur); }
        if (!has_next) break;
#pragma unroll
        for (int a = 0; a < 2; ++a)
#pragma unroll
            for (int b = 0; b < 2; ++b)
#pragma unroll
                for (int m = 0; m < 4; ++m)
#pragma unroll
                    for (int n = 0; n < 2; ++n) acc[a][b][m][n] = (f32x4){0.f, 0.f, 0.f, 0.f};
        cur = nxt; cA = nA; cB = nB; ++ui;
        if constexpr (ALIGN_EPI) { if (wr == 1) PG8_BAR; }
    }
    PG8_WAIT_V(0);
    if constexpr (!ALIGN_EPI) { if (wr == 0) PG8_BAR; }
    PG8_BAR;
    if constexpr (Epi::AFTER_DRAIN) { E.fused(acc, cur, wr, wc, fr, fq, lds, wid, lane); S.done(cur); }
#undef PG8_SA
#undef PG8_SB
#undef PG8_STAGE
#undef PG8_LDA
#undef PG8_LDB
#undef PG8_MMA
#undef PG8_WAIT_V
#undef PG8_WAIT_L
#undef PG8_BAR
#undef PG8_SCHED
}
}
#define GAS __attribute__((address_space(1)))
#define LAS __attribute__((address_space(3)))
typedef unsigned short bf16;
typedef unsigned v4u __attribute__((ext_vector_type(4)));
typedef float f32x4 __attribute__((ext_vector_type(4)));
typedef short bf16x8 __attribute__((ext_vector_type(8)));
typedef GAS unsigned gu32;
typedef GAS unsigned long long gu64;
#define RLX_AGENT __ATOMIC_RELAXED, __HIP_MEMORY_SCOPE_AGENT
#define LDS_WAIT() asm volatile("s_waitcnt lgkmcnt(0)" ::: "memory")
#define VM_WAIT() asm volatile("s_waitcnt vmcnt(0)" ::: "memory")
__device__ __forceinline__ unsigned long long rt() { return __builtin_amdgcn_s_memrealtime(); }
__device__ __forceinline__ unsigned f2bf(float f) { unsigned u = __builtin_bit_cast(unsigned, f); return (u + 0x7fffu + ((u >> 16) & 1u)) >> 16; }
__device__ __forceinline__ unsigned pk2(float lo, float hi) { return f2bf(lo) | (f2bf(hi) << 16); }

#define XB_TMO      128
#define XB_XCNT(j)  (256  + 64 * (j))
#define XB_XSUB(j)  (1280 + 64 * (j))
#define XB_XGEN(j)  (2304 + 64 * (j))
#define XB_TOP      3328
#define XB_TOPGEN   3392
#define XCD_BAR_WORDS 3456
#define XB_SPIN_CAP (1u << 18)

__device__ __forceinline__ unsigned xb_ld(unsigned* p)              { return __hip_atomic_load(p, __ATOMIC_RELAXED, __HIP_MEMORY_SCOPE_AGENT); }
__device__ __forceinline__ unsigned xb_add(unsigned* p, unsigned v) { return __hip_atomic_fetch_add(p, v, __ATOMIC_RELAXED, __HIP_MEMORY_SCOPE_AGENT); }
__device__ __forceinline__ unsigned xb_xcc_id() { return (unsigned)__builtin_amdgcn_s_getreg((3 << 11) | 20) & 0xFu; }
#define XB_SPIN(cond, bar) do { unsigned _sp = 0; while (cond) { __builtin_amdgcn_s_sleep(1); \
    if ((++_sp & 255u) == 0u) { if (xb_ld(&(bar)[XB_TMO])) break; if (_sp > XB_SPIN_CAP) { atomicAdd(&(bar)[XB_TMO], 1u); break; } } } } while (0)

struct XcdBarrier {
    unsigned* bar; unsigned x;
    volatile LAS unsigned* st;
};

__device__ __forceinline__ XcdBarrier xcd_barrier_post(unsigned* bar, volatile LAS unsigned* st) {
    XcdBarrier b; b.bar = bar; b.x = xb_xcc_id(); b.st = st;
    if (threadIdx.x == 0) (void)xb_add(&bar[XB_XCNT(b.x)], 1u);
    return b;
}
__device__ __forceinline__ void xcd_barrier_complete(unsigned* bar, unsigned x, unsigned& nloc, unsigned& nx) {
    const unsigned G = gridDim.x * gridDim.y * gridDim.z;
    unsigned sum, cnt, mine, sp = 0u;
    for (;;) {
        sum = 0u; cnt = 0u; mine = 0u;
#pragma unroll
        for (unsigned j = 0; j < 16; ++j) { const unsigned c = xb_ld(&bar[XB_XCNT(j)]); sum += c; cnt += (c > 0u) ? 1u : 0u; mine = (j == x) ? c : mine; }
        if (sum == G) break;
        __builtin_amdgcn_s_sleep(1);
        if ((++sp & 255u) == 0u) { if (xb_ld(&bar[XB_TMO])) break; if (sp > XB_SPIN_CAP) { atomicAdd(&bar[XB_TMO], 1u); break; } }
    }
    nloc = mine > 0u ? mine : 1u; nx = cnt > 0u ? cnt : 1u;
}

__device__ __forceinline__ void xcd_barrier(const XcdBarrier& b) {
    asm volatile("s_waitcnt vmcnt(0)" ::: "memory");
    __syncthreads();
    if (threadIdx.x == 0) {
        unsigned* bar = b.bar;
        __builtin_amdgcn_s_waitcnt(0);
        unsigned nloc = b.st[0], nx = b.st[1];
        if (nloc == 0u) { xcd_barrier_complete(bar, b.x, nloc, nx); b.st[0] = nloc; b.st[1] = nx; }
        const unsigned old = xb_add(&bar[XB_XSUB(b.x)], 1u);
        const unsigned gen = old / nloc;
        if (old + 1u == (gen + 1u) * nloc) {
            __builtin_amdgcn_fence(__ATOMIC_RELEASE, "agent");
            asm volatile("s_waitcnt vmcnt(0)" ::: "memory");
            const unsigned og = xb_add(&bar[XB_TOP], 1u);
            const unsigned tg = og / nx;
            if (og + 1u == (tg + 1u) * nx) xb_add(&bar[XB_TOPGEN], 1u);
            else XB_SPIN(xb_ld(&bar[XB_TOPGEN]) == tg, bar);
            __builtin_amdgcn_fence(__ATOMIC_ACQUIRE, "agent");
            xb_add(&bar[XB_XGEN(b.x)], 1u);
            asm volatile("s_waitcnt vmcnt(0)" ::: "memory");
        } else {
            XB_SPIN(xb_ld(&bar[XB_XGEN(b.x)]) == gen, bar);
            __builtin_amdgcn_fence(__ATOMIC_ACQUIRE, "agent");
            asm volatile("s_waitcnt vmcnt(0)" ::: "memory");
        }
    }
    __syncthreads();
}


constexpr int NWAVES = 8;
constexpr int DM = 4096, SEQ = 2048, CONVW = 2048, KVW = 512, DFF = 11008, INW = 17408;
constexpr int ROWS_P = pg8::ROWS_P, ROWS_R = pg8::ROWS_R, MPAD = pg8::ROWS_PAD;
constexpr float EPS = 1e-5f, LOG2E = 1.4426950408889634f;
using pg8::O_YP; using pg8::O_YS; using pg8::O_SK; using pg8::O_SV; using pg8::O_SC; using pg8::O_SF; using pg8::O_END;

constexpr size_t MiB = 1u << 20;
constexpr size_t WS_CTL = 0, CTL_ZERO_BYTES = 1 * MiB;
constexpr size_t WS_WGU = 1 * MiB;
constexpr size_t WS_WD  = WS_WGU + (size_t)2 * DFF * DM * 2;
constexpr size_t WS_XN  = WS_WD + (size_t)DM * DFF * 2;
constexpr size_t WS_X1  = WS_XN + (size_t)MPAD * DM * 2;
constexpr size_t WS_A   = WS_X1 + (size_t)MPAD * DM * 4;
constexpr size_t WS_WIN = WS_A;
constexpr size_t WS_WAB = WS_WIN + (size_t)INW * DM * 2;
constexpr size_t WS_WO  = WS_WAB + (size_t)DM * DM * 2;
constexpr size_t WS_CB  = WS_WO + (size_t)DM * DM * 2;
constexpr size_t WS_UU  = WS_CB + (size_t)MPAD * 2048 * 2;
constexpr size_t WS_Q   = WS_UU + (size_t)MPAD * 2048 * 2;
constexpr size_t WS_K   = WS_Q + (size_t)MPAD * 2048 * 2;
constexpr size_t WS_VT  = WS_K + (size_t)MPAD * 512 * 2;
constexpr size_t WS_RAT = WS_VT + (size_t)MPAD * 512 * 2;
constexpr size_t WS_SGB = WS_RAT + (size_t)MPAD * DM * 2;
constexpr size_t WS_AO  = WS_SGB + (size_t)MPAD * DM * 2;
constexpr size_t WS_MG  = WS_AO + (size_t)MPAD * DM * 2;
constexpr size_t WS_A_END = WS_MG + (size_t)MPAD * DM * 2;
constexpr size_t WS_G   = WS_A;
constexpr size_t WS_U   = WS_G + (size_t)MPAD * DFF * 2;
constexpr size_t WS_F   = WS_U + (size_t)MPAD * DFF * 2;
constexpr size_t WS_OV_END = WS_F + (size_t)MPAD * DFF * 2;
constexpr size_t WS_END = WS_A_END > WS_OV_END ? WS_A_END : WS_OV_END;
constexpr int CW_BAR = 4096;
static_assert((CW_BAR + XCD_BAR_WORDS) * 4 <= (int)CTL_ZERO_BYTES, "control words inside the memset region");

constexpr int RING_OFF = 0, RING_BYTES = 131072;
constexpr int LDSCTL_OFF = RING_BYTES, MISC_OFF = LDSCTL_OFF + 320;
constexpr int LDS_BYTES = 147456;
static_assert(MISC_OFF + 128 <= LDS_BYTES, "LDS map");
constexpr int BIAS_LD = 132;
constexpr int SCR_OFF = 20480, SCR_WAVE = 4096;

typedef float f32x16 __attribute__((ext_vector_type(16)));
typedef short s16x4 __attribute__((ext_vector_type(4)));
typedef unsigned v2u __attribute__((ext_vector_type(2)));
__device__ __forceinline__ float blo(unsigned w) { return __uint_as_float(w << 16); }
__device__ __forceinline__ float bhi(unsigned w) { return __uint_as_float(w & 0xffff0000u); }
__device__ __forceinline__ void unpack8(const v4u w, float (&f)[8]) { f[0] = blo(w.x); f[1] = bhi(w.x); f[2] = blo(w.y); f[3] = bhi(w.y); f[4] = blo(w.z); f[5] = bhi(w.z); f[6] = blo(w.w); f[7] = bhi(w.w); }
__device__ __forceinline__ v4u ldg16(const void* p) { return *(const GAS v4u*)p; }
__device__ __forceinline__ f32x4 ldg4f(const float* p) { return *(const GAS f32x4*)p; }
__device__ __forceinline__ void ld8f(const float* p, float (&f)[8]) { const f32x4 a = ldg4f(p), b = ldg4f(p + 4); f[0] = a[0]; f[1] = a[1]; f[2] = a[2]; f[3] = a[3]; f[4] = b[0]; f[5] = b[1]; f[6] = b[2]; f[7] = b[3]; }
__device__ __forceinline__ void st8f(float* p, const float (&f)[8]) { *(GAS f32x4*)p = (f32x4){f[0], f[1], f[2], f[3]}; *(GAS f32x4*)(p + 4) = (f32x4){f[4], f[5], f[6], f[7]}; }
__device__ __forceinline__ unsigned cvtpk(float lo, float hi) { return pg8::cvt_pk_bf16(lo, hi); }
__device__ __forceinline__ float ex2(float x) { return __builtin_amdgcn_exp2f(x); }
__device__ __forceinline__ float wave_sum(float v) {
#pragma unroll
    for (int o = 1; o < 64; o <<= 1) v += __shfl_xor(v, o);
    return v;
}
__device__ __forceinline__ float wave_max(float v) {
#pragma unroll
    for (int o = 1; o < 64; o <<= 1) v = fmaxf(v, __shfl_xor(v, o));
    return v;
}

__device__ __forceinline__ void p0_item(const float* src, int N, bf16* dst, int pitch, LAS float* scr, int lane) {
#pragma unroll 8
    for (int i = 0; i < 32; ++i) { const int kk = 2 * i + (lane >> 5); scr[kk * 33 + (lane & 31)] = *(const GAS float*)(src + (size_t)kk * N + (lane & 31)); }
    LDS_WAIT(); asm volatile("" ::: "memory");
    const int c = lane & 7;
#pragma unroll
    for (int j = 0; j < 4; ++j) { const int n = (lane >> 3) + 8 * j; const LAS float* s = scr + (8 * c) * 33 + n;
        v4u o; o.x = pk2(s[0 * 33], s[1 * 33]); o.y = pk2(s[2 * 33], s[3 * 33]); o.z = pk2(s[4 * 33], s[5 * 33]); o.w = pk2(s[6 * 33], s[7 * 33]);
        *(GAS v4u*)(dst + (size_t)n * pitch + 8 * c) = o; }
    LDS_WAIT(); asm volatile("" ::: "memory");
}
__host__ __device__ __forceinline__ int win_map(int n) {
    if (n < 2048) return n;
    if (n < 6144) { int t = n - 2048; const int h = t >= 2048 ? 1 : 0; t -= h * 2048; return 2048 + (t >> 7) * 256 + h * 128 + (t & 127); }
    if (n < 9216) return n;
    int t = n - 9216; const int h = t >= 4096 ? 1 : 0; t -= h * 4096; return 9216 + (t >> 7) * 256 + h * 128 + (t & 127);
}
template <bool OUT_BF16> __device__ __forceinline__ void rms_row(const float* xrow, const float* g, void* orow, int lane) {
    const GAS f32x4* xr = (const GAS f32x4*)xrow + lane;
    f32x4 v[16]; float s = 0.f;
#pragma unroll
    for (int j = 0; j < 16; ++j) { v[j] = xr[64 * j]; s += (v[j].x * v[j].x + v[j].y * v[j].y) + (v[j].z * v[j].z + v[j].w * v[j].w); }
    const float r = 1.0f / sqrtf(wave_sum(s) * (1.0f / DM) + EPS);
    const GAS f32x4* gr = (const GAS f32x4*)g + lane;
#pragma unroll
    for (int j = 0; j < 16; ++j) { const f32x4 gv = gr[64 * j]; const f32x4 y = (v[j] * r) * gv;
        if (OUT_BF16) { v2u w; w.x = cvtpk(y.x, y.y); w.y = cvtpk(y.z, y.w); ((GAS v2u*)orow)[lane + 64 * j] = w; }
        else ((GAS f32x4*)orow)[lane + 64 * j] = y; }
}

__device__ __forceinline__ int crow(int r, int hi) { return (r & 3) + 8 * (r >> 2) + 4 * hi; }
__device__ __forceinline__ void attn_prompt_task(int t, const bf16* Q, const bf16* KB, const bf16* VT, bf16* AO, const float* sinks, const LAS float* biasT, int lane) {
    const int g = t & 3, i32 = (t >> 2) & 63, kvh = (t >> 8) & 7, b = t >> 11, head = kvh * 4 + g;
    const int r32 = lane & 31, hi = lane >> 5;
    const int rowbase = b * SEQ, t0 = i32 * 32;
    const int kb_lo = (t0 >= 128) ? 0 : ((128 - t0) >> 5);
    bf16x8 qf[4];
    { const bf16* qp = Q + (size_t)(rowbase + t0 + r32) * 2048 + head * 64 + hi * 8;
#pragma unroll
      for (int ks = 0; ks < 4; ++ks) qf[ks] = *(const GAS bf16x8*)(qp + ks * 16); }
    f32x16 s[5];
#pragma unroll
    for (int kb = 0; kb < 5; ++kb) {
#pragma unroll
        for (int r = 0; r < 16; ++r) s[kb][r] = 0.f;
        if (kb >= kb_lo) {
            const bf16* kp = KB + (size_t)(rowbase + t0 - 128 + 32 * kb + r32) * KVW + kvh * 64 + hi * 8;
            bf16x8 kf[4];
#pragma unroll
            for (int ks = 0; ks < 4; ++ks) kf[ks] = *(const GAS bf16x8*)(kp + ks * 16);
#pragma unroll
            for (int ks = 0; ks < 4; ++ks) s[kb] = __builtin_amdgcn_mfma_f32_32x32x16_bf16(kf[ks], qf[ks], s[kb], 0, 0, 0);
        }
    }
    const LAS float* bt = biasT + head * BIAS_LD;
    const float sink = *(const GAS float*)(sinks + head);
    float mx = sink;
#pragma unroll
    for (int kb = 0; kb < 5; ++kb)
#pragma unroll
        for (int r = 0; r < 16; ++r) {
            const int dist = r32 + 128 - 32 * kb - crow(r, hi);
            const bool valid = (kb >= kb_lo) && dist >= 0 && dist <= 128;
            const int dc = dist < 0 ? 0 : (dist > 128 ? 128 : dist);
            float v = s[kb][r] * 0.125f + bt[dc];
            v = valid ? v : -INFINITY;
            s[kb][r] = v; mx = fmaxf(mx, v);
        }
    mx = fmaxf(mx, __shfl_xor(mx, 32));
    float sum = 0.f;
#pragma unroll
    for (int kb = 0; kb < 5; ++kb)
#pragma unroll
        for (int r = 0; r < 16; ++r) { const float e = ex2((s[kb][r] - mx) * LOG2E); s[kb][r] = e; sum += e; }
    sum += __shfl_xor(sum, 32);
    const float inv = 1.0f / (sum + ex2((sink - mx) * LOG2E));
    f32x16 o[2];
#pragma unroll
    for (int r = 0; r < 16; ++r) { o[0][r] = 0.f; o[1][r] = 0.f; }
#pragma unroll
    for (int kb = 0; kb < 5; ++kb) if (kb >= kb_lo) {
#pragma unroll
        for (int sx = 0; sx < 2; ++sx) {
            v4u pw; pw.x = cvtpk(s[kb][8 * sx + 0], s[kb][8 * sx + 1]); pw.y = cvtpk(s[kb][8 * sx + 2], s[kb][8 * sx + 3]); pw.z = cvtpk(s[kb][8 * sx + 4], s[kb][8 * sx + 5]); pw.w = cvtpk(s[kb][8 * sx + 6], s[kb][8 * sx + 7]);
            const bf16x8 pb = __builtin_bit_cast(bf16x8, pw);
            const int tk = rowbase + t0 - 128 + 32 * kb + 16 * sx;
#pragma unroll
            for (int db = 0; db < 2; ++db) {
                const bf16* vp = VT + (size_t)(kvh * 64 + db * 32 + r32) * MPAD + tk + 4 * hi;
                const v2u lo = *(const GAS v2u*)vp, hh = *(const GAS v2u*)(vp + 8);
                v4u vw; vw.x = lo.x; vw.y = lo.y; vw.z = hh.x; vw.w = hh.y;
                o[db] = __builtin_amdgcn_mfma_f32_32x32x16_bf16(__builtin_bit_cast(bf16x8, vw), pb, o[db], 0, 0, 0);
            }
        }
    }
    bf16* op = AO + (size_t)(rowbase + t0 + r32) * 4096 + 2048 + head * 64 + 4 * hi;
#pragma unroll
    for (int db = 0; db < 2; ++db)
#pragma unroll
        for (int rg = 0; rg < 4; ++rg) { v2u w; w.x = cvtpk(o[db][4 * rg] * inv, o[db][4 * rg + 1] * inv); w.y = cvtpk(o[db][4 * rg + 2] * inv, o[db][4 * rg + 3] * inv);
            *(GAS v2u*)(op + db * 32 + 8 * rg) = w; }
}
__device__ __forceinline__ void attn_sample_task(int t, const bf16* Q, const float* sk, const float* sv, float* out, bf16* AO, const float* sinks, const LAS float* biasT, LAS float* sc, int lane) {
    const int kvh = t & 7, b = t >> 3;
    const int kq = lane >> 4, d4 = lane & 15;
    float qv[4][4];
#pragma unroll
    for (int g = 0; g < 4; ++g) { const v2u w = *(const GAS v2u*)(Q + (size_t)(ROWS_P + b) * 2048 + (kvh * 4 + g) * 64 + 4 * d4);
        qv[g][0] = blo(w.x) * 0.125f; qv[g][1] = bhi(w.x) * 0.125f; qv[g][2] = blo(w.y) * 0.125f; qv[g][3] = bhi(w.y) * 0.125f; }
    const size_t woff = (size_t)b * 128 * 512 + kvh * 64 + 4 * d4;
    for (int i = 0; i < 33; ++i) { const int j = 4 * i + kq;
        f32x4 kv = (f32x4){0.f, 0.f, 0.f, 0.f};
        if (j < 128) kv = ldg4f(sk + woff + (size_t)j * 512); else if (j == 128) kv = ldg4f(out + O_SK + woff + (size_t)127 * 512);
        if (j >= 1 && j < 128) *(GAS f32x4*)(out + O_SK + woff + (size_t)(j - 1) * 512) = kv;
#pragma unroll
        for (int g = 0; g < 4; ++g) { float p = (qv[g][0] * kv[0] + qv[g][1] * kv[1]) + (qv[g][2] * kv[2] + qv[g][3] * kv[3]);
            p += __shfl_xor(p, 1); p += __shfl_xor(p, 2); p += __shfl_xor(p, 4); p += __shfl_xor(p, 8);
            if (d4 == 0 && j <= 128) sc[g * BIAS_LD + j] = p + biasT[(kvh * 4 + g) * BIAS_LD + (128 - j)]; }
    }
    asm volatile("s_waitcnt lgkmcnt(0)" ::: "memory");
    float inv[4];
#pragma unroll
    for (int g = 0; g < 4; ++g) {
        const float sink = *(const GAS float*)(sinks + kvh * 4 + g);
        const float v0 = sc[g * BIAS_LD + lane], v1 = sc[g * BIAS_LD + 64 + lane], v2 = (lane == 0) ? sc[g * BIAS_LD + 128] : -INFINITY;
        const float m = fmaxf(wave_max(fmaxf(fmaxf(v0, v1), v2)), sink);
        const float e0 = ex2((v0 - m) * LOG2E), e1 = ex2((v1 - m) * LOG2E), e2 = (lane == 0) ? ex2((v2 - m) * LOG2E) : 0.f;
        inv[g] = 1.0f / (wave_sum(e0 + e1 + e2) + ex2((sink - m) * LOG2E));
        sc[g * BIAS_LD + lane] = e0; sc[g * BIAS_LD + 64 + lane] = e1; if (lane == 0) sc[g * BIAS_LD + 128] = e2;
    }
    asm volatile("s_waitcnt lgkmcnt(0)" ::: "memory");
    float acc[4][4];
#pragma unroll
    for (int g = 0; g < 4; ++g)
#pragma unroll
        for (int e = 0; e < 4; ++e) acc[g][e] = 0.f;
    for (int i = 0; i < 33; ++i) { const int j = 4 * i + kq;
        f32x4 vv = (f32x4){0.f, 0.f, 0.f, 0.f};
        if (j < 128) vv = ldg4f(sv + woff + (size_t)j * 512); else if (j == 128) vv = ldg4f(out + O_SV + woff + (size_t)127 * 512);
        if (j >= 1 && j < 128) *(GAS f32x4*)(out + O_SV + woff + (size_t)(j - 1) * 512) = vv;
        if (j <= 128) {
#pragma unroll
            for (int g = 0; g < 4; ++g) { const float p = sc[g * BIAS_LD + j];
#pragma unroll
                for (int e = 0; e < 4; ++e) acc[g][e] += p * vv[e]; }
        }
    }
#pragma unroll
    for (int g = 0; g < 4; ++g)
#pragma unroll
        for (int e = 0; e < 4; ++e) { acc[g][e] += __shfl_xor(acc[g][e], 16); acc[g][e] += __shfl_xor(acc[g][e], 32); }
    if (kq == 0) {
#pragma unroll
        for (int g = 0; g < 4; ++g) { v2u w; w.x = cvtpk(acc[g][0] * inv[g], acc[g][1] * inv[g]); w.y = cvtpk(acc[g][2] * inv[g], acc[g][3] * inv[g]);
            *(GAS v2u*)(AO + (size_t)(ROWS_P + b) * 4096 + 2048 + (kvh * 4 + g) * 64 + 4 * d4) = w; }
    }
    asm volatile("s_waitcnt lgkmcnt(0)" ::: "memory");
}
__device__ __forceinline__ void conv_row(int row, const bf16* CB, const bf16* UU, bf16* AO, const float* cw, const float* st, float* out, int lane) {
    const bool samp = row >= ROWS_P; const int tl = row & (SEQ - 1);
#pragma unroll
    for (int j = 0; j < 4; ++j) { const int c = 8 * lane + 512 * j;
        float u0[8], u1[8], u2[8], cbv[8], w0[8], w1[8], w2[8];
        unpack8(ldg16(UU + (size_t)row * 2048 + c), u0); unpack8(ldg16(CB + (size_t)row * 2048 + c), cbv);
        if (!samp) {
            if (tl >= 1) unpack8(ldg16(UU + (size_t)(row - 1) * 2048 + c), u1); else {
#pragma unroll
                for (int e = 0; e < 8; ++e) u1[e] = 0.f; }
            if (tl >= 2) unpack8(ldg16(UU + (size_t)(row - 2) * 2048 + c), u2); else {
#pragma unroll
                for (int e = 0; e < 8; ++e) u2[e] = 0.f; }
        } else { const int b = row - ROWS_P; ld8f(st + ((size_t)b * 2 + 0) * 2048 + c, u2); ld8f(st + ((size_t)b * 2 + 1) * 2048 + c, u1); st8f(out + O_SC + ((size_t)b * 2 + 0) * 2048 + c, u1); }
        ld8f(cw + c, w0); ld8f(cw + 2048 + c, w1); ld8f(cw + 4096 + c, w2);
        float a[8];
#pragma unroll
        for (int e = 0; e < 8; ++e) a[e] = cbv[e] * ((w0[e] * u2[e] + w1[e] * u1[e]) + w2[e] * u0[e]);
        v4u w; w.x = cvtpk(a[0], a[1]); w.y = cvtpk(a[2], a[3]); w.z = cvtpk(a[4], a[5]); w.w = cvtpk(a[6], a[7]);
        *(GAS v4u*)(AO + (size_t)row * 4096 + c) = w; }
}
__device__ __forceinline__ void ffn_act_row(int row, const bf16* G, const bf16* U, bf16* F, const float* cw, const float* cbias, const float* st, float* out, int lane) {
    const bool samp = row >= ROWS_P; const int tl = row & (SEQ - 1);
    for (int c8 = lane; c8 < DFF / 8; c8 += 64) { const int c = 8 * c8;
        float g0[8], g1[8], g2[8], uv[8], w0[8], w1[8], w2[8], bb[8];
        unpack8(ldg16(G + (size_t)row * DFF + c), g0); unpack8(ldg16(U + (size_t)row * DFF + c), uv);
        if (!samp) {
            if (tl >= 1) unpack8(ldg16(G + (size_t)(row - 1) * DFF + c), g1); else {
#pragma unroll
                for (int e = 0; e < 8; ++e) g1[e] = 0.f; }
            if (tl >= 2) unpack8(ldg16(G + (size_t)(row - 2) * DFF + c), g2); else {
#pragma unroll
                for (int e = 0; e < 8; ++e) g2[e] = 0.f; }
        } else { const int b = row - ROWS_P; ld8f(st + ((size_t)b * 2 + 0) * DFF + c, g2); ld8f(st + ((size_t)b * 2 + 1) * DFF + c, g1); st8f(out + O_SF + ((size_t)b * 2 + 0) * DFF + c, g1); }
        ld8f(cw + c, w0); ld8f(cw + DFF + c, w1); ld8f(cw + 2 * DFF + c, w2); ld8f(cbias + c, bb);
        float f[8];
#pragma unroll
        for (int e = 0; e < 8; ++e) { const float gc = ((w0[e] * g2[e] + w1[e] * g1[e]) + w2[e] * g0[e]) + bb[e];
            f[e] = gc * __builtin_amdgcn_rcpf(1.0f + ex2(-gc * LOG2E)) * uv[e]; }
        v4u w; w.x = cvtpk(f[0], f[1]); w.y = cvtpk(f[2], f[3]); w.z = cvtpk(f[4], f[5]); w.w = cvtpk(f[6], f[7]);
        *(GAS v4u*)(F + (size_t)row * DFF + c) = w; }
}

#ifndef PH_MASK
#define PH_MASK 0x3ff
#endif
#define PH(k) ((PH_MASK >> (k)) & 1)
struct Args { const float* in[21]; float* out; unsigned char* ws; };
__global__ void __launch_bounds__(NWAVES * 64, 2) mega_fwd(Args args) {
    extern __shared__ __attribute__((aligned(16))) unsigned char lds[];
    LAS unsigned char* L = (LAS unsigned char*)lds;
    volatile LAS unsigned* MISC = (volatile LAS unsigned*)(L + MISC_OFF);
    const int tid = threadIdx.x, lane = tid & 63, wave = __builtin_amdgcn_readfirstlane(tid >> 6);
    const int G = gridDim.x, bx = blockIdx.x;
    const int vcu = (G % 8 == 0) ? (bx % 8) * (G / 8) + bx / 8 : bx;
    const int gw = vcu * NWAVES + wave, NGW = G * NWAVES;
    unsigned char* ws = args.ws; float* out = args.out;
#define INP(k) (args.in[k])
#define WSB(off) ((bf16*)(ws + (off)))
    gu32* ctl = (gu32*)(ws + WS_CTL);
    for (int u = tid; u < (LDS_BYTES - LDSCTL_OFF) / 4; u += NWAVES * 64) ((LAS unsigned*)(L + LDSCTL_OFF))[u] = 0u;
    __syncthreads();
    XcdBarrier bar = xcd_barrier_post((unsigned*)(ctl + CW_BAR), MISC + 8);

    if (PH(0)) {
        LAS float* scr = (LAS float*)(L + RING_OFF + wave * 16384);
        constexpr int I0 = 64 * 544, I1 = 32 * 128, I3 = 64 * 128, I4 = 64 * 344, I6 = 172 * 128;
        constexpr int NITEMS = I0 + 2 * I1 + I3 + 2 * I4 + I6;
        for (int it = gw; it < NITEMS; it += NGW) {
            int r = it;
            if (r < I0) { const int kb = r / 544, nb = r % 544; p0_item(INP(7) + (size_t)(64 * kb) * INW + 32 * nb, INW, WSB(WS_WIN) + (size_t)win_map(32 * nb) * DM + 64 * kb, DM, scr, lane); continue; } r -= I0;
            if (r < I1) { const int kb = r / 128, nb = r % 128; p0_item(INP(9) + (size_t)(64 * kb) * DM + 32 * nb, DM, WSB(WS_WAB) + (size_t)(32 * nb) * DM + 64 * kb, DM, scr, lane); continue; } r -= I1;
            if (r < I1) { const int kb = r / 128, nb = r % 128; p0_item(INP(10) + (size_t)(64 * kb) * DM + 32 * nb, DM, WSB(WS_WAB) + (size_t)(32 * nb) * DM + 2048 + 64 * kb, DM, scr, lane); continue; } r -= I1;
            if (r < I3) { const int kb = r / 128, nb = r % 128; p0_item(INP(12) + (size_t)(64 * kb) * DM + 32 * nb, DM, WSB(WS_WO) + (size_t)(32 * nb) * DM + 64 * kb, DM, scr, lane); continue; } r -= I3;
            if (r < I4) { const int kb = r / 344, nb = r % 344; p0_item(INP(14) + (size_t)(64 * kb) * DFF + 32 * nb, DFF, WSB(WS_WGU) + (size_t)(32 * nb) * DM + 64 * kb, DM, scr, lane); continue; } r -= I4;
            if (r < I4) { const int kb = r / 344, nb = r % 344; p0_item(INP(15) + (size_t)(64 * kb) * DFF + 32 * nb, DFF, WSB(WS_WGU) + (size_t)(DFF + 32 * nb) * DM + 64 * kb, DM, scr, lane); continue; } r -= I4;
            { const int kb = r / 128, nb = r % 128; p0_item(INP(18) + (size_t)(64 * kb) * DM + 32 * nb, DM, WSB(WS_WD) + (size_t)(32 * nb) * DFF + 64 * kb, DFF, scr, lane); }
        }
        for (int m = gw; m < MPAD; m += NGW) {
            if (m < ROWS_R) rms_row<true>(m < ROWS_P ? INP(0) + (size_t)m * DM : INP(1) + (size_t)(m - ROWS_P) * DM, INP(6), WSB(WS_XN) + (size_t)m * DM, lane);
            else {
#pragma unroll
                for (int j = 0; j < 8; ++j) ((GAS v4u*)(WSB(WS_XN) + (size_t)m * DM))[lane + 64 * j] = (v4u){0u, 0u, 0u, 0u}; }
        }
    }
    xcd_barrier(bar);

    if (PH(1)) {
        pg8::Gemm g{WSB(WS_XN), WSB(WS_WIN), MPAD, INW, DM}; pg8::StaticOrder S; S.init(MPAD, INW, G, bx);
        pg8::EpiProj E{WSB(WS_CB), WSB(WS_UU), WSB(WS_Q), WSB(WS_K), WSB(WS_VT), WSB(WS_RAT), WSB(WS_SGB), out};
        pg8::gemm_phase<pg8::EpiProj, pg8::StaticOrder, true, true>(L + RING_OFF, g, S, E);
    }
    xcd_barrier(bar);

    if (PH(2)) {
        LAS float* biasT = (LAS float*)(L + RING_OFF);
        for (int i = tid; i < 32 * 129; i += NWAVES * 64) { const int h = i / 129, d = i - h * 129;
            int bk = d;
            if (d >= 16) { bk = 16 + (int)(log2f((float)d * 0.0625f) * (16.0f / 3.0f)); bk = bk > 31 ? 31 : bk; }
            biasT[h * BIAS_LD + d] = *(const GAS float*)(INP(19) + bk * 32 + h); }
        __syncthreads();
        LAS float* sc = (LAS float*)(L + SCR_OFF + wave * SCR_WAVE);
        for (int t = gw; t < 4 * 8 * 64 * 4; t += NGW) attn_prompt_task(t, WSB(WS_Q), WSB(WS_K), WSB(WS_VT), WSB(WS_AO), INP(11), biasT, lane);
        for (int t = NGW - 1 - gw; t < 128 * 8; t += NGW) attn_sample_task(t, WSB(WS_Q), INP(2), INP(3), out, WSB(WS_AO), INP(11), biasT, sc, lane);
        for (int m = gw; m < ROWS_R; m += NGW) conv_row(m, WSB(WS_CB), WSB(WS_UU), WSB(WS_AO), INP(8), INP(4), out, lane);
    }
    xcd_barrier(bar);

    if (PH(3)) {
        pg8::Gemm g{WSB(WS_AO), WSB(WS_WAB), MPAD, DM, DM}; pg8::StaticOrder S; S.init(MPAD, DM, G, bx);
        pg8::EpiMerged E{WSB(WS_RAT), WSB(WS_SGB), WSB(WS_MG)};
        pg8::gemm_phase<pg8::EpiMerged, pg8::StaticOrder, true, true>(L + RING_OFF, g, S, E);
    }
    xcd_barrier(bar);

    if (PH(4)) {
        pg8::Gemm g{WSB(WS_MG), WSB(WS_WO), MPAD, DM, DM}; pg8::StaticOrder S; S.init(MPAD, DM, G, bx);
        pg8::EpiResid E{INP(0), INP(1), ((float*)(ws + WS_X1))};
        pg8::gemm_phase<pg8::EpiResid, pg8::StaticOrder, true, true>(L + RING_OFF, g, S, E);
    }
    xcd_barrier(bar);

    if (PH(5)) for (int m = gw; m < ROWS_R; m += NGW) rms_row<true>(((float*)(ws + WS_X1)) + (size_t)m * DM, INP(13), WSB(WS_XN) + (size_t)m * DM, lane);
    xcd_barrier(bar);

    if (PH(6)) {
        pg8::Gemm g{WSB(WS_XN), WSB(WS_WGU), MPAD, 2 * DFF, DM}; pg8::StaticOrder S; S.init(MPAD, 2 * DFF, G, bx);
        pg8::EpiGateUp E{WSB(WS_G), WSB(WS_U), out};
        pg8::gemm_phase<pg8::EpiGateUp, pg8::StaticOrder, true, true>(L + RING_OFF, g, S, E);
    }
    xcd_barrier(bar);

    if (PH(7)) for (int m = gw; m < ROWS_R; m += NGW) ffn_act_row(m, WSB(WS_G), WSB(WS_U), WSB(WS_F), INP(16), INP(17), INP(5), out, lane);
    xcd_barrier(bar);

    if (PH(8)) {
        pg8::Gemm g{WSB(WS_F), WSB(WS_WD), MPAD, DM, DFF}; pg8::StaticOrder S; S.init(MPAD, DM, G, bx);
        pg8::EpiResid E{((float*)(ws + WS_X1)), ((float*)(ws + WS_X1)) + (size_t)ROWS_P * DM, ((float*)(ws + WS_X1))};
        pg8::gemm_phase<pg8::EpiResid, pg8::StaticOrder, true, true>(L + RING_OFF, g, S, E);
    }
    xcd_barrier(bar);

    if (PH(9)) for (int m = gw; m < ROWS_R; m += NGW) rms_row<false>(((float*)(ws + WS_X1)) + (size_t)m * DM, INP(20), m < ROWS_P ? out + O_YP + (size_t)m * DM : out + O_YS + (size_t)(m - ROWS_P) * DM, lane);
}

extern "C" void kernel_launch(void* const* d_in, const int* in_sizes, int n_in, void* d_out, int out_size, void* d_ws, size_t ws_size, hipStream_t stream) {
    static int grid = 0;
    if (grid == 0) {
        if (n_in != 21 || in_sizes[0] != ROWS_P * DM || (size_t)out_size != O_END || ws_size < WS_END) {
            fprintf(stderr, "kernel_launch: built for 21 inputs, x_prompt of %d floats, %zu outputs, >= %zu bytes of workspace; got n_in %d, in0 %d, out %d, ws %zu; nothing launched\n", ROWS_P * DM, (size_t)O_END, (size_t)WS_END, n_in, n_in > 0 ? in_sizes[0] : -1, out_size, ws_size);
            grid = -1; return; }
        int dev = 0, cus = 0, per_cu = 0;
        if (hipGetDevice(&dev) != hipSuccess || hipDeviceGetAttribute(&cus, hipDeviceAttributeMultiprocessorCount, dev) != hipSuccess) { fprintf(stderr, "kernel_launch: hipGetDevice / hipDeviceGetAttribute failed; nothing launched\n"); grid = -1; return; }
        if (hipFuncSetAttribute((const void*)mega_fwd, hipFuncAttributeMaxDynamicSharedMemorySize, LDS_BYTES) != hipSuccess) { fprintf(stderr, "kernel_launch: hipFuncSetAttribute failed; nothing launched\n"); grid = -1; return; }
        if (hipOccupancyMaxActiveBlocksPerMultiprocessor(&per_cu, (const void*)mega_fwd, NWAVES * 64, LDS_BYTES) != hipSuccess || per_cu < 1)
            fprintf(stderr, "kernel_launch: note: the occupancy query reports %d workgroups per CU\n", per_cu);
        (void)hipGetLastError();
        grid = cus;
    }
    if (grid < 0) return;
    if (hipMemsetAsync((char*)d_ws + WS_CTL, 0, CTL_ZERO_BYTES, stream) != hipSuccess) { fprintf(stderr, "kernel_launch: hipMemsetAsync failed; nothing launched\n"); return; }
    Args a{};
    for (int i = 0; i < 21; ++i) a.in[i] = (const float*)d_in[i];
    a.out = (float*)d_out; a.ws = (unsigned char*)d_ws;
    hipLaunchKernelGGL(mega_fwd, dim3(grid), dim3(NWAVES * 64), LDS_BYTES, stream, a);
    const hipError_t le = hipPeekAtLastError();
    if (le != hipSuccess) fprintf(stderr, "kernel_launch: launch failed: %s (grid %d x %d threads, %d B LDS)\n", hipGetErrorName(le), grid, NWAVES * 64, LDS_BYTES);
}
```

```cpp
#include <hip/hip_runtime.h>
#include <cstdio>
#include <cstdint>
#include <cmath>
namespace pg8 {
#define PG8_LAS __attribute__((address_space(3)))
typedef unsigned short bf16_t;
typedef short bf16x8 __attribute__((ext_vector_type(8)));
typedef float f32x4 __attribute__((ext_vector_type(4)));
typedef unsigned u32x4 __attribute__((ext_vector_type(4)));
constexpr int BM = 256, BK = 64, HALF = 128, HTB = HALF * BK * 2  , STAGE_BYTES = 8 * HTB, NXCD = 8, WGM = 8;

__host__ __device__ __forceinline__ int lds_byte(int r, int c) { const int st = (r >> 4) * 2 + (c >> 5), rr = r & 15, cc = c & 31, ob = rr * 64 + cc * 2; return st * 1024 + (ob ^ (((ob >> 9) & 1) << 5)); }
__host__ __device__ __forceinline__ void stage_rc(int b, int& R, int& C) { const int st = b / 1024, sb = b % 1024, swz = sb ^ (((sb >> 9) & 1) << 5); R = (st >> 1) * 16 + swz / 64; C = (st & 1) * 32 + (swz % 64) / 2; }
__host__ __device__ __forceinline__ int perm32(int rho) { const int n = rho >> 4, i = rho & 15; return 8 * (i >> 2) + 4 * n + (i & 3); }

struct Unit { int pm, pn, kn; };
struct Gemm { const bf16_t* A; const bf16_t* Bt; int M, N, K; };

struct StaticOrder {
    int nM, nN, nwg, G, c;
    __host__ __device__ void init(int M, int N, int G_, int c_) { nM = M / BM; nN = N / BM; nwg = nM * nN; G = G_; c = c_; }
    __host__ __device__ bool next(int i, Unit& u) const {
        const long L = (long)i * G + c; if (L >= nwg) return false;
        int wgid = (int)L; { const int q = nwg / NXCD, r = nwg % NXCD, xcd = wgid % NXCD, off = wgid / NXCD; wgid = (xcd < r ? xcd * (q + 1) : r * (q + 1) + (xcd - r) * q) + off; }
        const int nig = WGM * nN, gid = wgid / nig, fm = gid * WGM, gsz = (nM - fm) < WGM ? (nM - fm) : WGM;
        u.pm = fm + ((wgid % nig) % gsz); u.pn = (wgid % nig) / gsz; return true;
    }
    __device__ __forceinline__ void a_ready(const Unit&) const {}
    __device__ __forceinline__ void done(const Unit&) const {}
};

__device__ __forceinline__ unsigned cvt_pk_bf16(float lo, float hi) { unsigned r; asm volatile("v_cvt_pk_bf16_f32 %0, %1, %2" : "=v"(r) : "v"(lo), "v"(hi)); return r; }
typedef float f32x2 __attribute__((ext_vector_type(2)));

#define PG8_GAS __attribute__((address_space(1)))
constexpr int ROWS_P = 8192, ROWS_R = 8320, ROWS_PAD = 8448, PAN_S = 32;
constexpr size_t O_YP = 0, O_YS = 33554432, O_PK = 34078720, O_PV = 34340864, O_PC = 34603008, O_PF = 34619392, O_SK = 34707456, O_SV = 43096064, O_SC = 51484672, O_SF = 52008960, O_END = 54827008;

__device__ __forceinline__ u32x4 pack8(const f32x4 a, const f32x4 b) { u32x4 w; w.x = cvt_pk_bf16(a[0], a[1]); w.y = cvt_pk_bf16(a[2], a[3]); w.z = cvt_pk_bf16(b[0], b[1]); w.w = cvt_pk_bf16(b[2], b[3]); return w; }
__device__ __forceinline__ float bf_lo(unsigned w) { return __uint_as_float(w << 16); }
__device__ __forceinline__ float bf_hi(unsigned w) { return __uint_as_float(w & 0xffff0000u); }
__device__ __forceinline__ void st16(void* p, u32x4 v) { *(PG8_GAS u32x4*)p = v; }
__device__ __forceinline__ void st16f(float* p, f32x4 v) { *(PG8_GAS f32x4*)p = v; }
__device__ __forceinline__ u32x4 ld16(const void* p) { return *(const PG8_GAS u32x4*)p; }
__device__ __forceinline__ f32x4 ld16f(const float* p) { return *(const PG8_GAS f32x4*)p; }
__device__ __forceinline__ u32x4 ld16nt(const void* p) { return __builtin_nontemporal_load((const PG8_GAS u32x4*)p); }
__device__ __forceinline__ f32x4 ld16fnt(const float* p) { return __builtin_nontemporal_load((const PG8_GAS f32x4*)p); }
__device__ __forceinline__ void st16nt(void* p, u32x4 v) { __builtin_nontemporal_store(v, (PG8_GAS u32x4*)p); }
__device__ __forceinline__ float fast_exp(float x) { return __builtin_amdgcn_exp2f(x * 1.4426950408889634f); }

struct EpiProj {
    static constexpr bool PERM = true, AFTER_DRAIN = false, MIDK = false;
    bf16_t *CB, *UU, *Q, *KB, *VT, *RAT, *SGB; float* out; PG8_LAS bf16_t* vt_lds;
    __device__ __forceinline__ void mid(f32x4 (&)[2][2][4][2], const Unit&, int, int, int, int) const {}
    __device__ __forceinline__ void operator()(const f32x4 (&acc)[2][2][4][2], const Unit& u, int wr, int wc, int fr, int fq) const {
        const int pn = u.pn, pm = u.pm;
        const int rbase = pm * BM + wr * 64 + fr;
        const int cl = wc * 32 + 8 * fq;
        const int nai = (pm == PAN_S) ? 1 : 2;
        const bool winp = ((pm & 7) == 7) && (pm < PAN_S);
        if (pn < 8 || (pn >= 24 && pn < 34)) {
            bf16_t* base; int ld, c0;
            if (pn < 8) { base = CB; ld = 2048; c0 = pn * 256; }
            else if (pn < 32) { base = Q; ld = 2048; c0 = (pn - 24) * 256; }
            else { base = KB; ld = 512; c0 = (pn - 32) * 256; }
#pragma unroll
            for (int ai = 0; ai < 2; ++ai) if (ai < nai)
#pragma unroll
                for (int m = 0; m < 4; ++m) { const int row = rbase + ai * HALF + m * 16;
#pragma unroll
                    for (int bj = 0; bj < 2; ++bj) st16nt(base + (size_t)row * ld + c0 + bj * HALF + cl, pack8(acc[ai][bj][m][0], acc[ai][bj][m][1])); }
            if (pn >= 32) {
                if (pm == PAN_S) {
#pragma unroll
                    for (int m = 0; m < 4; ++m) { const int b = rbase + m * 16 - ROWS_P;
#pragma unroll
                        for (int bj = 0; bj < 2; ++bj) { float* d = out + O_SK + ((size_t)b * 128 + 127) * 512 + c0 + bj * HALF + cl; st16f(d, acc[0][bj][m][0]); st16f(d + 4, acc[0][bj][m][1]); } }
                } else if (winp) {
#pragma unroll
                    for (int m = 0; m < 4; ++m) { const int row = rbase + HALF + m * 16, b = row >> 11, j = (row & 2047) - 1920;
#pragma unroll
                        for (int bj = 0; bj < 2; ++bj) { float* d = out + O_PK + ((size_t)b * 128 + j) * 512 + c0 + bj * HALF + cl; st16f(d, acc[1][bj][m][0]); st16f(d + 4, acc[1][bj][m][1]); } }
                }
            }
        } else if (pn < 24) {
            const int c0 = (pn - 8) * 128 + cl;
#pragma unroll
            for (int ai = 0; ai < 2; ++ai) if (ai < nai)
#pragma unroll
                for (int m = 0; m < 4; ++m) { const int row = rbase + ai * HALF + m * 16;
                    const f32x4 u0 = acc[ai][0][m][0] * acc[ai][1][m][0], u1 = acc[ai][0][m][1] * acc[ai][1][m][1];
                    st16nt(UU + (size_t)row * 2048 + c0, pack8(u0, u1));
                    if (pm == PAN_S) { float* d = out + O_SC + ((size_t)(row - ROWS_P) * 2 + 1) * 2048 + c0; st16f(d, u0); st16f(d + 4, u1); }
                    else if (winp && ai == 1 && m == 3 && wr == 1 && fr >= 14) { float* d = out + O_PC + ((size_t)(row >> 11) * 2 + (fr - 14)) * 2048 + c0; st16f(d, u0); st16f(d + 4, u1); }
                }
        } else if (pn < 36) {
            const int c0 = (pn - 34) * 256;
            if (pm < PAN_S) {
                PG8_LAS bf16_t* T = vt_lds + (wr * 4 + wc) * 512;
                const int l = fr + 16 * fq, rch = l >> 1, rh = l & 1;
#pragma unroll
                for (int ai = 0; ai < 2; ++ai)
#pragma unroll
                    for (int m = 0; m < 4; ++m)
#pragma unroll
                        for (int bj = 0; bj < 2; ++bj) {
#pragma unroll
                            for (int n = 0; n < 2; ++n) { const f32x4 v = acc[ai][bj][m][n]; const unsigned w0 = cvt_pk_bf16(v[0], v[1]), w1 = cvt_pk_bf16(v[2], v[3]);
                                PG8_LAS bf16_t* t = T + (8 * fq + 4 * n) * 16 + fr;
                                t[0] = (bf16_t)(w0 & 0xffffu); t[16] = (bf16_t)(w0 >> 16); t[32] = (bf16_t)(w1 & 0xffffu); t[48] = (bf16_t)(w1 >> 16); }
                            asm volatile("" ::: "memory");
                            const u32x4 tv = *(const PG8_LAS u32x4*)(T + rch * 16 + 8 * rh);
                            asm volatile("" ::: "memory");
                            st16nt(VT + (size_t)(c0 + bj * HALF + wc * 32 + rch) * ROWS_PAD + pm * BM + ai * HALF + wr * 64 + m * 16 + 8 * rh, tv); }
            }
            if (pm == PAN_S) {
#pragma unroll
                for (int m = 0; m < 4; ++m) { const int b = rbase + m * 16 - ROWS_P;
#pragma unroll
                    for (int bj = 0; bj < 2; ++bj) { float* d = out + O_SV + ((size_t)b * 128 + 127) * 512 + c0 + bj * HALF + cl; st16f(d, acc[0][bj][m][0]); st16f(d + 4, acc[0][bj][m][1]); } }
            } else if (winp) {
#pragma unroll
                for (int m = 0; m < 4; ++m) { const int row = rbase + HALF + m * 16, b = row >> 11, j = (row & 2047) - 1920;
#pragma unroll
                    for (int bj = 0; bj < 2; ++bj) { float* d = out + O_PV + ((size_t)b * 128 + j) * 512 + c0 + bj * HALF + cl; st16f(d, acc[1][bj][m][0]); st16f(d + 4, acc[1][bj][m][1]); } }
            }
        } else {
            const int c0 = (pn - 36) * 128 + cl;
#pragma unroll
            for (int ai = 0; ai < 2; ++ai) if (ai < nai)
#pragma unroll
                for (int m = 0; m < 4; ++m) { const int row = rbase + ai * HALF + m * 16;
                    f32x4 rt[2], sb[2];
#pragma unroll
                    for (int n = 0; n < 2; ++n)
#pragma unroll
                        for (int e = 0; e < 4; ++e) { const float ea = 1.0f + fast_exp(-acc[ai][0][m][n][e]), eb = 1.0f + fast_exp(-acc[ai][1][m][n][e]);
                            sb[n][e] = __builtin_amdgcn_rcpf(eb); rt[n][e] = eb * __builtin_amdgcn_rcpf(ea); }
                    st16nt(RAT + (size_t)row * 4096 + c0, pack8(rt[0], rt[1])); st16nt(SGB + (size_t)row * 4096 + c0, pack8(sb[0], sb[1])); }
        }
    }
};

struct EpiMerged {
    static constexpr bool PERM = true, AFTER_DRAIN = false, MIDK = true;
    const bf16_t *RAT, *SGB; bf16_t* MG;
    __device__ __forceinline__ void scale(f32x4 (&acc)[2][2][4][2], const bf16_t* S, const Unit& u, int wr, int wc, int fr, int fq) const {
        int rbase = u.pm * BM + wr * 64 + fr; const int c0 = u.pn * BM + wc * 32 + 8 * fq, nai = (u.pm == PAN_S) ? 1 : 2;
        asm volatile("" : "+v"(rbase));
        u32x4 r[2][4][2];
#pragma unroll
        for (int ai = 0; ai < 2; ++ai) if (ai < nai)
#pragma unroll
            for (int m = 0; m < 4; ++m)
#pragma unroll
                for (int bj = 0; bj < 2; ++bj) r[ai][m][bj] = ld16nt(S + (size_t)(rbase + ai * HALF + m * 16) * 4096 + c0 + bj * HALF);
#pragma unroll
        for (int ai = 0; ai < 2; ++ai) if (ai < nai)
#pragma unroll
            for (int m = 0; m < 4; ++m)
#pragma unroll
                for (int bj = 0; bj < 2; ++bj) { const u32x4 q = r[ai][m][bj];
                    acc[ai][bj][m][0] *= (f32x4){bf_lo(q.x), bf_hi(q.x), bf_lo(q.y), bf_hi(q.y)}; acc[ai][bj][m][1] *= (f32x4){bf_lo(q.z), bf_hi(q.z), bf_lo(q.w), bf_hi(q.w)}; }
    }
    __device__ __forceinline__ void mid(f32x4 (&acc)[2][2][4][2], const Unit& u, int wr, int wc, int fr, int fq) const { scale(acc, RAT, u, wr, wc, fr, fq); }
    __device__ __forceinline__ void operator()(f32x4 (&acc)[2][2][4][2], const Unit& u, int wr, int wc, int fr, int fq) const {
        scale(acc, SGB, u, wr, wc, fr, fq);
        const int rbase = u.pm * BM + wr * 64 + fr, c0 = u.pn * BM + wc * 32 + 8 * fq, nai = (u.pm == PAN_S) ? 1 : 2;
#pragma unroll
        for (int ai = 0; ai < 2; ++ai) if (ai < nai)
#pragma unroll
            for (int m = 0; m < 4; ++m) { const int row = rbase + ai * HALF + m * 16;
#pragma unroll
                for (int bj = 0; bj < 2; ++bj) st16(MG + (size_t)row * 4096 + c0 + bj * HALF, pack8(acc[ai][bj][m][0], acc[ai][bj][m][1])); }
    }
};

template <bool BASE_BF16> struct EpiResidB {
    static constexpr bool PERM = true, AFTER_DRAIN = false, MIDK = false;
    const void* base; bf16_t* Xo; bf16_t* XN2; const float* g2; float* part;
    __device__ __forceinline__ void mid(f32x4 (&)[2][2][4][2], const Unit&, int, int, int, int) const {}
    __device__ __forceinline__ void operator()(const f32x4 (&acc)[2][2][4][2], const Unit& u, int wr, int wc, int fr, int fq) const {
        const int rbase = u.pm * BM + wr * 64 + fr, c0 = u.pn * BM + wc * 32 + 8 * fq;
        f32x4 gv[2][2];
        if (XN2) {
#pragma unroll
            for (int bj = 0; bj < 2; ++bj)
#pragma unroll
                for (int n = 0; n < 2; ++n) gv[bj][n] = ld16f(g2 + c0 + bj * HALF + 4 * n); }
        u32x4 wb[2][4][2];
        if (BASE_BF16) {
#pragma unroll
            for (int ai = 0; ai < 2; ++ai)
#pragma unroll
                for (int m = 0; m < 4; ++m)
#pragma unroll
                    for (int bj = 0; bj < 2; ++bj) wb[ai][m][bj] = ld16nt((const bf16_t*)base + (size_t)(rbase + ai * HALF + m * 16) * 4096 + c0 + bj * HALF); }
#pragma unroll
        for (int ai = 0; ai < 2; ++ai) {
            f32x4 xb[4][2][2];
            if (!BASE_BF16) {
#pragma unroll
                for (int m = 0; m < 4; ++m)
#pragma unroll
                    for (int bj = 0; bj < 2; ++bj) { const size_t o = (size_t)(rbase + ai * HALF + m * 16) * 4096 + c0 + bj * HALF; xb[m][bj][0] = ld16fnt((const float*)base + o); xb[m][bj][1] = ld16fnt((const float*)base + o + 4); } }
#pragma unroll
            for (int m = 0; m < 4; ++m) { const int row = rbase + ai * HALF + m * 16; f32x4 xo[2][2]; float ss = 0.f;
#pragma unroll
                for (int bj = 0; bj < 2; ++bj) {
                    if (BASE_BF16) { const u32x4 w = wb[ai][m][bj];
                        xo[bj][0] = (f32x4){bf_lo(w.x), bf_hi(w.x), bf_lo(w.y), bf_hi(w.y)} + acc[ai][bj][m][0]; xo[bj][1] = (f32x4){bf_lo(w.z), bf_hi(w.z), bf_lo(w.w), bf_hi(w.w)} + acc[ai][bj][m][1]; }
                    else { xo[bj][0] = xb[m][bj][0] + acc[ai][bj][m][0]; xo[bj][1] = xb[m][bj][1] + acc[ai][bj][m][1]; } }
#pragma unroll
                for (int bj = 0; bj < 2; ++bj) { st16(Xo + (size_t)row * 4096 + c0 + bj * HALF, pack8(xo[bj][0], xo[bj][1]));
#pragma unroll
                    for (int n = 0; n < 2; ++n) ss += (xo[bj][n][0] * xo[bj][n][0] + xo[bj][n][1] * xo[bj][n][1]) + (xo[bj][n][2] * xo[bj][n][2] + xo[bj][n][3] * xo[bj][n][3]);
                    if (XN2) { const int c = c0 + bj * HALF; st16(XN2 + ((size_t)(row >> 8) * 64 + (c >> 6)) * 16384 + (size_t)(row & 255) * 64 + (c & 63), pack8(xo[bj][0] * gv[bj][0], xo[bj][1] * gv[bj][1])); } }
                *(PG8_GAS float*)(part + (size_t)row * 256 + 16 * u.pn + 4 * wc + fq) = ss; }
            asm volatile("" ::: "memory"); }
    }
};

struct EpiGateUpF {
    static constexpr bool PERM = true, AFTER_DRAIN = false, MIDK = false;
    bf16_t* F; float* sideG; float* sideU; const float* cw; const float* cbias; const float* st; float* out; PG8_LAS float* xch; const float* rstat;
    __device__ __forceinline__ void mid(f32x4 (&)[2][2][4][2], const Unit&, int, int, int, int) const {}
    static __device__ __forceinline__ float rot1(float x, int idx) { return __builtin_bit_cast(float, __builtin_amdgcn_ds_bpermute(idx, __builtin_bit_cast(int, x))); }
    static __device__ __forceinline__ f32x4 rot(const f32x4 v, int idx) {
        const float a = rot1(v.x, idx), b = rot1(v.y, idx), c = rot1(v.z, idx), d = rot1(v.w, idx);
        return (f32x4){a, b, c, d}; }
    static __device__ __forceinline__ f32x4 silu_mul4(const f32x4 gc, const f32x4 u) { f32x4 r;
#pragma unroll
        for (int e = 0; e < 4; ++e) r[e] = gc[e] * __builtin_amdgcn_rcpf(1.0f + __builtin_amdgcn_exp2f(-gc[e] * 1.4426950408889634f)) * u[e];
        return r; }
    __device__ __forceinline__ void operator()(f32x4 (&acc)[2][2][4][2], const Unit& u, int wr, int wc, int fr, int fq) const {
        const int pn = u.pn, pm = u.pm;
        const int cl = wc * 32 + 8 * fq, c0 = pn * 128 + cl;
        const int rbase = pm * BM + wr * 64 + fr;
        f32x4 w0[2], w1[2], w2[2], bb[2];
#pragma unroll
        for (int n = 0; n < 2; ++n) { w0[n] = ld16f(cw + c0 + 4 * n); w1[n] = ld16f(cw + 11008 + c0 + 4 * n); w2[n] = ld16f(cw + 2 * 11008 + c0 + 4 * n); bb[n] = ld16f(cbias + c0 + 4 * n); }
        {
            float rs[2][4];
#pragma unroll
            for (int ai = 0; ai < 2; ++ai)
#pragma unroll
                for (int m = 0; m < 4; ++m) rs[ai][m] = *(const PG8_GAS float*)(rstat + pm * BM + wr * 64 + fr + ai * HALF + m * 16);
#pragma unroll
            for (int ai = 0; ai < 2; ++ai)
#pragma unroll
                for (int bj = 0; bj < 2; ++bj)
#pragma unroll
                    for (int m = 0; m < 4; ++m)
#pragma unroll
                        for (int n = 0; n < 2; ++n) acc[ai][bj][m][n] *= rs[ai][m];
        }
        if (pm == PAN_S) {
            f32x4 s0[4][2], s1[4][2];
#pragma unroll
            for (int m = 0; m < 4; ++m)
#pragma unroll
                for (int n = 0; n < 2; ++n) { const int b = rbase + m * 16 - ROWS_P; s0[m][n] = ld16f(st + ((size_t)b * 2 + 0) * 11008 + c0 + 4 * n); s1[m][n] = ld16f(st + ((size_t)b * 2 + 1) * 11008 + c0 + 4 * n); }
#pragma unroll
            for (int m = 0; m < 4; ++m) { const int b = rbase + m * 16 - ROWS_P; f32x4 f[2];
#pragma unroll
                for (int n = 0; n < 2; ++n) { const f32x4 g = acc[0][0][m][n];
                    st16f(out + O_SF + ((size_t)b * 2 + 0) * 11008 + c0 + 4 * n, s1[m][n]); st16f(out + O_SF + ((size_t)b * 2 + 1) * 11008 + c0 + 4 * n, g);
                    f[n] = silu_mul4(((w0[n] * s0[m][n] + w1[n] * s1[m][n]) + w2[n] * g) + bb[n], acc[0][1][m][n]); }
                st16nt(F + (size_t)(rbase + m * 16) * 11008 + c0, pack8(f[0], f[1])); }
            asm volatile("s_waitcnt lgkmcnt(0)" ::: "memory"); __builtin_amdgcn_s_barrier(); asm volatile("" ::: "memory");
            return;
        }
        if (fr >= 14) {
#pragma unroll
            for (int ai = 0; ai < 2; ++ai)
#pragma unroll
                for (int n = 0; n < 2; ++n) *(PG8_LAS f32x4*)(xch + ((ai * 2 + wr) * 2 + (fr - 14)) * 128 + cl + 4 * n) = acc[ai][0][3][n];
        }
        asm volatile("s_waitcnt lgkmcnt(0)" ::: "memory"); __builtin_amdgcn_s_barrier(); asm volatile("" ::: "memory");
        const int lane_ = fr + 16 * fq, i1 = ((lane_ & 48) | ((fr + 15) & 15)) << 2, i2 = ((lane_ & 48) | ((fr + 14) & 15)) << 2;
        const bool winp = ((pm & 7) == 7);
#pragma unroll
        for (int ai = 0; ai < 2; ++ai) {
            f32x4 c1[2], c2[2];
            if (ai == 0 && wr == 0) {
#pragma unroll
                for (int n = 0; n < 2; ++n) { c1[n] = (f32x4){0.f, 0.f, 0.f, 0.f}; c2[n] = (f32x4){0.f, 0.f, 0.f, 0.f}; }
            } else {
                const int sa = (wr == 1) ? ai : ai - 1, sw = (wr == 1) ? 0 : 1;
#pragma unroll
                for (int n = 0; n < 2; ++n) { const f32x4 l2 = *(const PG8_LAS f32x4*)(xch + ((sa * 2 + sw) * 2 + 0) * 128 + cl + 4 * n), l1 = *(const PG8_LAS f32x4*)(xch + ((sa * 2 + sw) * 2 + 1) * 128 + cl + 4 * n);
                    c1[n] = l1; c2[n] = (fr == 0) ? l2 : l1; }
            }
#pragma unroll
            for (int m = 0; m < 4; ++m) { const int row = rbase + ai * HALF + m * 16; f32x4 f[2];
#pragma unroll
                for (int n = 0; n < 2; ++n) { const f32x4 g = acc[ai][0][m][n], r1 = rot(g, i1), r2 = rot(g, i2);
                    f32x4 p1, p2;
#pragma unroll
                    for (int e = 0; e < 4; ++e) { p1[e] = (fr >= 1) ? r1[e] : c1[n][e]; p2[e] = (fr >= 2) ? r2[e] : c2[n][e]; }
                    c1[n] = r1; c2[n] = r2;
                    f[n] = silu_mul4(((w0[n] * p2 + w1[n] * p1) + w2[n] * g) + bb[n], acc[ai][1][m][n]); }
                st16nt(F + (size_t)row * 11008 + c0, pack8(f[0], f[1]));
                if (ai == 0 && m == 0 && wr == 0 && fr < 2) {
#pragma unroll
                    for (int n = 0; n < 2; ++n) { st16f(sideG + ((size_t)pm * 4 + fr) * 11008 + c0 + 4 * n, acc[0][0][0][n]); st16f(sideU + ((size_t)pm * 2 + fr) * 11008 + c0 + 4 * n, acc[0][1][0][n]); } }
                if (ai == 1 && m == 3 && wr == 1 && fr >= 14) {
#pragma unroll
                    for (int n = 0; n < 2; ++n) { st16f(sideG + ((size_t)pm * 4 + 2 + (fr - 14)) * 11008 + c0 + 4 * n, acc[1][0][3][n]);
                        if (winp) st16f(out + O_PF + ((size_t)(row >> 11) * 2 + (fr - 14)) * 11008 + c0 + 4 * n, acc[1][0][3][n]); } }
            }
        }
    }
};

struct EpiSlab {
    static constexpr bool PERM = true, AFTER_DRAIN = false, MIDK = false;
    float* slab; int np;
    __device__ __forceinline__ void mid(f32x4 (&)[2][2][4][2], const Unit&, int, int, int, int) const {}
    __device__ __forceinline__ void operator()(const f32x4 (&acc)[2][2][4][2], const Unit& u, int wr, int wc, int fr, int fq) const {
        const int sl = (8 * (u.kn & 0xffff) + np - 1) / np;
        float* sp = slab + ((size_t)sl * 128 + wr * 64 + fr) * 4096 + u.pn * BM + wc * 32 + 8 * fq;
#pragma unroll
        for (int m = 0; m < 4; ++m)
#pragma unroll
            for (int bj = 0; bj < 2; ++bj) { st16f(sp + (size_t)(m * 16) * 4096 + bj * HALF, acc[0][bj][m][0]); st16f(sp + (size_t)(m * 16) * 4096 + bj * HALF + 4, acc[0][bj][m][1]); }
    }
};
struct EpiNull {
    static constexpr bool PERM = true, AFTER_DRAIN = false, MIDK = false;
    float* sink;
    __device__ __forceinline__ void mid(f32x4 (&)[2][2][4][2], const Unit&, int, int, int, int) const {}
    __device__ __forceinline__ void operator()(const f32x4 (&acc)[2][2][4][2], const Unit& u, int wr, int wc, int fr, int fq) const {
        f32x4 s = acc[0][0][0][0];
#pragma unroll
        for (int ai = 0; ai < 2; ++ai)
#pragma unroll
            for (int bj = 0; bj < 2; ++bj)
#pragma unroll
                for (int m = 0; m < 4; ++m)
#pragma unroll
                    for (int n = 0; n < 2; ++n) s += acc[ai][bj][m][n];
        if (s[0] == 123456.789f && s[1] == 1.f && s[2] == 2.f && s[3] == 3.f) *(PG8_GAS float*)sink = s[0];
    }
};
template <class Epi, class Sched, bool ALIGN_EPI = false, bool SP2 = false, bool TA = false, bool TB = false, bool BNT = false, bool VARK = false, bool SKIP32 = false>
__device__ __forceinline__ void gemm_phase(PG8_LAS unsigned char* lds, const Gemm g, const Sched& S, const Epi& E) {
    int tid_ = threadIdx.x; asm volatile("" : "+v"(tid_));
    const int tid = tid_, wid = __builtin_amdgcn_readfirstlane(tid >> 6), lane = tid & 63, wr = wid >> 2, wc = wid & 3, fr = lane & 15, fq = lane >> 4;
    const int K = g.K, nt = K / BK;
    unsigned voffA[2], voffB[2];
#pragma unroll
    for (int i = 0; i < 2; ++i) { int R, C; stage_rc(tid * 16 + i * 8192, R, C); const int Rb = Epi::PERM ? ((R & ~31) + perm32(R & 31)) : R;
        voffA[i] = (unsigned)(R * (TA ? BK : K) + C) * 2u; voffB[i] = (unsigned)(Rb * (TB ? BK : K) + C) * 2u; }
    const size_t kstepA = TA ? (size_t)BM * BK * 2 : (size_t)(BK * 2), kstepB = TB ? (size_t)BM * BK * 2 : (size_t)(BK * 2);
    const size_t hstepA = TA ? (size_t)HALF * BK * 2 : (size_t)HALF * K * 2, hstepB = TB ? (size_t)HALF * BK * 2 : (size_t)HALF * K * 2;
    const size_t tstepA = (size_t)BM * K * 2, tstepB = (size_t)BM * K * 2;
    const unsigned ldsw = (unsigned)wid * 1024u;
    const int aoff = lds_byte(wr * 64 + fr, fq * 8), boff = lds_byte(wc * 32 + fr, fq * 8);
#define PG8_SA(b, h) (((b) * 2 + (h)) * HTB)
#define PG8_SB(b, h) ((4 + (b) * 2 + (h)) * HTB)
#define PG8_STAGE(bufoff, gbase, voff) do { _Pragma("unroll") for (int _i = 0; _i < 2; ++_i) \
        __builtin_amdgcn_global_load_lds((const unsigned*)((const char*)(gbase) + (voff)[_i]), (PG8_LAS unsigned*)(lds + (bufoff) + ldsw + _i * 8192), 16, 0, 0); } while (0)
#define PG8_STAGEB(bufoff, gbase, voff) do { if constexpr (BNT) { _Pragma("unroll") for (int _i = 0; _i < 2; ++_i) \
        __builtin_amdgcn_global_load_lds((const unsigned*)((const char*)(gbase) + (voff)[_i]), (PG8_LAS unsigned*)(lds + (bufoff) + ldsw + _i * 8192), 16, 0, 2); } else PG8_STAGE(bufoff, gbase, voff); } while (0)
#define PG8_LDA(dst, b, h) do { _Pragma("unroll") for (int m = 0; m < 4; ++m) _Pragma("unroll") for (int k = 0; k < 2; ++k) dst[m][k] = *(const PG8_LAS bf16x8*)(lds + PG8_SA(b, h) + aoff + m * 2048 + k * 1024); } while (0)
#define PG8_LDB(dst, b, h) do { _Pragma("unroll") for (int n = 0; n < 2; ++n) _Pragma("unroll") for (int k = 0; k < 2; ++k) dst[n][k] = *(const PG8_LAS bf16x8*)(lds + PG8_SB(b, h) + boff + n * 2048 + k * 1024); } while (0)
#ifdef PG8_STATIC_PRIO
#define PG8_MMA(ai, bj, At, Bt) do { _Pragma("unroll") for (int m = 0; m < 4; ++m) _Pragma("unroll") for (int n = 0; n < 2; ++n) _Pragma("unroll") for (int k = 0; k < 2; ++k) \
        acc[ai][bj][m][n] = __builtin_amdgcn_mfma_f32_16x16x32_bf16(Bt[n][k], At[m][k], acc[ai][bj][m][n], 0, 0, 0); } while (0)
#else
#define PG8_MMA(ai, bj, At, Bt) do { __builtin_amdgcn_s_setprio(1); _Pragma("unroll") for (int m = 0; m < 4; ++m) _Pragma("unroll") for (int n = 0; n < 2; ++n) _Pragma("unroll") for (int k = 0; k < 2; ++k) \
        acc[ai][bj][m][n] = __builtin_amdgcn_mfma_f32_16x16x32_bf16(Bt[n][k], At[m][k], acc[ai][bj][m][n], 0, 0, 0); __builtin_amdgcn_s_setprio(0); } while (0)
#endif
#define PG8_WAIT_V(n) asm volatile("s_waitcnt vmcnt(" #n ")" ::: "memory")
#define PG8_WAIT_L(n) asm volatile("s_waitcnt lgkmcnt(" #n ")" ::: "memory")
#define PG8_BAR __builtin_amdgcn_s_barrier()
#define PG8_SCHED __builtin_amdgcn_sched_barrier(0)
    Unit cur, nxt; int ui = 0;
    if (!S.next(0, cur)) return;
#ifdef PG8_STATIC_PRIO
    if (wr == 1) __builtin_amdgcn_s_setprio(1);
#endif
    f32x4 acc[2][2][4][2];
#pragma unroll
    for (int a = 0; a < 2; ++a)
#pragma unroll
        for (int b = 0; b < 2; ++b)
#pragma unroll
            for (int m = 0; m < 4; ++m)
#pragma unroll
                for (int n = 0; n < 2; ++n) acc[a][b][m][n] = (f32x4){0.f, 0.f, 0.f, 0.f};
    bf16x8 At[4][2], B0[2][2], B1[2][2];
    const char* cA = (const char*)g.A + (size_t)cur.pm * tstepA + (VARK ? (size_t)(cur.kn & 0xffff) * kstepA : (size_t)0); const char* cB = (const char*)g.Bt + (size_t)cur.pn * tstepB + (VARK ? (size_t)(cur.kn & 0xffff) * kstepB : (size_t)0);
    S.a_ready(cur);
    if constexpr (SP2) {
        PG8_STAGEB(PG8_SB(0, 0), cB, voffB); PG8_STAGEB(PG8_SB(0, 1), cB + hstepB, voffB); PG8_STAGE(PG8_SA(0, 0), cA, voffA); PG8_STAGE(PG8_SA(0, 1), cA + hstepA, voffA);
        if (wr == 1) PG8_BAR;
        PG8_WAIT_V(2); PG8_BAR;
        PG8_STAGEB(PG8_SB(1, 0), cB + kstepB, voffB); PG8_STAGE(PG8_SA(1, 0), cA + kstepA, voffA); PG8_STAGEB(PG8_SB(1, 1), cB + hstepB + kstepB, voffB);
        PG8_WAIT_V(6); PG8_BAR;
    } else {
        PG8_STAGEB(PG8_SB(0, 0), cB, voffB); PG8_STAGE(PG8_SA(0, 0), cA, voffA); PG8_STAGEB(PG8_SB(0, 1), cB + hstepB, voffB); PG8_STAGE(PG8_SA(0, 1), cA + hstepA, voffA);
        if (wr == 1) PG8_BAR;
        PG8_WAIT_V(4); PG8_BAR;
        PG8_STAGEB(PG8_SB(1, 0), cB + kstepB, voffB); PG8_STAGE(PG8_SA(1, 0), cA + kstepA, voffA); PG8_STAGEB(PG8_SB(1, 1), cB + hstepB + kstepB, voffB);
        PG8_WAIT_V(6); PG8_BAR;
    }
    for (;;) {
        const bool has_next = S.next(ui + 1, nxt);
        const char* nA = has_next ? (const char*)g.A + (size_t)nxt.pm * tstepA + (VARK ? (size_t)(nxt.kn & 0xffff) * kstepA : (size_t)0) : cA; const char* nB = has_next ? (const char*)g.Bt + (size_t)nxt.pn * tstepB + (VARK ? (size_t)(nxt.kn & 0xffff) * kstepB : (size_t)0) : cB;
        const int ntu = VARK ? (cur.kn >> 16) : nt;
        const bool fullm = !(VARK || SKIP32) || cur.pm < 32;
        for (int t = 0; t < ntu; t += 2) {
            if constexpr (Epi::MIDK) { if (t == (nt >> 1)) E.mid(acc, cur, wr, wc, fr, fq); }
            const bool last = (t == ntu - 2);
            const char* a1 = cA + (size_t)(t + 1) * kstepA;
            const char* a2 = last ? nA : cA + (size_t)(t + 2) * kstepA; const char* b2 = last ? nB : cB + (size_t)(t + 2) * kstepB;
            const char* a3 = a2 + kstepA; const char* b3 = b2 + kstepB;
            if (last && has_next) S.a_ready(nxt);
            if constexpr (SP2) {
            PG8_LDB(B0, 0, 0); PG8_LDB(B1, 0, 1); PG8_SCHED; PG8_LDA(At, 0, 0); PG8_STAGE(PG8_SA(1, 1), a1 + hstepA, voffA);
            PG8_WAIT_V(8); PG8_WAIT_L(0); PG8_BAR; PG8_MMA(0, 0, At, B0); PG8_MMA(0, 1, At, B1); PG8_BAR; PG8_SCHED;
            PG8_LDA(At, 0, 1); PG8_STAGEB(PG8_SB(0, 0), b2, voffB); PG8_STAGEB(PG8_SB(0, 1), b2 + hstepB, voffB); PG8_STAGE(PG8_SA(0, 0), a2, voffA);
            PG8_WAIT_V(8); PG8_WAIT_L(0); PG8_BAR; if (fullm) { PG8_MMA(1, 0, At, B0); PG8_MMA(1, 1, At, B1); } PG8_BAR; PG8_SCHED;
            PG8_LDB(B0, 1, 0); PG8_LDB(B1, 1, 1); PG8_SCHED; PG8_LDA(At, 1, 0); PG8_STAGE(PG8_SA(0, 1), a2 + hstepA, voffA);
            PG8_WAIT_V(8); PG8_WAIT_L(0); PG8_BAR; PG8_MMA(0, 0, At, B0); PG8_MMA(0, 1, At, B1); PG8_BAR; PG8_SCHED;
            PG8_LDA(At, 1, 1); PG8_STAGEB(PG8_SB(1, 0), b3, voffB); PG8_STAGEB(PG8_SB(1, 1), b3 + hstepB, voffB); PG8_STAGE(PG8_SA(1, 0), a3, voffA);
            PG8_WAIT_V(8); PG8_WAIT_L(0); PG8_BAR; if (fullm) { PG8_MMA(1, 0, At, B0); PG8_MMA(1, 1, At, B1); } PG8_BAR; PG8_SCHED;
            } else {
            PG8_LDB(B0, 0, 0); PG8_SCHED; PG8_LDA(At, 0, 0); PG8_STAGE(PG8_SA(1, 1), a1 + hstepA, voffA);
            PG8_WAIT_L(8); PG8_BAR; PG8_WAIT_L(0); PG8_MMA(0, 0, At, B0); PG8_BAR; PG8_SCHED;
            PG8_LDB(B1, 0, 1); PG8_STAGEB(PG8_SB(0, 0), b2, voffB);
            PG8_BAR; PG8_WAIT_L(0); PG8_MMA(0, 1, At, B1); PG8_BAR;
            PG8_LDA(At, 0, 1); PG8_STAGE(PG8_SA(0, 0), a2, voffA);
            PG8_BAR; PG8_WAIT_L(0); PG8_MMA(1, 0, At, B0); PG8_BAR; PG8_SCHED;
            PG8_STAGEB(PG8_SB(0, 1), b2 + hstepB, voffB);
            PG8_WAIT_V(6); PG8_BAR; PG8_MMA(1, 1, At, B1); PG8_BAR;
            PG8_LDB(B0, 1, 0); PG8_SCHED; PG8_LDA(At, 1, 0); PG8_STAGE(PG8_SA(0, 1), a2 + hstepA, voffA);
            PG8_WAIT_L(8); PG8_BAR; PG8_WAIT_L(0); PG8_MMA(0, 0, At, B0); PG8_BAR; PG8_SCHED;
            PG8_LDB(B1, 1, 1); PG8_STAGEB(PG8_SB(1, 0), b3, voffB);
            PG8_BAR; PG8_WAIT_L(0); PG8_MMA(0, 1, At, B1); PG8_BAR;
            PG8_LDA(At, 1, 1); PG8_STAGE(PG8_SA(1, 0), a3, voffA);
            PG8_BAR; PG8_WAIT_L(0); PG8_MMA(1, 0, At, B0); PG8_BAR; PG8_SCHED;
            PG8_STAGEB(PG8_SB(1, 1), b3 + hstepB, voffB);
            PG8_WAIT_V(6); PG8_BAR; PG8_MMA(1, 1, At, B1); PG8_BAR;
            }
        }
        if constexpr (ALIGN_EPI) { if (wr == 0) PG8_BAR; }
        if constexpr (!Epi::AFTER_DRAIN) { E(acc, cur, wr, wc, fr, fq); S.done(cur); }
        if (!has_next) break;
#pragma unroll
        for (int a = 0; a < 2; ++a)
#pragma unroll
            for (int b = 0; b < 2; ++b)
#pragma unroll
                for (int m = 0; m < 4; ++m)
#pragma unroll
                    for (int n = 0; n < 2; ++n) acc[a][b][m][n] = (f32x4){0.f, 0.f, 0.f, 0.f};
        cur = nxt; cA = nA; cB = nB; ++ui;
        if constexpr (ALIGN_EPI) { if (wr == 1) PG8_BAR; }
    }
#ifdef PG8_STATIC_PRIO
    __builtin_amdgcn_s_setprio(0);
#endif
    PG8_WAIT_V(0);
    if constexpr (!ALIGN_EPI) { if (wr == 0) PG8_BAR; }
    PG8_BAR;
    if constexpr (Epi::AFTER_DRAIN) { E.fused(acc, cur, wr, wc, fr, fq, lds, wid, lane); S.done(cur); }
#undef PG8_SA
#undef PG8_SB
#undef PG8_STAGE
#undef PG8_STAGEB
#undef PG8_LDA
#undef PG8_LDB
#undef PG8_MMA
#undef PG8_WAIT_V
#undef PG8_WAIT_L
#undef PG8_BAR
#undef PG8_SCHED
}
}
#define GAS __attribute__((address_space(1)))
#define LAS __attribute__((address_space(3)))
typedef unsigned short bf16;
typedef unsigned v4u __attribute__((ext_vector_type(4)));
typedef float f32x4 __attribute__((ext_vector_type(4)));
typedef short bf16x8 __attribute__((ext_vector_type(8)));
typedef GAS unsigned gu32;
typedef GAS unsigned long long gu64;
#define RLX_AGENT __ATOMIC_RELAXED, __HIP_MEMORY_SCOPE_AGENT
#define LDS_WAIT() asm volatile("s_waitcnt lgkmcnt(0)" ::: "memory")
#define VM_WAIT() asm volatile("s_waitcnt vmcnt(0)" ::: "memory")
__device__ __forceinline__ unsigned long long rt() { return __builtin_amdgcn_s_memrealtime(); }
__device__ __forceinline__ unsigned f2bf(float f) { unsigned u = __builtin_bit_cast(unsigned, f); return (u + 0x7fffu + ((u >> 16) & 1u)) >> 16; }
__device__ __forceinline__ unsigned pk2(float lo, float hi) { return f2bf(lo) | (f2bf(hi) << 16); }

#define XB_TMO      128
#define XB_XCNT(j)  (256  + 64 * (j))
#define XB_XSUB(j)  (1280 + 64 * (j))
#define XB_XGEN(j)  (2304 + 64 * (j))
#define XB_TOP      3328
#define XB_TOPGEN   3392
#define XCD_BAR_WORDS 3456
#define XB_SPIN_CAP (1u << 18)

__device__ __forceinline__ unsigned xb_ld(unsigned* p)              { return __hip_atomic_load(p, __ATOMIC_RELAXED, __HIP_MEMORY_SCOPE_AGENT); }
__device__ __forceinline__ unsigned xb_add(unsigned* p, unsigned v) { return __hip_atomic_fetch_add(p, v, __ATOMIC_RELAXED, __HIP_MEMORY_SCOPE_AGENT); }
__device__ __forceinline__ unsigned xb_xcc_id() { return (unsigned)__builtin_amdgcn_s_getreg((3 << 11) | 20) & 0xFu; }
#define XB_SPIN(cond, bar) do { unsigned _sp = 0; while (cond) { __builtin_amdgcn_s_sleep(1); \
    if ((++_sp & 255u) == 0u) { if (xb_ld(&(bar)[XB_TMO])) break; if (_sp > XB_SPIN_CAP) { atomicAdd(&(bar)[XB_TMO], 1u); break; } } } } while (0)

struct XcdBarrier {
    unsigned* bar; unsigned x;
    volatile LAS unsigned* st;
};

__device__ __forceinline__ XcdBarrier xcd_barrier_post(unsigned* bar, volatile LAS unsigned* st) {
    XcdBarrier b; b.bar = bar; b.x = xb_xcc_id(); b.st = st;
    if (threadIdx.x == 0) (void)xb_add(&bar[XB_XCNT(b.x)], 1u);
    return b;
}
__device__ __forceinline__ void xcd_barrier_complete(unsigned* bar, unsigned x, unsigned& nloc, unsigned& nx) {
    const unsigned G = gridDim.x * gridDim.y * gridDim.z;
    unsigned sum, cnt, mine, sp = 0u;
    for (;;) {
        sum = 0u; cnt = 0u; mine = 0u;
#pragma unroll
        for (unsigned j = 0; j < 16; ++j) { const unsigned c = xb_ld(&bar[XB_XCNT(j)]); sum += c; cnt += (c > 0u) ? 1u : 0u; mine = (j == x) ? c : mine; }
        if (sum == G) break;
        __builtin_amdgcn_s_sleep(1);
        if ((++sp & 255u) == 0u) { if (xb_ld(&bar[XB_TMO])) break; if (sp > XB_SPIN_CAP) { atomicAdd(&bar[XB_TMO], 1u); break; } }
    }
    nloc = mine > 0u ? mine : 1u; nx = cnt > 0u ? cnt : 1u;
}

__device__ __forceinline__ void xcd_barrier(const XcdBarrier& b) {
    asm volatile("s_waitcnt vmcnt(0)" ::: "memory");
    __syncthreads();
    if (threadIdx.x == 0) {
        unsigned* bar = b.bar;
        __builtin_amdgcn_s_waitcnt(0);
        unsigned nloc = b.st[0], nx = b.st[1];
        if (nloc == 0u) { xcd_barrier_complete(bar, b.x, nloc, nx); b.st[0] = nloc; b.st[1] = nx; }
        const unsigned old = xb_add(&bar[XB_XSUB(b.x)], 1u);
        const unsigned gen = old / nloc;
        if (old + 1u == (gen + 1u) * nloc) {
            __builtin_amdgcn_fence(__ATOMIC_RELEASE, "agent");
            asm volatile("s_waitcnt vmcnt(0)" ::: "memory");
            const unsigned og = xb_add(&bar[XB_TOP], 1u);
            const unsigned tg = og / nx;
            if (og + 1u == (tg + 1u) * nx) {
#pragma unroll
                for (unsigned j = 0; j < 16; ++j) (void)xb_add(&bar[XB_XGEN(j)], 1u);
            }
            XB_SPIN(xb_ld(&bar[XB_XGEN(b.x)]) == gen, bar);
            __builtin_amdgcn_fence(__ATOMIC_ACQUIRE, "agent");
            asm volatile("s_waitcnt vmcnt(0)" ::: "memory");
        } else {
            XB_SPIN(xb_ld(&bar[XB_XGEN(b.x)]) == gen, bar);
            __builtin_amdgcn_fence(__ATOMIC_ACQUIRE, "agent");
            asm volatile("s_waitcnt vmcnt(0)" ::: "memory");
        }
    }
    __syncthreads();
}


constexpr int NWAVES = 8;
constexpr int DM = 4096, SEQ = 2048, CONVW = 2048, KVW = 512, DFF = 11008, INW = 17408;
constexpr int ROWS_P = pg8::ROWS_P, ROWS_R = pg8::ROWS_R, MPAD = pg8::ROWS_PAD;
constexpr float EPS = 1e-5f, LOG2E = 1.4426950408889634f;
using pg8::O_YP; using pg8::O_YS; using pg8::O_SK; using pg8::O_SV; using pg8::O_SC; using pg8::O_SF; using pg8::O_END;

constexpr size_t MiB = 1u << 20;
constexpr size_t WS_CTL = 0, CTL_ZERO_BYTES = 1 * MiB;
constexpr size_t WS_WGU = 1 * MiB;
constexpr size_t WS_WD  = WS_WGU + (size_t)2 * DFF * DM * 2;
constexpr size_t WS_XN  = WS_WD + (size_t)DM * DFF * 2;
constexpr size_t WS_X1  = WS_XN + (size_t)MPAD * DM * 2;
constexpr size_t WS_A   = WS_X1 + (size_t)MPAD * DM * 4;
constexpr size_t WS_WIN = WS_A;
constexpr size_t WS_WAB = WS_WIN + (size_t)INW * DM * 2;
constexpr size_t WS_WO  = WS_WAB + (size_t)DM * DM * 2;
constexpr size_t WS_CB  = WS_WO + (size_t)DM * DM * 2;
constexpr size_t WS_UU  = WS_CB + (size_t)MPAD * 2048 * 2;
constexpr size_t WS_Q   = WS_UU + (size_t)MPAD * 2048 * 2;
constexpr size_t WS_K   = WS_Q + (size_t)MPAD * 2048 * 2;
constexpr size_t WS_VT  = WS_K + (size_t)MPAD * 512 * 2;
constexpr size_t WS_RAT = WS_VT + (size_t)MPAD * 512 * 2;
constexpr size_t WS_SGB = WS_RAT + (size_t)MPAD * DM * 2;
constexpr size_t WS_AO  = WS_SGB + (size_t)MPAD * DM * 2;
constexpr size_t WS_MG  = WS_AO + (size_t)MPAD * DM * 2;
constexpr size_t WS_A_END = WS_MG + (size_t)MPAD * DM * 2;
constexpr size_t WS_G   = WS_A;
constexpr size_t WS_U   = WS_G + (size_t)MPAD * DFF * 2;
constexpr size_t WS_F   = WS_U + (size_t)MPAD * DFF * 2;
constexpr size_t WS_OV_END = WS_F + (size_t)MPAD * DFF * 2;
constexpr size_t WS_SIDEG = WS_A_END > WS_OV_END ? WS_A_END : WS_OV_END;
constexpr size_t WS_SIDEU = WS_SIDEG + (size_t)32 * 4 * DFF * 4;
constexpr size_t WS_PART1 = WS_SIDEU + (size_t)32 * 2 * DFF * 4;
constexpr size_t WS_PART2 = WS_PART1 + (size_t)ROWS_P * 256 * 4;
constexpr size_t WS_RSTAT = WS_PART2 + (size_t)ROWS_P * 256 * 4;
constexpr size_t WS_END = WS_RSTAT + (size_t)MPAD * 4;
constexpr size_t WS_SLAB4 = WS_WIN;
constexpr size_t WS_SLAB = WS_XN;
constexpr int CW_BAR = 4096;
static_assert((CW_BAR + XCD_BAR_WORDS) * 4 <= (int)CTL_ZERO_BYTES, "control words inside the memset region");

constexpr int RING_OFF = 0, RING_BYTES = 131072;
constexpr int LDSCTL_OFF = RING_BYTES, MISC_OFF = LDSCTL_OFF + 320;
constexpr int LDS_BYTES = 147456;
static_assert(MISC_OFF + 128 <= LDS_BYTES, "LDS map");
constexpr int XCH_OFF = LDSCTL_OFF + 1024;
static_assert(XCH_OFF + 8192 <= LDS_BYTES, "LDS map");
constexpr int BIAS_LD = 132;
constexpr int SCR_OFF = 20480, SCR_WAVE = 4096;

typedef float f32x16 __attribute__((ext_vector_type(16)));
typedef short s16x4 __attribute__((ext_vector_type(4)));
typedef unsigned v2u __attribute__((ext_vector_type(2)));
__device__ __forceinline__ float blo(unsigned w) { return __uint_as_float(w << 16); }
__device__ __forceinline__ float bhi(unsigned w) { return __uint_as_float(w & 0xffff0000u); }
__device__ __forceinline__ void unpack8(const v4u w, float (&f)[8]) { f[0] = blo(w.x); f[1] = bhi(w.x); f[2] = blo(w.y); f[3] = bhi(w.y); f[4] = blo(w.z); f[5] = bhi(w.z); f[6] = blo(w.w); f[7] = bhi(w.w); }
__device__ __forceinline__ v4u ldg16(const void* p) { return *(const GAS v4u*)p; }
__device__ __forceinline__ f32x4 ldg4f(const float* p) { return *(const GAS f32x4*)p; }
__device__ __forceinline__ void ld8f(const float* p, float (&f)[8]) { const f32x4 a = ldg4f(p), b = ldg4f(p + 4); f[0] = a[0]; f[1] = a[1]; f[2] = a[2]; f[3] = a[3]; f[4] = b[0]; f[5] = b[1]; f[6] = b[2]; f[7] = b[3]; }
__device__ __forceinline__ void st8f(float* p, const float (&f)[8]) { *(GAS f32x4*)p = (f32x4){f[0], f[1], f[2], f[3]}; *(GAS f32x4*)(p + 4) = (f32x4){f[4], f[5], f[6], f[7]}; }
__device__ __forceinline__ unsigned cvtpk(float lo, float hi) { return pg8::cvt_pk_bf16(lo, hi); }
__device__ __forceinline__ float ex2(float x) { return __builtin_amdgcn_exp2f(x); }
__device__ __forceinline__ float wave_sum(float v) {
#pragma unroll
    for (int o = 1; o < 64; o <<= 1) v += __shfl_xor(v, o);
    return v;
}
__device__ __forceinline__ float wave_max(float v) {
#pragma unroll
    for (int o = 1; o < 64; o <<= 1) v = fmaxf(v, __shfl_xor(v, o));
    return v;
}

struct P0Ref { const float* src; bf16* dst; int N; };
__device__ __forceinline__ void p0_load(const P0Ref& r, f32x4 (&v)[8], int lane) {
#pragma unroll
#ifdef P0_PLAIN_LOADS
    for (int i = 0; i < 8; ++i) v[i] = *(const GAS f32x4*)(r.src + (size_t)(8 * i + (lane >> 3)) * r.N + 4 * (lane & 7));
#else
    for (int i = 0; i < 8; ++i) v[i] = __builtin_nontemporal_load((const GAS f32x4*)(r.src + (size_t)(8 * i + (lane >> 3)) * r.N + 4 * (lane & 7)));
#endif
}
__device__ __forceinline__ void p0_store(const P0Ref& r, const f32x4 (&v)[8], LAS float* scr, int lane) {
#pragma unroll
    for (int i = 0; i < 8; ++i) { LAS float* w = scr + (8 * i + (lane >> 3)) * 33 + 4 * (lane & 7); w[0] = v[i][0]; w[1] = v[i][1]; w[2] = v[i][2]; w[3] = v[i][3]; }
    LDS_WAIT(); asm volatile("" ::: "memory");
    const int c = lane & 7;
#pragma unroll
    for (int j = 0; j < 4; ++j) { const int n = (lane >> 3) + 8 * j; const LAS float* q = scr + (8 * c) * 33 + n;
        v4u o; o.x = cvtpk(q[0 * 33], q[1 * 33]); o.y = cvtpk(q[2 * 33], q[3 * 33]); o.z = cvtpk(q[4 * 33], q[5 * 33]); o.w = cvtpk(q[6 * 33], q[7 * 33]);
        *(GAS v4u*)(r.dst + (size_t)n * 64 + 8 * c) = o; }
    LDS_WAIT(); asm volatile("" ::: "memory");
}
__host__ __device__ __forceinline__ int win_map(int n) {
    if (n < 2048) return n;
    if (n < 6144) { int t = n - 2048; const int h = t >= 2048 ? 1 : 0; t -= h * 2048; return 2048 + (t >> 7) * 256 + h * 128 + (t & 127); }
    if (n < 9216) return n;
    int t = n - 9216; const int h = t >= 4096 ? 1 : 0; t -= h * 4096; return 9216 + (t >> 7) * 256 + h * 128 + (t & 127);
}
__host__ __device__ __forceinline__ size_t tiled_off(int n, int kt, int nt) { return ((size_t)(n >> 8) * nt + kt) * 16384 + (size_t)(n & 255) * 64; }
__device__ __forceinline__ void load_gain(const float* g, f32x4 (&gv)[16], int lane) {
    const GAS f32x4* gr = (const GAS f32x4*)g + lane;
#pragma unroll
    for (int j = 0; j < 16; ++j) gv[j] = gr[64 * j];
}
template <bool OUT_BF16, bool TILED = false> __device__ __forceinline__ void rms_row(const float* xrow, const f32x4 (&gv)[16], void* orow, int lane) {
    const GAS f32x4* xr = (const GAS f32x4*)xrow + lane;
    f32x4 v[16]; float s = 0.f;
#pragma unroll
    for (int j = 0; j < 16; ++j) { v[j] = xr[64 * j]; s += (v[j].x * v[j].x + v[j].y * v[j].y) + (v[j].z * v[j].z + v[j].w * v[j].w); }
    const float r = 1.0f / sqrtf(wave_sum(s) * (1.0f / DM) + EPS);
#pragma unroll
    for (int j = 0; j < 16; ++j) { const f32x4 y = (v[j] * r) * gv[j];
        if (OUT_BF16) { v2u w; w.x = cvtpk(y.x, y.y); w.y = cvtpk(y.z, y.w);
            if (TILED) { const int c = 4 * (lane + 64 * j); *(GAS v2u*)((bf16*)orow + (size_t)(c >> 6) * 16384 + (c & 63)) = w; } else ((GAS v2u*)orow)[lane + 64 * j] = w; }
        else ((GAS f32x4*)orow)[lane + 64 * j] = y; }
}

__device__ __forceinline__ void load_row(const float* xrow, f32x4 (&v)[16], int lane) {
    const GAS f32x4* xr = (const GAS f32x4*)xrow + lane;
#pragma unroll
    for (int j = 0; j < 16; ++j) v[j] = __builtin_nontemporal_load(xr + 64 * j);
}
__device__ __forceinline__ void rms_row_pre_tiled(const f32x4 (&v)[16], const f32x4 (&gv)[16], bf16* orow, int lane) {
    float s = 0.f;
#pragma unroll
    for (int j = 0; j < 16; ++j) s += (v[j].x * v[j].x + v[j].y * v[j].y) + (v[j].z * v[j].z + v[j].w * v[j].w);
    const float r = 1.0f / sqrtf(wave_sum(s) * (1.0f / DM) + EPS);
#pragma unroll
    for (int j = 0; j < 16; ++j) { const f32x4 y = (v[j] * r) * gv[j]; v2u w; w.x = cvtpk(y.x, y.y); w.y = cvtpk(y.z, y.w); const int c = 4 * (lane + 64 * j);
        *(GAS v2u*)(orow + (size_t)(c >> 6) * 16384 + (c & 63)) = w; }
}
__device__ __forceinline__ void rms_raw_row(const float* xrow, const f32x4 (&gv)[16], bf16* orow, float* rstat, int lane) {
    const GAS f32x4* xr = (const GAS f32x4*)xrow + lane;
    f32x4 v[16]; float s = 0.f;
#pragma unroll
    for (int j = 0; j < 16; ++j) { v[j] = xr[64 * j]; s += (v[j].x * v[j].x + v[j].y * v[j].y) + (v[j].z * v[j].z + v[j].w * v[j].w); }
    const float r = 1.0f / sqrtf(wave_sum(s) * (1.0f / DM) + EPS);
    if (lane == 0) *(GAS float*)rstat = r;
#pragma unroll
    for (int j = 0; j < 16; ++j) { const f32x4 y = v[j] * gv[j]; v2u w; w.x = cvtpk(y.x, y.y); w.y = cvtpk(y.z, y.w); const int c = 4 * (lane + 64 * j);
        *(GAS v2u*)(orow + (size_t)(c >> 6) * 16384 + (c & 63)) = w; }
}
__device__ __forceinline__ float row16_sum(float v) {
    v += __builtin_bit_cast(float, __builtin_amdgcn_update_dpp(0, __builtin_bit_cast(int, v), 0xB1, 0xF, 0xF, false));
    v += __builtin_bit_cast(float, __builtin_amdgcn_update_dpp(0, __builtin_bit_cast(int, v), 0x4E, 0xF, 0xF, false));
    v += __builtin_bit_cast(float, __builtin_amdgcn_update_dpp(0, __builtin_bit_cast(int, v), 0x141, 0xF, 0xF, false));
    v += __builtin_bit_cast(float, __builtin_amdgcn_update_dpp(0, __builtin_bit_cast(int, v), 0x140, 0xF, 0xF, false));
    return v;
}
__device__ __forceinline__ int crow(int r, int hi) { return (r & 3) + 8 * (r >> 2) + 4 * hi; }
__device__ __forceinline__ void attn_prompt_task(int t, const bf16* Q, const bf16* KB, const bf16* VT, bf16* AO, const float* sinks, const LAS float* biasT, int lane) {
    const int g = t & 3, i32 = (t >> 2) & 63, kvh = (t >> 8) & 7, b = t >> 11, head = kvh * 4 + g;
    const int r32 = lane & 31, hi = lane >> 5;
    const int rowbase = b * SEQ, t0 = i32 * 32;
    const int kb_lo = (t0 >= 128) ? 0 : ((128 - t0) >> 5);
    bf16x8 qf[4];
    { const bf16* qp = Q + (size_t)(rowbase + t0 + r32) * 2048 + head * 64 + hi * 8;
#pragma unroll
      for (int ks = 0; ks < 4; ++ks) qf[ks] = *(const GAS bf16x8*)(qp + ks * 16); }
    f32x16 s[5];
    bf16x8 kf[5][4];
#pragma unroll
    for (int kb = 0; kb < 5; ++kb) if (kb >= kb_lo) {
        const bf16* kp = KB + (size_t)(rowbase + t0 - 128 + 32 * kb + r32) * KVW + kvh * 64 + hi * 8;
#pragma unroll
        for (int ks = 0; ks < 4; ++ks) kf[kb][ks] = *(const GAS bf16x8*)(kp + ks * 16);
    }
#pragma unroll
    for (int kb = 0; kb < 5; ++kb) {
#pragma unroll
        for (int r = 0; r < 16; ++r) s[kb][r] = 0.f;
        if (kb >= kb_lo) {
#pragma unroll
            for (int ks = 0; ks < 4; ++ks) s[kb] = __builtin_amdgcn_mfma_f32_32x32x16_bf16(kf[kb][ks], qf[ks], s[kb], 0, 0, 0);
        }
    }
    __builtin_amdgcn_sched_barrier(0);
    v2u vl[5][2][2], vh[5][2][2];
#pragma unroll
    for (int kb = 0; kb < 5; ++kb) if (kb >= kb_lo) {
#pragma unroll
        for (int sx = 0; sx < 2; ++sx) { const int tk = rowbase + t0 - 128 + 32 * kb + 16 * sx;
#pragma unroll
            for (int db = 0; db < 2; ++db) { const bf16* vp = VT + (size_t)(kvh * 64 + db * 32 + r32) * MPAD + tk + 4 * hi;
                vl[kb][sx][db] = *(const GAS v2u*)vp; vh[kb][sx][db] = *(const GAS v2u*)(vp + 8); } }
    }
    const LAS float* bt = biasT + head * BIAS_LD;
    const float sink = *(const GAS float*)(sinks + head);
    float mx = sink;
#pragma unroll
    for (int kb = 0; kb < 5; ++kb)
#pragma unroll
        for (int r = 0; r < 16; ++r) {
            const int dist = r32 + 128 - 32 * kb - crow(r, hi);
            const bool valid = (kb >= kb_lo) && dist >= 0 && dist <= 128;
            const int dc = dist < 0 ? 0 : (dist > 128 ? 128 : dist);
            float v = s[kb][r] * 0.125f + bt[dc];
            v = valid ? v : -INFINITY;
            s[kb][r] = v; mx = fmaxf(mx, v);
        }
    mx = fmaxf(mx, __shfl_xor(mx, 32));
    float sum = 0.f;
#pragma unroll
    for (int kb = 0; kb < 5; ++kb)
#pragma unroll
        for (int r = 0; r < 16; ++r) { const float e = ex2((s[kb][r] - mx) * LOG2E); s[kb][r] = e; sum += e; }
    sum += __shfl_xor(sum, 32);
    const float inv = 1.0f / (sum + ex2((sink - mx) * LOG2E));
    f32x16 o[2];
#pragma unroll
    for (int r = 0; r < 16; ++r) { o[0][r] = 0.f; o[1][r] = 0.f; }
#pragma unroll
    for (int kb = 0; kb < 5; ++kb) if (kb >= kb_lo) {
#pragma unroll
        for (int sx = 0; sx < 2; ++sx) {
            v4u pw; pw.x = cvtpk(s[kb][8 * sx + 0], s[kb][8 * sx + 1]); pw.y = cvtpk(s[kb][8 * sx + 2], s[kb][8 * sx + 3]); pw.z = cvtpk(s[kb][8 * sx + 4], s[kb][8 * sx + 5]); pw.w = cvtpk(s[kb][8 * sx + 6], s[kb][8 * sx + 7]);
            const bf16x8 pb = __builtin_bit_cast(bf16x8, pw);
#pragma unroll
            for (int db = 0; db < 2; ++db) {
                v4u vw; vw.x = vl[kb][sx][db].x; vw.y = vl[kb][sx][db].y; vw.z = vh[kb][sx][db].x; vw.w = vh[kb][sx][db].y;
                o[db] = __builtin_amdgcn_mfma_f32_32x32x16_bf16(__builtin_bit_cast(bf16x8, vw), pb, o[db], 0, 0, 0);
            }
        }
    }
    bf16* op = AO + (size_t)(rowbase + t0 + r32) * 4096 + 2048 + head * 64 + 4 * hi;
#pragma unroll
    for (int db = 0; db < 2; ++db)
#pragma unroll
        for (int rg = 0; rg < 4; ++rg) { v2u w; w.x = cvtpk(o[db][4 * rg] * inv, o[db][4 * rg + 1] * inv); w.y = cvtpk(o[db][4 * rg + 2] * inv, o[db][4 * rg + 3] * inv);
            *(GAS v2u*)(op + db * 32 + 8 * rg) = w; }
}
template <bool copy_win> __device__ __forceinline__ void attn_sample_task(int t, const bf16* Q, const float* sk, const float* sv, float* out, bf16* AO, const float* sinks, const LAS float* biasT, LAS float* sc, int lane) {
    const int kvh = t & 7, b = t >> 3;
    const int kq = lane >> 4, d4 = lane & 15;
    float qv[4][4];
#pragma unroll
    for (int g = 0; g < 4; ++g) { const v2u w = *(const GAS v2u*)(Q + (size_t)(ROWS_P + b) * 2048 + (kvh * 4 + g) * 64 + 4 * d4);
        qv[g][0] = blo(w.x) * 0.125f; qv[g][1] = bhi(w.x) * 0.125f; qv[g][2] = blo(w.y) * 0.125f; qv[g][3] = bhi(w.y) * 0.125f; }
    const size_t woff = (size_t)b * 128 * 512 + kvh * 64 + 4 * d4;
#pragma unroll 1
    for (int i0 = 0; i0 < 33; i0 += 17) {
        f32x4 kv[17];
#pragma unroll
        for (int u = 0; u < 17; ++u) { const int j = 4 * (i0 + u) + kq; kv[u] = (f32x4){0.f, 0.f, 0.f, 0.f};
            if (j < 128) kv[u] = __builtin_nontemporal_load((const GAS f32x4*)(sk + woff + (size_t)j * 512)); else if (j == 128) kv[u] = ldg4f(out + O_SK + woff + (size_t)127 * 512); }
#pragma unroll
        for (int u = 0; u < 17; ++u) { const int j = 4 * (i0 + u) + kq;
            if (copy_win && j >= 1 && j < 128) __builtin_nontemporal_store(kv[u], (GAS f32x4*)(out + O_SK + woff + (size_t)(j - 1) * 512));
#pragma unroll
            for (int g = 0; g < 4; ++g) { float p = (qv[g][0] * kv[u][0] + qv[g][1] * kv[u][1]) + (qv[g][2] * kv[u][2] + qv[g][3] * kv[u][3]);
                p = row16_sum(p);
                if (d4 == 0 && j <= 128) sc[g * BIAS_LD + j] = p + biasT[(kvh * 4 + g) * BIAS_LD + (128 - j)]; } }
    }
    asm volatile("s_waitcnt lgkmcnt(0)" ::: "memory");
    float inv[4];
#pragma unroll
    for (int g = 0; g < 4; ++g) {
        const float sink = *(const GAS float*)(sinks + kvh * 4 + g);
        const float v0 = sc[g * BIAS_LD + lane], v1 = sc[g * BIAS_LD + 64 + lane], v2 = (lane == 0) ? sc[g * BIAS_LD + 128] : -INFINITY;
        const float m = fmaxf(wave_max(fmaxf(fmaxf(v0, v1), v2)), sink);
        const float e0 = ex2((v0 - m) * LOG2E), e1 = ex2((v1 - m) * LOG2E), e2 = (lane == 0) ? ex2((v2 - m) * LOG2E) : 0.f;
        inv[g] = 1.0f / (wave_sum(e0 + e1 + e2) + ex2((sink - m) * LOG2E));
        sc[g * BIAS_LD + lane] = e0; sc[g * BIAS_LD + 64 + lane] = e1; if (lane == 0) sc[g * BIAS_LD + 128] = e2;
    }
    asm volatile("s_waitcnt lgkmcnt(0)" ::: "memory");
    float acc[4][4];
#pragma unroll
    for (int g = 0; g < 4; ++g)
#pragma unroll
        for (int e = 0; e < 4; ++e) acc[g][e] = 0.f;
#pragma unroll 1
    for (int i0 = 0; i0 < 33; i0 += 17) {
        f32x4 vv[17];
#pragma unroll
        for (int u = 0; u < 17; ++u) { const int j = 4 * (i0 + u) + kq; vv[u] = (f32x4){0.f, 0.f, 0.f, 0.f};
            if (j < 128) vv[u] = __builtin_nontemporal_load((const GAS f32x4*)(sv + woff + (size_t)j * 512)); else if (j == 128) vv[u] = ldg4f(out + O_SV + woff + (size_t)127 * 512); }
#pragma unroll
        for (int u = 0; u < 17; ++u) { const int j = 4 * (i0 + u) + kq;
            if (copy_win && j >= 1 && j < 128) __builtin_nontemporal_store(vv[u], (GAS f32x4*)(out + O_SV + woff + (size_t)(j - 1) * 512));
            if (j <= 128) {
#pragma unroll
                for (int g = 0; g < 4; ++g) { const float p = sc[g * BIAS_LD + j];
#pragma unroll
                    for (int e = 0; e < 4; ++e) acc[g][e] += p * vv[u][e]; }
            } }
    }
#pragma unroll
    for (int g = 0; g < 4; ++g)
#pragma unroll
        for (int e = 0; e < 4; ++e) { acc[g][e] += __shfl_xor(acc[g][e], 16); acc[g][e] += __shfl_xor(acc[g][e], 32); }
    if (kq == 0) {
#pragma unroll
        for (int g = 0; g < 4; ++g) { v2u w; w.x = cvtpk(acc[g][0] * inv[g], acc[g][1] * inv[g]); w.y = cvtpk(acc[g][2] * inv[g], acc[g][3] * inv[g]);
            *(GAS v2u*)(AO + (size_t)(ROWS_P + b) * 4096 + 2048 + (kvh * 4 + g) * 64 + 4 * d4) = w; }
    }
    asm volatile("s_waitcnt lgkmcnt(0)" ::: "memory");
}
__device__ __forceinline__ void conv_row(int row, const bf16* CB, const bf16* UU, bf16* AO, const float* cw, const float* st, float* out, int lane) {
    const bool samp = row >= ROWS_P; const int tl = row & (SEQ - 1);
    v4u a0[4], ac[4], a1[4], a2[4]; f32x4 s1[4][2], s2[4][2];
#pragma unroll
    for (int j = 0; j < 4; ++j) { const int c = 8 * lane + 512 * j;
        a0[j] = ldg16(UU + (size_t)row * 2048 + c); ac[j] = ldg16(CB + (size_t)row * 2048 + c); a1[j] = (v4u){0u, 0u, 0u, 0u}; a2[j] = (v4u){0u, 0u, 0u, 0u};
        if (!samp) { if (tl >= 1) a1[j] = ldg16(UU + (size_t)(row - 1) * 2048 + c); if (tl >= 2) a2[j] = ldg16(UU + (size_t)(row - 2) * 2048 + c); }
        else { const int b = row - ROWS_P; const float* p2 = st + ((size_t)b * 2 + 0) * 2048 + c; const float* p1 = st + ((size_t)b * 2 + 1) * 2048 + c;
            s2[j][0] = ldg4f(p2); s2[j][1] = ldg4f(p2 + 4); s1[j][0] = ldg4f(p1); s1[j][1] = ldg4f(p1 + 4); } }
#pragma unroll
    for (int j = 0; j < 4; ++j) { const int c = 8 * lane + 512 * j;
        float u0[8], u1[8], u2[8], cbv[8], w0[8], w1[8], w2[8];
        unpack8(a0[j], u0); unpack8(ac[j], cbv);
        if (!samp) { unpack8(a1[j], u1); unpack8(a2[j], u2); }
        else { const int b = row - ROWS_P;
#pragma unroll
            for (int e = 0; e < 4; ++e) { u1[e] = s1[j][0][e]; u1[4 + e] = s1[j][1][e]; u2[e] = s2[j][0][e]; u2[4 + e] = s2[j][1][e]; }
            st8f(out + O_SC + ((size_t)b * 2 + 0) * 2048 + c, u1); }
        ld8f(cw + c, w0); ld8f(cw + 2048 + c, w1); ld8f(cw + 4096 + c, w2);
        float a[8];
#pragma unroll
        for (int e = 0; e < 8; ++e) a[e] = cbv[e] * ((w0[e] * u2[e] + w1[e] * u1[e]) + w2[e] * u0[e]);
        v4u w; w.x = cvtpk(a[0], a[1]); w.y = cvtpk(a[2], a[3]); w.z = cvtpk(a[4], a[5]); w.w = cvtpk(a[6], a[7]);
        *(GAS v4u*)(AO + (size_t)row * 4096 + c) = w; }
}
__device__ __forceinline__ void conv_run8(int r0, const bf16* CB, const bf16* UU, bf16* AO, const float* cw, int lane) {
    const bool head = (r0 & (SEQ - 1)) == 0;
#pragma unroll 1
    for (int j = 0; j < 4; ++j) { const int c = 8 * lane + 512 * j;
        v4u u[10], cb[8];
        u[0] = (v4u){0u, 0u, 0u, 0u}; u[1] = (v4u){0u, 0u, 0u, 0u};
        if (!head) { u[0] = ldg16(UU + (size_t)(r0 - 2) * 2048 + c); u[1] = ldg16(UU + (size_t)(r0 - 1) * 2048 + c); }
#pragma unroll
        for (int i = 0; i < 8; ++i) { u[2 + i] = ldg16(UU + (size_t)(r0 + i) * 2048 + c); cb[i] = ldg16(CB + (size_t)(r0 + i) * 2048 + c); }
        float w0[8], w1[8], w2[8], p2[8], p1[8];
        ld8f(cw + c, w0); ld8f(cw + 2048 + c, w1); ld8f(cw + 4096 + c, w2);
        unpack8(u[0], p2); unpack8(u[1], p1);
#pragma unroll
        for (int i = 0; i < 8; ++i) { float u0[8], cbv[8], a[8];
            unpack8(u[2 + i], u0); unpack8(cb[i], cbv);
#pragma unroll
            for (int e = 0; e < 8; ++e) a[e] = cbv[e] * ((w0[e] * p2[e] + w1[e] * p1[e]) + w2[e] * u0[e]);
            v4u w; w.x = cvtpk(a[0], a[1]); w.y = cvtpk(a[2], a[3]); w.z = cvtpk(a[4], a[5]); w.w = cvtpk(a[6], a[7]);
            *(GAS v4u*)(AO + (size_t)(r0 + i) * 4096 + c) = w;
#pragma unroll
            for (int e = 0; e < 8; ++e) { p2[e] = p1[e]; p1[e] = u0[e]; } }
    }
}
__device__ __forceinline__ float silu_mul(float gc, float u) { return gc * __builtin_amdgcn_rcpf(1.0f + ex2(-gc * LOG2E)) * u; }
__device__ __forceinline__ void ffn_act_block(int task, const bf16* G, const bf16* U, bf16* F, const float* cw, const float* cbias, const float* st, float* out, int lane) {
    const int ch = task % 22, rb = task / 22, c = ch * 512 + lane * 8;
    if (c >= DFF) return;
    float w0[8], w1[8], w2[8], bb[8];
    ld8f(cw + c, w0); ld8f(cw + DFF + c, w1); ld8f(cw + 2 * DFF + c, w2); ld8f(cbias + c, bb);
    const int row0 = rb * 32;
    if (rb < ROWS_P / 32) {
        float g1[8], g2[8];
        if ((row0 & (SEQ - 1)) != 0) { unpack8(ldg16(G + (size_t)(row0 - 1) * DFF + c), g1); unpack8(ldg16(G + (size_t)(row0 - 2) * DFF + c), g2); }
        else {
#pragma unroll
            for (int e = 0; e < 8; ++e) { g1[e] = 0.f; g2[e] = 0.f; } }
        for (int r0 = 0; r0 < 32; r0 += 8) {
            v4u gw_[8], uw_[8];
#pragma unroll
            for (int r = 0; r < 8; ++r) { gw_[r] = ldg16(G + (size_t)(row0 + r0 + r) * DFF + c); uw_[r] = ldg16(U + (size_t)(row0 + r0 + r) * DFF + c); }
#pragma unroll
            for (int r = 0; r < 8; ++r) { float g0[8], uv[8], f[8]; unpack8(gw_[r], g0); unpack8(uw_[r], uv);
#pragma unroll
                for (int e = 0; e < 8; ++e) { f[e] = silu_mul(((w0[e] * g2[e] + w1[e] * g1[e]) + w2[e] * g0[e]) + bb[e], uv[e]); g2[e] = g1[e]; g1[e] = g0[e]; }
                v4u w; w.x = cvtpk(f[0], f[1]); w.y = cvtpk(f[2], f[3]); w.z = cvtpk(f[4], f[5]); w.w = cvtpk(f[6], f[7]);
                *(GAS v4u*)(F + (size_t)(row0 + r0 + r) * DFF + c) = w; }
        }
    } else {
        for (int r0 = 0; r0 < 32; r0 += 4) {
            v4u gw_[4], uw_[4]; float s0[4][8], s1[4][8];
#pragma unroll
            for (int r = 0; r < 4; ++r) { const int row = row0 + r0 + r, b = row - ROWS_P; gw_[r] = ldg16(G + (size_t)row * DFF + c); uw_[r] = ldg16(U + (size_t)row * DFF + c);
                ld8f(st + ((size_t)b * 2 + 0) * DFF + c, s0[r]); ld8f(st + ((size_t)b * 2 + 1) * DFF + c, s1[r]); }
#pragma unroll
            for (int r = 0; r < 4; ++r) { const int row = row0 + r0 + r, b = row - ROWS_P; float g0[8], uv[8], f[8]; unpack8(gw_[r], g0); unpack8(uw_[r], uv);
                st8f(out + O_SF + ((size_t)b * 2 + 0) * DFF + c, s1[r]);
#pragma unroll
                for (int e = 0; e < 8; ++e) f[e] = silu_mul(((w0[e] * s0[r][e] + w1[e] * s1[r][e]) + w2[e] * g0[e]) + bb[e], uv[e]);
                v4u w; w.x = cvtpk(f[0], f[1]); w.y = cvtpk(f[2], f[3]); w.z = cvtpk(f[4], f[5]); w.w = cvtpk(f[6], f[7]);
                *(GAS v4u*)(F + (size_t)row * DFF + c) = w; }
        }
    }
}

template <int NB, int NR, bool PIPE>
__device__ __forceinline__ void skinny_ksplit(f32x4 (&acc)[NB * NR], const bf16* A  , int lda, int ags  ,
                                              const bf16* const (&brow)[NB]  , int bgs  , int gfirst, int gstride, int gcount, int rot, int fr, int fq) {
    const bf16* a0 = A + (size_t)fr * lda + 16 * fq;
    auto ld = [&](int i, bf16x8 (&a)[NR][2], bf16x8 (&b)[NB][2]) {
        int ii = i + rot; if (ii >= gcount) ii -= gcount;
        const int gi = gfirst + gstride * ii; const size_t ka_ = (size_t)gi * ags, kb_ = (size_t)gi * bgs;
#pragma unroll
        for (int j = 0; j < NB; ++j) { b[j][0] = *(const GAS bf16x8*)(brow[j] + 16 * fq + kb_); b[j][1] = *(const GAS bf16x8*)(brow[j] + 16 * fq + kb_ + 8); }
#pragma unroll
        for (int rg = 0; rg < NR; ++rg) { a[rg][0] = *(const GAS bf16x8*)(a0 + (size_t)(16 * rg) * lda + ka_); a[rg][1] = *(const GAS bf16x8*)(a0 + (size_t)(16 * rg) * lda + ka_ + 8); }
    };
    auto mm = [&](const bf16x8 (&a)[NR][2], const bf16x8 (&b)[NB][2]) {
#pragma unroll
        for (int u = 0; u < 2; ++u)
#pragma unroll
            for (int j = 0; j < NB; ++j)
#pragma unroll
                for (int rg = 0; rg < NR; ++rg) acc[j * NR + rg] = __builtin_amdgcn_mfma_f32_16x16x32_bf16(b[j][u], a[rg][u], acc[j * NR + rg], 0, 0, 0);
    };
    if constexpr (PIPE) {
        bf16x8 a0s[NR][2], b0s[NB][2], a1s[NR][2], b1s[NB][2];
        if (gcount > 0) ld(0, a0s, b0s);
#pragma unroll 1
        for (int i = 0; i < gcount; i += 2) {
            if (i + 1 < gcount) ld(i + 1, a1s, b1s);
            mm(a0s, b0s);
            if (i + 1 < gcount) { if (i + 2 < gcount) ld(i + 2, a0s, b0s); mm(a1s, b1s); }
        }
    } else {
#pragma unroll 1
        for (int i = 0; i < gcount; ++i) { bf16x8 a[NR][2], b[NB][2]; ld(i, a, b); mm(a, b); }
    }
}
__device__ __forceinline__ void skinny_reduce(const f32x4 (&acc)[8], LAS f32x4* red, int wave, int lane, f32x4& lo, f32x4& hi) {
#pragma unroll
    for (int rg = 0; rg < 8; ++rg) red[(wave * 8 + rg) * 64 + lane] = acc[rg];
    __syncthreads();
    lo = (red[(0 * 8 + wave) * 64 + lane] + red[(1 * 8 + wave) * 64 + lane]) + (red[(2 * 8 + wave) * 64 + lane] + red[(3 * 8 + wave) * 64 + lane]);
    hi = (red[(4 * 8 + wave) * 64 + lane] + red[(5 * 8 + wave) * 64 + lane]) + (red[(6 * 8 + wave) * 64 + lane] + red[(7 * 8 + wave) * 64 + lane]);
    __syncthreads();
}
__device__ __forceinline__ f32x4 unpack4(const v2u w) { return (f32x4){blo(w.x), bhi(w.x), blo(w.y), bhi(w.y)}; }
__device__ __forceinline__ v2u pack4(const f32x4 v) { v2u w; w.x = cvtpk(v[0], v[1]); w.y = cvtpk(v[2], v[3]); return w; }

constexpr bool P1_HOLE_COPY = false;
#ifndef P6_BNT
#define P6_BNT false
#endif
constexpr int P6_SAMPLE_TILES = 64;
struct OrderXcd {
    int nN, E, G, c, x, r, Rm, nfull; bool xm;
    __device__ void init(int nN_, int E_, int G_, int c_) { nN = nN_; E = E_; G = G_; c = c_; x = c_ & 7; r = c_ >> 3; Rm = (nN_ + 7) >> 3; nfull = nN_ - 8 * (Rm - 1); xm = (G_ == 256); }
    __device__ bool next(int i, pg8::Unit& u) const {
        if (!xm) { const long Lx = (long)i * G + c; if (Lx < 32L * nN) { u.pm = (int)(Lx / nN); u.pn = (int)(Lx % nN); return true; } if (Lx - 32L * nN < E) { u.pm = 32; u.pn = (int)(Lx - 32L * nN); return true; } return false; }
        if (i >= Rm) return false;
        const int pn = 8 * i + (r >> 2);
        if (pn < nN) { u.pm = 4 * x + (r & 3); u.pn = pn; return true; }
        const int sidx = x + 8 * ((r & 3) + 4 * ((r >> 2) - nfull));
        if (sidx < E) { u.pm = 32; u.pn = sidx; return true; }
        return false; }
    __device__ __forceinline__ void a_ready(const pg8::Unit&) const {}
    __device__ __forceinline__ void done(const pg8::Unit&) const {}
};
struct OrderSame { int n; __device__ bool next(int i, pg8::Unit& u) const { if (i >= n) return false; u.pm = 0; u.pn = 0; return true; }
    __device__ __forceinline__ void a_ready(const pg8::Unit&) const {} __device__ __forceinline__ void done(const pg8::Unit&) const {} };
struct OrderSlices { int np, G, c;
    __device__ bool next(int i, pg8::Unit& u) const {
        const long id = (long)i * G + c; if (id >= 256) return false;
        const int sl = (int)id & 15, p0 = (np * sl) >> 4, p1 = (np * (sl + 1)) >> 4;
        u.pm = 32; u.pn = (int)id >> 4; u.kn = 2 * p0 + ((2 * (p1 - p0)) << 16); return true; }
    __device__ __forceinline__ void a_ready(const pg8::Unit&) const {}
    __device__ __forceinline__ void done(const pg8::Unit&) const {}
};
#ifndef PH_MASK
#define PH_MASK 0x3ff
#endif
#define PH(k) ((PH_MASK >> (k)) & 1)
#ifndef REP_MASK
#define REP_MASK 0
#endif
#define REPN(k) (((REP_MASK >> (k)) & 1) ? 2 : 1)
struct Args { const float* in[21]; float* out; unsigned char* ws; };
__global__ void __launch_bounds__(NWAVES * 64, 2) mega_fwd(Args args) {
    extern __shared__ __attribute__((aligned(16))) unsigned char lds[];
    LAS unsigned char* L = (LAS unsigned char*)lds;
    volatile LAS unsigned* MISC = (volatile LAS unsigned*)(L + MISC_OFF);
    const int tid = threadIdx.x;
#define PHASE_IDS() int tid_p_ = threadIdx.x; asm volatile("" : "+v"(tid_p_)); const int lane = tid_p_ & 63, wave = __builtin_amdgcn_readfirstlane(tid_p_ >> 6), gw = vcu * NWAVES + wave; (void)lane; (void)gw
    const int G = gridDim.x, bx = blockIdx.x;
    const int vcu = (G % 8 == 0) ? (bx % 8) * (G / 8) + bx / 8 : bx;
    const int NGW = G * NWAVES;
    unsigned char* ws = args.ws; float* out = args.out;
#define INP(k) (args.in[k])
#define WSB(off) ((bf16*)(ws + (off)))
    gu32* ctl = (gu32*)(ws + WS_CTL);
    for (int u = tid; u < (LDS_BYTES - LDSCTL_OFF) / 4; u += NWAVES * 64) ((LAS unsigned*)(L + LDSCTL_OFF))[u] = 0u;
    __syncthreads();
    XcdBarrier bar = xcd_barrier_post((unsigned*)(ctl + CW_BAR), MISC + 8);
#ifdef PROBE_PHASES
    unsigned long long pt0_ = 0, probe_acc_ = 0;
#ifdef PROBE_P2SUB
#define PTS(k) do { if (PROBE_P2SUB == (k)) pt0_ = __builtin_amdgcn_s_memrealtime(); } while (0)
#define PTE(k) do { if (PROBE_P2SUB == (k)) probe_acc_ += __builtin_amdgcn_s_memrealtime() - pt0_; } while (0)
#else
#define PTS(k)
#define PTE(k)
#endif
#define PT_BEGIN(k) do { if ((PROBE_PHASES >> (k)) & 1) pt0_ = __builtin_amdgcn_s_memrealtime(); } while (0)
#define PT_END(k) do { if ((PROBE_PHASES >> (k)) & 1) probe_acc_ += __builtin_amdgcn_s_memrealtime() - pt0_; } while (0)
#else
#define PT_BEGIN(k)
#define PT_END(k)
#define PTS(k)
#define PTE(k)
#endif
#ifdef PROBE_CLOCK
    unsigned long long probe_dc_ = 0, probe_dr_ = 1;
#endif

#define SCR() ((LAS float*)(L + RING_OFF + wave * 16384))
        constexpr int I0 = 64 * 544, I1 = 32 * 128, I3 = 64 * 128, I4 = 64 * 344, I6 = 172 * 128;
        constexpr int NITEMS = I0 + 2 * I1 + I3 + 2 * I4 + I6;
        auto decode = [&](int it) -> P0Ref {
            int r = (it < NITEMS - I0) ? it + I0 : it - (NITEMS - I0);
            if (r < I0) { const int kb = r / 544, nb = r % 544; return P0Ref{INP(7) + (size_t)(64 * kb) * INW + 32 * nb, WSB(WS_WIN) + tiled_off(win_map(32 * nb), kb, 64), INW}; } r -= I0;
            if (r < I1) { const int kb = r / 128, nb = r % 128; return P0Ref{INP(9) + (size_t)(64 * kb) * DM + 32 * nb, WSB(WS_WAB) + tiled_off(32 * nb, kb, 64), DM}; } r -= I1;
            if (r < I1) { const int kb = r / 128, nb = r % 128; return P0Ref{INP(10) + (size_t)(64 * kb) * DM + 32 * nb, WSB(WS_WAB) + tiled_off(32 * nb, 32 + kb, 64), DM}; } r -= I1;
            if (r < I3) { const int kb = r / 128, nb = r % 128; return P0Ref{INP(12) + (size_t)(64 * kb) * DM + 32 * nb, WSB(WS_WO) + tiled_off(32 * nb, kb, 64), DM}; } r -= I3;
            if (r < I4) { const int kb = r / 344, nb = r % 344; return P0Ref{INP(14) + (size_t)(64 * kb) * DFF + 32 * nb, WSB(WS_WGU) + tiled_off(((32 * nb) >> 7) * 256 + ((32 * nb) & 127), kb, 64), DFF}; } r -= I4;
            if (r < I4) { const int kb = r / 344, nb = r % 344; return P0Ref{INP(15) + (size_t)(64 * kb) * DFF + 32 * nb, WSB(WS_WGU) + tiled_off(((32 * nb) >> 7) * 256 + 128 + ((32 * nb) & 127), kb, 64), DFF}; } r -= I4;
            const int kb = r / 128, nb = r % 128; return P0Ref{INP(18) + (size_t)(64 * kb) * DM + 32 * nb, WSB(WS_WD) + tiled_off(32 * nb, kb, 172), DM};
        };
    const int p1_units = (MPAD / 256) * (INW / 256), p1_hole = (p1_units % G) ? G - (p1_units % G) : 0;
    const int DEFER = 0;
    constexpr int R_AB0 = 0, R_AB1 = 2 * I1, R_O1 = R_AB1 + I3, R_GU1 = R_O1 + 2 * I4, R_D1 = R_GU1 + I6, R_IN1 = NITEMS;
    static_assert(R_D1 == NITEMS - I0, "item ranges");
#define CONVERT_RANGE(FIRST, LAST, SCRP) do { const int f_ = (FIRST), l_ = (LAST); if (f_ + gw < l_) { P0Ref cur = decode(f_ + gw); f32x4 va[8], vb[8]; p0_load(cur, va, lane); \
        for (int it = f_ + gw; it < l_; it += NGW) { const int nx = it + NGW; P0Ref nr = cur; if (nx < l_) { nr = decode(nx); p0_load(nr, vb, lane); } p0_store(cur, va, (SCRP), lane); \
            _Pragma("unroll") for (int i = 0; i < 8; ++i) va[i] = vb[i]; cur = nr; } } } while (0)
    PT_BEGIN(0);
    for (int rep_ = 0; rep_ < REPN(0); ++rep_) {
    if (PH(0)) {
        PHASE_IDS();
        f32x4 g1v[16]; load_gain(INP(6), g1v, lane);
        {
            f32x4 va[16], vb[16];
            if (gw < ROWS_R) load_row(gw < ROWS_P ? INP(0) + (size_t)gw * DM : INP(1) + (size_t)(gw - ROWS_P) * DM, va, lane);
#pragma unroll 1
            for (int m = gw; m < MPAD; m += NGW) {
                const int mn = m + NGW;
                if (mn < ROWS_R) load_row(mn < ROWS_P ? INP(0) + (size_t)mn * DM : INP(1) + (size_t)(mn - ROWS_P) * DM, vb, lane);
                if (m < ROWS_R) rms_row_pre_tiled(va, g1v, WSB(WS_XN) + tiled_off(m, 0, 64), lane);
                else {
#pragma unroll
                    for (int j = 0; j < 8; ++j) { const int c = 8 * (lane + 64 * j); *(GAS v4u*)(WSB(WS_XN) + tiled_off(m, c >> 6, 64) + (c & 63)) = (v4u){0u, 0u, 0u, 0u}; } }
#pragma unroll
                for (int j = 0; j < 16; ++j) va[j] = vb[j];
            }
        }
        CONVERT_RANGE(R_D1, R_IN1, SCR());
    }
    xcd_barrier(bar);
    }
    PT_END(0);

    PT_BEGIN(1);
    for (int rep_ = 0; rep_ < REPN(1); ++rep_) {
    if (PH(1)) {
        PHASE_IDS();
        pg8::Gemm g{WSB(WS_XN), WSB(WS_WIN), MPAD, INW, DM}; OrderXcd S; S.init(INW / 256, INW / 256, G, bx);
        pg8::EpiProj E{WSB(WS_CB), WSB(WS_UU), WSB(WS_Q), WSB(WS_K), WSB(WS_VT), WSB(WS_RAT), WSB(WS_SGB), out, (LAS bf16*)(L + XCH_OFF)};
#if defined(PROBE_CLOCK) && PROBE_CLOCK == 1
        const unsigned long long pc0_ = __builtin_amdgcn_s_memtime(), pr0_ = __builtin_amdgcn_s_memrealtime();
#endif
        pg8::gemm_phase<pg8::EpiProj, OrderXcd, false, true, true, true, false, false, true>(L + RING_OFF, g, S, E);
#if defined(PROBE_CLOCK) && PROBE_CLOCK == 1
        probe_dc_ = __builtin_amdgcn_s_memtime() - pc0_; probe_dr_ = __builtin_amdgcn_s_memrealtime() - pr0_;
#endif
        if (P1_HOLE_COPY && G == 256 && ((bx >> 3) >> 2) >= 4) {
            const int sidx = (bx & 7) + 8 * (((bx >> 3) & 3) + 4 * (((bx >> 3) >> 2) - 4));
            if (sidx >= INW / 256) { const int h = sidx - INW / 256, nh = 128 - INW / 256;
                for (int blk = h; blk < 256; blk += nh) { const int tensor = blk >> 7, b = blk & 127;
                    const GAS f32x4* src = (const GAS f32x4*)((tensor ? INP(3) : INP(2)) + ((size_t)b * 128 + 1) * 512); GAS f32x4* dst = (GAS f32x4*)(out + (tensor ? O_SV : O_SK) + (size_t)b * 128 * 512);
#pragma unroll 1
                    for (int i0 = threadIdx.x; i0 < 127 * 128; i0 += 8 * 512) {
                        const int ia = i0, ib = min(i0 + 512, 127 * 128 - 1), ic = min(i0 + 1024, 127 * 128 - 1), id = min(i0 + 1536, 127 * 128 - 1), ie = min(i0 + 2048, 127 * 128 - 1), ig = min(i0 + 2560, 127 * 128 - 1), ih = min(i0 + 3072, 127 * 128 - 1), ii = min(i0 + 3584, 127 * 128 - 1);
                        const f32x4 va = src[ia], vb = src[ib], vc = src[ic], vd = src[id], ve = src[ie], vg = src[ig], vh = src[ih], vi = src[ii];
                        dst[ia] = va; dst[ib] = vb; dst[ic] = vc; dst[id] = vd; dst[ie] = ve; dst[ig] = vg; dst[ih] = vh; dst[ii] = vi; } } } }
        if (DEFER && bx >= G - p1_hole) {
            const int hw = (bx - (G - p1_hole)) * NWAVES + wave, nhw = p1_hole * NWAVES, first = NITEMS - DEFER;
            if (first + hw < NITEMS) {
                P0Ref cur = decode(first + hw); f32x4 va[8], vb[8];
                p0_load(cur, va, lane);
                for (int it = first + hw; it < NITEMS; it += nhw) {
                    const int nx = it + nhw; P0Ref nr = cur;
                    if (nx < NITEMS) { nr = decode(nx); p0_load(nr, vb, lane); }
                    p0_store(cur, va, SCR(), lane);
#pragma unroll
                    for (int i = 0; i < 8; ++i) va[i] = vb[i];
                    cur = nr;
                }
            }
        }
#ifdef PROBE_P1_NULL
#ifdef PROBE_SAME
        { pg8::EpiNull EN{(float*)(ws + WS_CTL + 512)}; OrderSame SS{9}; pg8::gemm_phase<pg8::EpiNull, OrderSame, true, true, true, true>(L + RING_OFF, g, SS, EN); }
#else
        { pg8::EpiNull EN{(float*)(ws + WS_CTL + 512)}; pg8::gemm_phase<pg8::EpiNull, OrderXcd, true, true, true, true>(L + RING_OFF, g, S, EN); }
#endif
#endif
    }
    xcd_barrier(bar);
    }
    PT_END(1);

    PT_BEGIN(2);
    for (int rep_ = 0; rep_ < REPN(2); ++rep_) {
    if (PH(2)) {
        PHASE_IDS();
        LAS float* biasT = (LAS float*)(L + RING_OFF);
        PTS(1);
        for (int i = tid; i < 32 * 129; i += NWAVES * 64) { const int h = i / 129, d = i - h * 129;
            int bk = d;
            if (d >= 16) { bk = 16 + (int)(log2f((float)d * 0.0625f) * (16.0f / 3.0f)); bk = bk > 31 ? 31 : bk; }
            biasT[h * BIAS_LD + d] = *(const GAS float*)(INP(19) + bk * 32 + h); }
        __syncthreads();
        LAS float* sc = (LAS float*)(L + SCR_OFF + wave * SCR_WAVE);
        if (wave >= 4) CONVERT_RANGE(R_AB0, R_AB1, (LAS float*)(L + 61440 + wave * 8448));
        for (int t = gw; t < 4 * 8 * 64 * 4; t += NGW) attn_prompt_task(t, WSB(WS_Q), WSB(WS_K), WSB(WS_VT), WSB(WS_AO), INP(11), biasT, lane);
        PTE(1); PTS(2);
        if (P1_HOLE_COPY && G == 256) { for (int t = NGW - 1 - gw; t < 128 * 8; t += NGW) attn_sample_task<false>(t, WSB(WS_Q), INP(2), INP(3), out, WSB(WS_AO), INP(11), biasT, sc, lane); }
        else { for (int t = NGW - 1 - gw; t < 128 * 8; t += NGW) attn_sample_task<true>(t, WSB(WS_Q), INP(2), INP(3), out, WSB(WS_AO), INP(11), biasT, sc, lane); }
        { const int cwn = NGW > 128 * 8 ? NGW - 128 * 8 : NGW;
          if (gw < cwn) {
            for (int run = gw; run < ROWS_P / 8; run += cwn) conv_run8(8 * run, WSB(WS_CB), WSB(WS_UU), WSB(WS_AO), INP(8), lane);
            for (int m = ROWS_P + gw; m < ROWS_R; m += cwn) conv_row(m, WSB(WS_CB), WSB(WS_UU), WSB(WS_AO), INP(8), INP(4), out, lane); } }
        PTE(2); PTS(3);
        if (wave < 4) CONVERT_RANGE(R_AB0, R_AB1, (LAS float*)(L + 61440 + wave * 8448));
        PTE(3);
#ifdef PROBE_P2A
        for (int t = gw; t < 4 * 8 * 64 * 4; t += NGW) attn_prompt_task(t, WSB(WS_Q), WSB(WS_K), WSB(WS_VT), WSB(WS_AO), INP(11), biasT, lane);
#endif
#ifdef PROBE_P2S
        for (int t = NGW - 1 - gw; t < 128 * 8; t += NGW) attn_sample_task<true>(t, WSB(WS_Q), INP(2), INP(3), out, WSB(WS_AO), INP(11), biasT, sc, lane);
#endif
    }
    xcd_barrier(bar);
    }
    PT_END(2);

    PT_BEGIN(3);
    for (int rep_ = 0; rep_ < REPN(3); ++rep_) {
    if (PH(3)) {
        PHASE_IDS();
        pg8::Gemm g{WSB(WS_AO), WSB(WS_WAB), ROWS_P, DM, DM}; OrderXcd S; S.init(DM / 256, 0, G, bx);
        pg8::EpiMerged E{WSB(WS_RAT), WSB(WS_SGB), WSB(WS_MG)};
        pg8::gemm_phase<pg8::EpiMerged, OrderXcd, true, true, false, true>(L + RING_OFF, g, S, E);
        { const int fr = lane & 15, fq = lane >> 4;
#ifdef PROBE_SK2
          for (int rp_ = 0; rp_ < 2; ++rp_)
#endif
          for (int t = vcu; t < 2 * (DM / 32); t += G) { const int cp = t >> 1, rh = t & 1;
            f32x4 acc[8];
#pragma unroll
            for (int q = 0; q < 8; ++q) acc[q] = (f32x4){0.f, 0.f, 0.f, 0.f};
            const bf16* const bp[2] = {WSB(WS_WAB) + tiled_off(32 * cp + fr, 0, 64), WSB(WS_WAB) + tiled_off(32 * cp + 16 + fr, 0, 64)};
            const size_t o = (size_t)(ROWS_P + 64 * rh + 16 * (wave & 3) + fr) * DM + 32 * cp + 16 * (wave >> 2) + 4 * fq;
            const v2u rat_ = *(const GAS v2u*)(WSB(WS_RAT) + o), sgb_ = *(const GAS v2u*)(WSB(WS_SGB) + o);
            skinny_ksplit<2, 4, true>(acc, WSB(WS_AO) + (size_t)(ROWS_P + 64 * rh) * DM, DM, 64, bp, 16384, (wave >> 2) * 32 + (wave & 3), 4, 8, vcu & 7, fr, fq);
            f32x4 lo, hi; skinny_reduce(acc, (LAS f32x4*)(L + RING_OFF), wave, lane, lo, hi);
            *(GAS v2u*)(WSB(WS_MG) + o) = pack4((lo * unpack4(rat_) + hi) * unpack4(sgb_));
          } }
        CONVERT_RANGE(R_AB1, R_O1, SCR());
    }
    xcd_barrier(bar);
    }
    PT_END(3);

    PT_BEGIN(4);
    for (int rep_ = 0; rep_ < REPN(4); ++rep_) {
    if (PH(4)) {
        PHASE_IDS();
        pg8::Gemm g{WSB(WS_MG), WSB(WS_WO), ROWS_P, DM, DM}; OrderXcd S; S.init(DM / 256, 0, G, bx);
        pg8::EpiResidB<false> E{INP(0), WSB(WS_X1), WSB(WS_XN), INP(13), (float*)(ws + WS_PART1)};
        pg8::gemm_phase<pg8::EpiResidB<false>, OrderXcd, true, true, false, true>(L + RING_OFF, g, S, E);
        { OrderSlices S2{DM / 128, G, bx}; pg8::EpiSlab E2{(float*)(ws + WS_SLAB4), DM / 128};
          pg8::gemm_phase<pg8::EpiSlab, OrderSlices, false, true, false, true, false, true>(L + RING_OFF, g, S2, E2); }
    }
    xcd_barrier(bar);
    }
    PT_END(4);

    PT_BEGIN(5);
    for (int rep_ = 0; rep_ < REPN(5); ++rep_) {
    if (PH(5)) { PHASE_IDS();
        for (int m0 = gw; m0 < ROWS_P; m0 += 4 * NGW) { f32x4 p[4];
#pragma unroll
            for (int i = 0; i < 4; ++i) { const int m = m0 + i * NGW; p[i] = (f32x4){0.f, 0.f, 0.f, 0.f}; if (m < ROWS_P) p[i] = *(const GAS f32x4*)((const float*)(ws + WS_PART1) + (size_t)m * 256 + 4 * lane); }
#pragma unroll
            for (int i = 0; i < 4; ++i) { const int m = m0 + i * NGW; const float ss = wave_sum((p[i].x + p[i].y) + (p[i].z + p[i].w)); if (m < ROWS_P && lane == 0) *(GAS float*)((float*)(ws + WS_RSTAT) + m) = 1.0f / sqrtf(ss * (1.0f / DM) + EPS); } }
        for (int r = bx; r < ROWS_R - ROWS_P; r += G) {
            const int c = 512 * wave + 8 * lane;
            const float* sl = (const float*)(ws + WS_SLAB4) + (size_t)r * DM + c;
            f32x4 a0 = ldg4f(INP(1) + (size_t)r * DM + c), a1 = ldg4f(INP(1) + (size_t)r * DM + c + 4);
#pragma unroll
            for (int h = 0; h < 2; ++h) { f32x4 t0[8], t1[8];
#pragma unroll
                for (int q = 0; q < 8; ++q) { t0[q] = ldg4f(sl + (size_t)(8 * h + q) * 128 * DM); t1[q] = ldg4f(sl + (size_t)(8 * h + q) * 128 * DM + 4); }
#pragma unroll
                for (int q = 0; q < 8; ++q) { a0 += t0[q]; a1 += t1[q]; } }
            float* xo = (float*)(ws + WS_X1) + (size_t)(ROWS_P + r) * DM + c;
            *(GAS f32x4*)xo = a0; *(GAS f32x4*)(xo + 4) = a1;
            const float ssw = wave_sum(((a0.x * a0.x + a0.y * a0.y) + (a0.z * a0.z + a0.w * a0.w)) + ((a1.x * a1.x + a1.y * a1.y) + (a1.z * a1.z + a1.w * a1.w)));
            LAS float* red = (LAS float*)(L + RING_OFF);
            if (lane == 0) red[wave] = ssw;
            __syncthreads();
            const float tot = ((red[0] + red[1]) + (red[2] + red[3])) + ((red[4] + red[5]) + (red[6] + red[7]));
            __syncthreads();
            if (wave == 0 && lane == 0) *(GAS float*)((float*)(ws + WS_RSTAT) + ROWS_P + r) = 1.0f / sqrtf(tot * (1.0f / DM) + EPS);
            const f32x4 y0 = a0 * ldg4f(INP(13) + c), y1 = a1 * ldg4f(INP(13) + c + 4);
            v4u w; w.x = cvtpk(y0.x, y0.y); w.y = cvtpk(y0.z, y0.w); w.z = cvtpk(y1.x, y1.y); w.w = cvtpk(y1.z, y1.w);
            *(GAS v4u*)(WSB(WS_XN) + tiled_off(ROWS_P + r, c >> 6, 64) + (c & 63)) = w;
        }
        CONVERT_RANGE(R_O1, R_GU1, SCR());
    }
    xcd_barrier(bar);
    }
    PT_END(5);

    PT_BEGIN(6);
    for (int rep_ = 0; rep_ < REPN(6); ++rep_) {
    if (PH(6)) {
        PHASE_IDS();
        pg8::Gemm g{WSB(WS_XN), WSB(WS_WGU), MPAD, 2 * DFF, DM}; OrderXcd S; S.init(2 * DFF / 256, P6_SAMPLE_TILES, G, bx);
        pg8::EpiGateUpF E{WSB(WS_F), (float*)(ws + WS_SIDEG), (float*)(ws + WS_SIDEU), INP(16), INP(17), INP(5), out, (LAS float*)(L + XCH_OFF), (const float*)(ws + WS_RSTAT)};
#if defined(PROBE_CLOCK) && PROBE_CLOCK == 6
        const unsigned long long pc6_ = __builtin_amdgcn_s_memtime(), pr6_ = __builtin_amdgcn_s_memrealtime();
#endif
        pg8::gemm_phase<pg8::EpiGateUpF, OrderXcd, true, true, true, true, P6_BNT>(L + RING_OFF, g, S, E);
#if defined(PROBE_CLOCK) && PROBE_CLOCK == 6
        probe_dc_ = __builtin_amdgcn_s_memtime() - pc6_; probe_dr_ = __builtin_amdgcn_s_memrealtime() - pr6_;
#endif
        { const int fr = lane & 15, fq = lane >> 4; LAS f32x4* red = (LAS f32x4*)(L + RING_OFF);
          for (int t = vcu; t < 2 * ((DFF - P6_SAMPLE_TILES * 128) / 16); t += G) { const int j = t >> 1, rh = t & 1;
            const int ch = P6_SAMPLE_TILES * 128 + 16 * j, nrow = (ch >> 7) * 256 + (ch & 127) + fr;
            f32x4 acc[8];
#pragma unroll
            for (int q = 0; q < 8; ++q) acc[q] = (f32x4){0.f, 0.f, 0.f, 0.f};
            const bf16* const bp[2] = {WSB(WS_WGU) + tiled_off(nrow, 0, 64), WSB(WS_WGU) + tiled_off(nrow + 128, 0, 64)};
            skinny_ksplit<2, 4, true>(acc, WSB(WS_XN) + tiled_off(ROWS_P + 64 * rh, 0, 64), 64, 16384, bp, 16384, wave, 8, 8, vcu & 7, fr, fq);
#pragma unroll
            for (int q = 0; q < 8; ++q) red[(wave * 8 + q) * 64 + lane] = acc[q];
            __syncthreads();
            if (wave < 4) {
                f32x4 gv = (f32x4){0.f, 0.f, 0.f, 0.f}, uv = (f32x4){0.f, 0.f, 0.f, 0.f};
#pragma unroll
                for (int ww = 0; ww < 8; ++ww) { gv += red[(ww * 8 + wave) * 64 + lane]; uv += red[(ww * 8 + 4 + wave) * 64 + lane]; }
                const size_t b = 64 * rh + 16 * wave + fr; const int c = ch + 4 * fq;
                { const float rs = *(const GAS float*)((const float*)(ws + WS_RSTAT) + ROWS_P + b); gv *= rs; uv *= rs; }
                const f32x4 s0 = ldg4f(INP(5) + (b * 2 + 0) * DFF + c), s1 = ldg4f(INP(5) + (b * 2 + 1) * DFF + c);
                const f32x4 gc = ((ldg4f(INP(16) + c) * s0 + ldg4f(INP(16) + DFF + c) * s1) + ldg4f(INP(16) + 2 * DFF + c) * gv) + ldg4f(INP(17) + c);
                *(GAS f32x4*)(out + O_SF + (b * 2 + 0) * DFF + c) = s1; *(GAS f32x4*)(out + O_SF + (b * 2 + 1) * DFF + c) = gv;
                *(GAS v2u*)(WSB(WS_F) + (ROWS_P + b) * DFF + c) = pack4((f32x4){silu_mul(gc[0], uv[0]), silu_mul(gc[1], uv[1]), silu_mul(gc[2], uv[2]), silu_mul(gc[3], uv[3])});
            }
            __syncthreads();
          } }
    }
    xcd_barrier(bar);
    }
    PT_END(6);

    PT_BEGIN(7);
    for (int rep_ = 0; rep_ < REPN(7); ++rep_) {
    if (PH(7)) { PHASE_IDS(); for (int idx = gw * 64 + lane; idx < 32 * 2 * (DFF / 8); idx += NGW * 64) {
        const int c = 8 * (idx % (DFF / 8)), rr = (idx / (DFF / 8)) & 1, pm = idx / (2 * (DFF / 8));
        if ((pm & 7) != 0) {
            const float* sg = (const float*)(ws + WS_SIDEG); const float* su = (const float*)(ws + WS_SIDEU);
            float g0[8], gm1[8], gm2[8], uv[8], w0[8], w1[8], w2[8], bb[8], f[8];
            ld8f(sg + ((size_t)pm * 4 + rr) * DFF + c, g0); ld8f(su + ((size_t)pm * 2 + rr) * DFF + c, uv);
            ld8f(rr == 0 ? sg + ((size_t)(pm - 1) * 4 + 3) * DFF + c : sg + ((size_t)pm * 4 + 0) * DFF + c, gm1);
            ld8f(rr == 0 ? sg + ((size_t)(pm - 1) * 4 + 2) * DFF + c : sg + ((size_t)(pm - 1) * 4 + 3) * DFF + c, gm2);
            ld8f(INP(16) + c, w0); ld8f(INP(16) + DFF + c, w1); ld8f(INP(16) + 2 * DFF + c, w2); ld8f(INP(17) + c, bb);
#pragma unroll
            for (int e = 0; e < 8; ++e) f[e] = silu_mul(((w0[e] * gm2[e] + w1[e] * gm1[e]) + w2[e] * g0[e]) + bb[e], uv[e]);
            v4u w; w.x = cvtpk(f[0], f[1]); w.y = cvtpk(f[2], f[3]); w.z = cvtpk(f[4], f[5]); w.w = cvtpk(f[6], f[7]);
            *(GAS v4u*)(WSB(WS_F) + ((size_t)pm * 256 + rr) * DFF + c) = w;
        }
    }     CONVERT_RANGE(R_GU1, R_D1, SCR());
    }
    xcd_barrier(bar);
    }
    PT_END(7);

    PT_BEGIN(8);
    if (PH(8)) {
        PHASE_IDS();
        pg8::Gemm g{WSB(WS_F), WSB(WS_WD), ROWS_P, DM, DFF}; OrderXcd S; S.init(DM / 256, 0, G, bx);
        pg8::EpiResidB<true> E{WSB(WS_X1), WSB(WS_X1) + (size_t)ROWS_P * DM, nullptr, nullptr, (float*)(ws + WS_PART2)};
        pg8::gemm_phase<pg8::EpiResidB<true>, OrderXcd, true, true, false, true>(L + RING_OFF, g, S, E);
        { OrderSlices S2{DFF / 128, G, bx}; pg8::EpiSlab E2{(float*)(ws + WS_SLAB), DFF / 128};
          pg8::gemm_phase<pg8::EpiSlab, OrderSlices, false, true, false, true, false, true>(L + RING_OFF, g, S2, E2); }
    }
    xcd_barrier(bar);
    PT_END(8);

    PT_BEGIN(9);
    if (PH(9)) { PHASE_IDS();
        const GAS f32x4* gr = (const GAS f32x4*)INP(20); f32x4 g[16];
#pragma unroll
        for (int j = 0; j < 8; ++j) { const int q = 2 * (lane + 64 * j); g[2 * j] = gr[q]; g[2 * j + 1] = gr[q + 1]; }
        v4u w[8]; f32x4 p4 = (f32x4){0.f, 0.f, 0.f, 0.f};
        if (gw < ROWS_P) { const GAS v4u* xr = (const GAS v4u*)(WSB(WS_X1) + (size_t)(ROWS_P + gw) * DM) + lane;
#pragma unroll
            for (int j = 0; j < 8; ++j) w[j] = xr[64 * j];
            p4 = *(const GAS f32x4*)((const float*)(ws + WS_PART2) + (size_t)gw * 256 + 4 * lane); }
#pragma unroll 1
        for (int m = gw; m < ROWS_P; m += NGW) {
            const int mn = m + NGW; v4u wn[8]; f32x4 pn = (f32x4){0.f, 0.f, 0.f, 0.f};
#pragma unroll
            for (int j = 0; j < 8; ++j) wn[j] = (v4u){0u, 0u, 0u, 0u};
            if (mn < ROWS_P) { const GAS v4u* xr = (const GAS v4u*)(WSB(WS_X1) + (size_t)(ROWS_P + mn) * DM) + lane;
#pragma unroll
                for (int j = 0; j < 8; ++j) wn[j] = xr[64 * j];
                pn = *(const GAS f32x4*)((const float*)(ws + WS_PART2) + (size_t)mn * 256 + 4 * lane); }
            const float r = 1.0f / sqrtf(wave_sum((p4.x + p4.y) + (p4.z + p4.w)) * (1.0f / DM) + EPS);
            GAS f32x4* orow = (GAS f32x4*)(out + O_YP + (size_t)m * DM);
#pragma unroll
            for (int j = 0; j < 8; ++j) { float x[8]; unpack8(w[j], x); const int q = 2 * (lane + 64 * j); const f32x4 g0 = g[2 * j], g1 = g[2 * j + 1];
                orow[q] = (f32x4){(x[0] * r) * g0.x, (x[1] * r) * g0.y, (x[2] * r) * g0.z, (x[3] * r) * g0.w}; orow[q + 1] = (f32x4){(x[4] * r) * g1.x, (x[5] * r) * g1.y, (x[6] * r) * g1.z, (x[7] * r) * g1.w}; }
#pragma unroll
            for (int j = 0; j < 8; ++j) w[j] = wn[j];
            p4 = pn;
        }
        for (int r = bx; r < ROWS_R - ROWS_P; r += G) {
            const int c = 512 * wave + 8 * lane;
            const float* xr = (const float*)(ws + WS_X1) + (size_t)(ROWS_P + r) * DM + c; const float* sl = (const float*)(ws + WS_SLAB) + (size_t)r * DM + c;
            f32x4 a0 = ldg4f(xr), a1 = ldg4f(xr + 4);
#pragma unroll
            for (int h = 0; h < 2; ++h) { f32x4 t0[8], t1[8];
#pragma unroll
                for (int q = 0; q < 8; ++q) { t0[q] = ldg4f(sl + (size_t)(8 * h + q) * 128 * DM); t1[q] = ldg4f(sl + (size_t)(8 * h + q) * 128 * DM + 4); }
#pragma unroll
                for (int q = 0; q < 8; ++q) { a0 += t0[q]; a1 += t1[q]; } }
            const float ssw = wave_sum(((a0.x * a0.x + a0.y * a0.y) + (a0.z * a0.z + a0.w * a0.w)) + ((a1.x * a1.x + a1.y * a1.y) + (a1.z * a1.z + a1.w * a1.w)));
            LAS float* red = (LAS float*)(L + RING_OFF);
            if (lane == 0) red[wave] = ssw;
            __syncthreads();
            const float tot = ((red[0] + red[1]) + (red[2] + red[3])) + ((red[4] + red[5]) + (red[6] + red[7]));
            __syncthreads();
            const float rr = 1.0f / sqrtf(tot * (1.0f / DM) + EPS);
            const f32x4 g0 = ldg4f(INP(20) + c), g1 = ldg4f(INP(20) + c + 4);
            float* yo = out + O_YS + (size_t)r * DM + c;
            *(GAS f32x4*)yo = (a0 * rr) * g0; *(GAS f32x4*)(yo + 4) = (a1 * rr) * g1;
        }
    }
    PT_END(9);
#ifdef PROBE_BARS
    for (int pb_ = 0; pb_ < PROBE_BARS; ++pb_) xcd_barrier(bar);
#endif
#ifdef PROBE_PHASES
#ifndef PROBE_BLOCK
#define PROBE_BLOCK 0
#endif
    if (blockIdx.x == PROBE_BLOCK) { const unsigned long long t0_ = __builtin_amdgcn_s_memrealtime(); while (__builtin_amdgcn_s_memrealtime() - t0_ < probe_acc_) __builtin_amdgcn_s_sleep(8); }
#endif
#ifdef PROBE_CLOCK
    if (blockIdx.x == 0) {
#ifdef PROBE_CYCLES
        const unsigned long long want = probe_dc_ * 20ull / 576ull, t0_ = __builtin_amdgcn_s_memrealtime();
#else
        const unsigned long long want = probe_dc_ * 5000ull / probe_dr_, t0_ = __builtin_amdgcn_s_memrealtime();
#endif
        while (__builtin_amdgcn_s_memrealtime() - t0_ < want) __builtin_amdgcn_s_sleep(8);
    }
#endif
}

extern "C" void kernel_launch(void* const* d_in, const int* in_sizes, int n_in, void* d_out, int out_size, void* d_ws, size_t ws_size, hipStream_t stream) {
    static int grid = 0;
    if (grid == 0) {
        if (n_in != 21 || in_sizes[0] != ROWS_P * DM || (size_t)out_size != O_END || ws_size < WS_END) {
            fprintf(stderr, "kernel_launch: built for 21 inputs, x_prompt of %d floats, %zu outputs, >= %zu bytes of workspace; got n_in %d, in0 %d, out %d, ws %zu; nothing launched\n", ROWS_P * DM, (size_t)O_END, (size_t)WS_END, n_in, n_in > 0 ? in_sizes[0] : -1, out_size, ws_size);
            grid = -1; return; }
        int dev = 0, cus = 0, per_cu = 0;
        if (hipGetDevice(&dev) != hipSuccess || hipDeviceGetAttribute(&cus, hipDeviceAttributeMultiprocessorCount, dev) != hipSuccess) { fprintf(stderr, "kernel_launch: hipGetDevice / hipDeviceGetAttribute failed; nothing launched\n"); grid = -1; return; }
        if (hipFuncSetAttribute((const void*)mega_fwd, hipFuncAttributeMaxDynamicSharedMemorySize, LDS_BYTES) != hipSuccess) { fprintf(stderr, "kernel_launch: hipFuncSetAttribute failed; nothing launched\n"); grid = -1; return; }
        if (hipOccupancyMaxActiveBlocksPerMultiprocessor(&per_cu, (const void*)mega_fwd, NWAVES * 64, LDS_BYTES) != hipSuccess || per_cu < 1)
            fprintf(stderr, "kernel_launch: note: the occupancy query reports %d workgroups per CU\n", per_cu);
        (void)hipGetLastError();
        grid = cus;
    }
    if (grid < 0) return;
    if (hipMemsetAsync((char*)d_ws + WS_CTL, 0, CTL_ZERO_BYTES, stream) != hipSuccess) { fprintf(stderr, "kernel_launch: hipMemsetAsync failed; nothing launched\n"); return; }
    Args a{};
    for (int i = 0; i < 21; ++i) a.in[i] = (const float*)d_in[i];
    a.out = (float*)d_out; a.ws = (unsigned char*)d_ws;
    hipLaunchKernelGGL(mega_fwd, dim3(grid), dim3(NWAVES * 64), LDS_BYTES, stream, a);
    const hipError_t le = hipPeekAtLastError();
    if (le != hipSuccess) fprintf(stderr, "kernel_launch: launch failed: %s (grid %d x %d threads, %d B LDS)\n", hipGetErrorName(le), grid, NWAVES * 64, LDS_BYTES);
}
```

```cpp
#include <hip/hip_runtime.h>
#include <cstdio>
#include <cstdint>
#include <cmath>
namespace pg8 {
#define PG8_LAS __attribute__((address_space(3)))
typedef unsigned short bf16_t;
typedef short bf16x8 __attribute__((ext_vector_type(8)));
typedef float f32x4 __attribute__((ext_vector_type(4)));
typedef unsigned u32x4 __attribute__((ext_vector_type(4)));
constexpr int BM = 256, BK = 64, HALF = 128, HTB = HALF * BK * 2  , STAGE_BYTES = 8 * HTB, NXCD = 8, WGM = 8;

__host__ __device__ __forceinline__ int lds_byte(int r, int c) { const int st = (r >> 4) * 2 + (c >> 5), rr = r & 15, cc = c & 31, ob = rr * 64 + cc * 2; return st * 1024 + (ob ^ (((ob >> 9) & 1) << 5)); }
__host__ __device__ __forceinline__ void stage_rc(int b, int& R, int& C) { const int st = b / 1024, sb = b % 1024, swz = sb ^ (((sb >> 9) & 1) << 5); R = (st >> 1) * 16 + swz / 64; C = (st & 1) * 32 + (swz % 64) / 2; }
__host__ __device__ __forceinline__ int perm32(int rho) { const int n = rho >> 4, i = rho & 15; return 8 * (i >> 2) + 4 * n + (i & 3); }

struct Unit { int pm, pn, kn; };
struct Gemm { const bf16_t* A; const bf16_t* Bt; int M, N, K; };

struct StaticOrder {
    int nM, nN, nwg, G, c;
    __host__ __device__ void init(int M, int N, int G_, int c_) { nM = M / BM; nN = N / BM; nwg = nM * nN; G = G_; c = c_; }
    __host__ __device__ bool next(int i, Unit& u) const {
        const long L = (long)i * G + c; if (L >= nwg) return false;
        int wgid = (int)L; { const int q = nwg / NXCD, r = nwg % NXCD, xcd = wgid % NXCD, off = wgid / NXCD; wgid = (xcd < r ? xcd * (q + 1) : r * (q + 1) + (xcd - r) * q) + off; }
        const int nig = WGM * nN, gid = wgid / nig, fm = gid * WGM, gsz = (nM - fm) < WGM ? (nM - fm) : WGM;
        u.pm = fm + ((wgid % nig) % gsz); u.pn = (wgid % nig) / gsz; return true;
    }
    __device__ __forceinline__ void a_ready(const Unit&) const {}
    __device__ __forceinline__ void done(const Unit&) const {}
};

__device__ __forceinline__ unsigned cvt_pk_bf16(float lo, float hi) { unsigned r; asm volatile("v_cvt_pk_bf16_f32 %0, %1, %2" : "=v"(r) : "v"(lo), "v"(hi)); return r; }
typedef float f32x2 __attribute__((ext_vector_type(2)));

#define PG8_GAS __attribute__((address_space(1)))
constexpr int ROWS_P = 8192, ROWS_R = 8320, ROWS_PAD = 8448, PAN_S = 32;
constexpr size_t O_YP = 0, O_YS = 33554432, O_PK = 34078720, O_PV = 34340864, O_PC = 34603008, O_PF = 34619392, O_SK = 34707456, O_SV = 43096064, O_SC = 51484672, O_SF = 52008960, O_END = 54827008;

__device__ __forceinline__ u32x4 pack8(const f32x4 a, const f32x4 b) { u32x4 w; w.x = cvt_pk_bf16(a[0], a[1]); w.y = cvt_pk_bf16(a[2], a[3]); w.z = cvt_pk_bf16(b[0], b[1]); w.w = cvt_pk_bf16(b[2], b[3]); return w; }
__device__ __forceinline__ float bf_lo(unsigned w) { return __uint_as_float(w << 16); }
__device__ __forceinline__ float bf_hi(unsigned w) { return __uint_as_float(w & 0xffff0000u); }
__device__ __forceinline__ void st16(void* p, u32x4 v) { *(PG8_GAS u32x4*)p = v; }
__device__ __forceinline__ void st16f(float* p, f32x4 v) { *(PG8_GAS f32x4*)p = v; }
__device__ __forceinline__ u32x4 ld16(const void* p) { return *(const PG8_GAS u32x4*)p; }
__device__ __forceinline__ f32x4 ld16f(const float* p) { return *(const PG8_GAS f32x4*)p; }
__device__ __forceinline__ u32x4 ld16nt(const void* p) { return __builtin_nontemporal_load((const PG8_GAS u32x4*)p); }
__device__ __forceinline__ f32x4 ld16fnt(const float* p) { return __builtin_nontemporal_load((const PG8_GAS f32x4*)p); }
__device__ __forceinline__ void st16nt(void* p, u32x4 v) { __builtin_nontemporal_store(v, (PG8_GAS u32x4*)p); }
__device__ __forceinline__ float fast_exp(float x) { return __builtin_amdgcn_exp2f(x * 1.4426950408889634f); }

struct EpiProj {
    static constexpr bool PERM = true, AFTER_DRAIN = false, MIDK = false;
    bf16_t *CB, *UU, *Q, *KB, *VT, *RAT, *SGB; float* out; PG8_LAS bf16_t* vt_lds;
    __device__ __forceinline__ void mid(f32x4 (&)[2][2][4][2], const Unit&, int, int, int, int) const {}
    __device__ __forceinline__ void operator()(const f32x4 (&acc)[2][2][4][2], const Unit& u, int wr, int wc, int fr, int fq) const {
        const int pn = u.pn, pm = u.pm;
        const int rbase = pm * BM + wr * 64 + fr;
        const int cl = wc * 32 + 8 * fq;
        const int nai = (pm == PAN_S) ? 1 : 2;
        const bool winp = ((pm & 7) == 7) && (pm < PAN_S);
        if (pn < 8 || (pn >= 24 && pn < 34)) {
            bf16_t* base; int ld, c0;
            if (pn < 8) { base = CB; ld = 2048; c0 = pn * 256; }
            else if (pn < 32) { base = Q; ld = 2048; c0 = (pn - 24) * 256; }
            else { base = KB; ld = 512; c0 = (pn - 32) * 256; }
#pragma unroll
            for (int ai = 0; ai < 2; ++ai) if (ai < nai)
#pragma unroll
                for (int m = 0; m < 4; ++m) { const int row = rbase + ai * HALF + m * 16;
#pragma unroll
                    for (int bj = 0; bj < 2; ++bj) st16nt(base + (size_t)row * ld + c0 + bj * HALF + cl, pack8(acc[ai][bj][m][0], acc[ai][bj][m][1])); }
            if (pn >= 32) {
                if (pm == PAN_S) {
#pragma unroll
                    for (int m = 0; m < 4; ++m) { const int b = rbase + m * 16 - ROWS_P;
#pragma unroll
                        for (int bj = 0; bj < 2; ++bj) { float* d = out + O_SK + ((size_t)b * 128 + 127) * 512 + c0 + bj * HALF + cl; st16f(d, acc[0][bj][m][0]); st16f(d + 4, acc[0][bj][m][1]); } }
                } else if (winp) {
#pragma unroll
                    for (int m = 0; m < 4; ++m) { const int row = rbase + HALF + m * 16, b = row >> 11, j = (row & 2047) - 1920;
#pragma unroll
                        for (int bj = 0; bj < 2; ++bj) { float* d = out + O_PK + ((size_t)b * 128 + j) * 512 + c0 + bj * HALF + cl; st16f(d, acc[1][bj][m][0]); st16f(d + 4, acc[1][bj][m][1]); } }
                }
            }
        } else if (pn < 24) {
            const int c0 = (pn - 8) * 128 + cl;
#pragma unroll
            for (int ai = 0; ai < 2; ++ai) if (ai < nai)
#pragma unroll
                for (int m = 0; m < 4; ++m) { const int row = rbase + ai * HALF + m * 16;
                    const f32x4 u0 = acc[ai][0][m][0] * acc[ai][1][m][0], u1 = acc[ai][0][m][1] * acc[ai][1][m][1];
                    st16nt(UU + (size_t)row * 2048 + c0, pack8(u0, u1));
                    if (pm == PAN_S) { float* d = out + O_SC + ((size_t)(row - ROWS_P) * 2 + 1) * 2048 + c0; st16f(d, u0); st16f(d + 4, u1); }
                    else if (winp && ai == 1 && m == 3 && wr == 1 && fr >= 14) { float* d = out + O_PC + ((size_t)(row >> 11) * 2 + (fr - 14)) * 2048 + c0; st16f(d, u0); st16f(d + 4, u1); }
                }
        } else if (pn < 36) {
            const int c0 = (pn - 34) * 256;
            if (pm < PAN_S) {
                PG8_LAS bf16_t* T = vt_lds + (wr * 4 + wc) * 512;
                const int l = fr + 16 * fq, rch = l >> 1, rh = l & 1;
#pragma unroll
                for (int ai = 0; ai < 2; ++ai)
#pragma unroll
                    for (int m = 0; m < 4; ++m)
#pragma unroll
                        for (int bj = 0; bj < 2; ++bj) {
#pragma unroll
                            for (int n = 0; n < 2; ++n) { const f32x4 v = acc[ai][bj][m][n]; const unsigned w0 = cvt_pk_bf16(v[0], v[1]), w1 = cvt_pk_bf16(v[2], v[3]);
                                PG8_LAS bf16_t* t = T + (8 * fq + 4 * n) * 16 + fr;
                                t[0] = (bf16_t)(w0 & 0xffffu); t[16] = (bf16_t)(w0 >> 16); t[32] = (bf16_t)(w1 & 0xffffu); t[48] = (bf16_t)(w1 >> 16); }
                            asm volatile("" ::: "memory");
                            const u32x4 tv = *(const PG8_LAS u32x4*)(T + rch * 16 + 8 * rh);
                            asm volatile("" ::: "memory");
                            st16nt(VT + (size_t)(c0 + bj * HALF + wc * 32 + rch) * ROWS_PAD + pm * BM + ai * HALF + wr * 64 + m * 16 + 8 * rh, tv); }
            }
            if (pm == PAN_S) {
#pragma unroll
                for (int m = 0; m < 4; ++m) { const int b = rbase + m * 16 - ROWS_P;
#pragma unroll
                    for (int bj = 0; bj < 2; ++bj) { float* d = out + O_SV + ((size_t)b * 128 + 127) * 512 + c0 + bj * HALF + cl; st16f(d, acc[0][bj][m][0]); st16f(d + 4, acc[0][bj][m][1]); } }
            } else if (winp) {
#pragma unroll
                for (int m = 0; m < 4; ++m) { const int row = rbase + HALF + m * 16, b = row >> 11, j = (row & 2047) - 1920;
#pragma unroll
                    for (int bj = 0; bj < 2; ++bj) { float* d = out + O_PV + ((size_t)b * 128 + j) * 512 + c0 + bj * HALF + cl; st16f(d, acc[1][bj][m][0]); st16f(d + 4, acc[1][bj][m][1]); } }
            }
        } else {
            const int c0 = (pn - 36) * 128 + cl;
#pragma unroll
            for (int ai = 0; ai < 2; ++ai) if (ai < nai)
#pragma unroll
                for (int m = 0; m < 4; ++m) { const int row = rbase + ai * HALF + m * 16;
                    f32x4 rt[2], sb[2];
#pragma unroll
                    for (int n = 0; n < 2; ++n)
#pragma unroll
                        for (int e = 0; e < 4; ++e) { const float ea = 1.0f + fast_exp(-acc[ai][0][m][n][e]), eb = 1.0f + fast_exp(-acc[ai][1][m][n][e]);
                            sb[n][e] = __builtin_amdgcn_rcpf(eb); rt[n][e] = eb * __builtin_amdgcn_rcpf(ea); }
                    st16nt(RAT + (size_t)row * 4096 + c0, pack8(rt[0], rt[1])); st16nt(SGB + (size_t)row * 4096 + c0, pack8(sb[0], sb[1])); }
        }
    }
};

struct EpiMerged {
    static constexpr bool PERM = true, AFTER_DRAIN = false, MIDK = true;
    const bf16_t *RAT, *SGB; bf16_t* MG;
    __device__ __forceinline__ void scale(f32x4 (&acc)[2][2][4][2], const bf16_t* S, const Unit& u, int wr, int wc, int fr, int fq) const {
        int rbase = u.pm * BM + wr * 64 + fr; const int c0 = u.pn * BM + wc * 32 + 8 * fq, nai = (u.pm == PAN_S) ? 1 : 2;
        asm volatile("" : "+v"(rbase));
        u32x4 r[2][4][2];
#pragma unroll
        for (int ai = 0; ai < 2; ++ai) if (ai < nai)
#pragma unroll
            for (int m = 0; m < 4; ++m)
#pragma unroll
                for (int bj = 0; bj < 2; ++bj) r[ai][m][bj] = ld16nt(S + (size_t)(rbase + ai * HALF + m * 16) * 4096 + c0 + bj * HALF);
#pragma unroll
        for (int ai = 0; ai < 2; ++ai) if (ai < nai)
#pragma unroll
            for (int m = 0; m < 4; ++m)
#pragma unroll
                for (int bj = 0; bj < 2; ++bj) { const u32x4 q = r[ai][m][bj];
                    acc[ai][bj][m][0] *= (f32x4){bf_lo(q.x), bf_hi(q.x), bf_lo(q.y), bf_hi(q.y)}; acc[ai][bj][m][1] *= (f32x4){bf_lo(q.z), bf_hi(q.z), bf_lo(q.w), bf_hi(q.w)}; }
    }
    __device__ __forceinline__ void mid(f32x4 (&acc)[2][2][4][2], const Unit& u, int wr, int wc, int fr, int fq) const { scale(acc, RAT, u, wr, wc, fr, fq); }
    __device__ __forceinline__ void operator()(f32x4 (&acc)[2][2][4][2], const Unit& u, int wr, int wc, int fr, int fq) const {
        scale(acc, SGB, u, wr, wc, fr, fq);
        const int rbase = u.pm * BM + wr * 64 + fr, c0 = u.pn * BM + wc * 32 + 8 * fq, nai = (u.pm == PAN_S) ? 1 : 2;
#pragma unroll
        for (int ai = 0; ai < 2; ++ai) if (ai < nai)
#pragma unroll
            for (int m = 0; m < 4; ++m) { const int row = rbase + ai * HALF + m * 16;
#pragma unroll
                for (int bj = 0; bj < 2; ++bj) st16(MG + (size_t)row * 4096 + c0 + bj * HALF, pack8(acc[ai][bj][m][0], acc[ai][bj][m][1])); }
    }
};

template <bool BASE_BF16> struct EpiResidB {
    static constexpr bool PERM = true, AFTER_DRAIN = false, MIDK = false;
    const void* base; bf16_t* Xo; bf16_t* XN2; const float* g2; float* part;
    __device__ __forceinline__ void mid(f32x4 (&)[2][2][4][2], const Unit&, int, int, int, int) const {}
    __device__ __forceinline__ void operator()(const f32x4 (&acc)[2][2][4][2], const Unit& u, int wr, int wc, int fr, int fq) const {
        const int rbase = u.pm * BM + wr * 64 + fr, c0 = u.pn * BM + wc * 32 + 8 * fq;
        f32x4 gv[2][2];
        if (XN2) {
#pragma unroll
            for (int bj = 0; bj < 2; ++bj)
#pragma unroll
                for (int n = 0; n < 2; ++n) gv[bj][n] = ld16f(g2 + c0 + bj * HALF + 4 * n); }
        u32x4 wb[2][4][2];
        if (BASE_BF16) {
#pragma unroll
            for (int ai = 0; ai < 2; ++ai)
#pragma unroll
                for (int m = 0; m < 4; ++m)
#pragma unroll
                    for (int bj = 0; bj < 2; ++bj) wb[ai][m][bj] = ld16nt((const bf16_t*)base + (size_t)(rbase + ai * HALF + m * 16) * 4096 + c0 + bj * HALF); }
#pragma unroll
        for (int ai = 0; ai < 2; ++ai) {
            f32x4 xb[4][2][2];
            if (!BASE_BF16) {
#pragma unroll
                for (int m = 0; m < 4; ++m)
#pragma unroll
                    for (int bj = 0; bj < 2; ++bj) { const size_t o = (size_t)(rbase + ai * HALF + m * 16) * 4096 + c0 + bj * HALF; xb[m][bj][0] = ld16fnt((const float*)base + o); xb[m][bj][1] = ld16fnt((const float*)base + o + 4); } }
#pragma unroll
            for (int m = 0; m < 4; ++m) { const int row = rbase + ai * HALF + m * 16; f32x4 xo[2][2]; float ss = 0.f;
#pragma unroll
                for (int bj = 0; bj < 2; ++bj) {
                    if (BASE_BF16) { const u32x4 w = wb[ai][m][bj];
                        xo[bj][0] = (f32x4){bf_lo(w.x), bf_hi(w.x), bf_lo(w.y), bf_hi(w.y)} + acc[ai][bj][m][0]; xo[bj][1] = (f32x4){bf_lo(w.z), bf_hi(w.z), bf_lo(w.w), bf_hi(w.w)} + acc[ai][bj][m][1]; }
                    else { xo[bj][0] = xb[m][bj][0] + acc[ai][bj][m][0]; xo[bj][1] = xb[m][bj][1] + acc[ai][bj][m][1]; } }
#pragma unroll
                for (int bj = 0; bj < 2; ++bj) { st16(Xo + (size_t)row * 4096 + c0 + bj * HALF, pack8(xo[bj][0], xo[bj][1]));
#pragma unroll
                    for (int n = 0; n < 2; ++n) ss += (xo[bj][n][0] * xo[bj][n][0] + xo[bj][n][1] * xo[bj][n][1]) + (xo[bj][n][2] * xo[bj][n][2] + xo[bj][n][3] * xo[bj][n][3]);
                    if (XN2) { const int c = c0 + bj * HALF; st16(XN2 + ((size_t)(row >> 8) * 64 + (c >> 6)) * 16384 + (size_t)(row & 255) * 64 + (c & 63), pack8(xo[bj][0] * gv[bj][0], xo[bj][1] * gv[bj][1])); } }
                *(PG8_GAS float*)(part + (size_t)row * 256 + 16 * u.pn + 4 * wc + fq) = ss; }
            asm volatile("" ::: "memory"); }
    }
};

struct EpiGateUpF {
    static constexpr bool PERM = true, AFTER_DRAIN = false, MIDK = false;
    bf16_t* F; float* sideG; float* sideU; const float* cw; const float* cbias; const float* st; float* out; PG8_LAS float* xch; const float* rstat;
    __device__ __forceinline__ void mid(f32x4 (&)[2][2][4][2], const Unit&, int, int, int, int) const {}
    static __device__ __forceinline__ float rot1(float x, int idx) { return __builtin_bit_cast(float, __builtin_amdgcn_ds_bpermute(idx, __builtin_bit_cast(int, x))); }
    static __device__ __forceinline__ f32x4 rot(const f32x4 v, int idx) {
        const float a = rot1(v.x, idx), b = rot1(v.y, idx), c = rot1(v.z, idx), d = rot1(v.w, idx);
        return (f32x4){a, b, c, d}; }
    static __device__ __forceinline__ f32x4 silu_mul4(const f32x4 gc, const f32x4 u) { f32x4 r;
#pragma unroll
        for (int e = 0; e < 4; ++e) r[e] = gc[e] * __builtin_amdgcn_rcpf(1.0f + __builtin_amdgcn_exp2f(-gc[e] * 1.4426950408889634f)) * u[e];
        return r; }
    __device__ __forceinline__ void operator()(f32x4 (&acc)[2][2][4][2], const Unit& u, int wr, int wc, int fr, int fq) const {
        const int pn = u.pn, pm = u.pm;
        const int cl = wc * 32 + 8 * fq, c0 = pn * 128 + cl;
        const int rbase = pm * BM + wr * 64 + fr;
        f32x4 w0[2], w1[2], w2[2], bb[2];
#pragma unroll
        for (int n = 0; n < 2; ++n) { w0[n] = ld16f(cw + c0 + 4 * n); w1[n] = ld16f(cw + 11008 + c0 + 4 * n); w2[n] = ld16f(cw + 2 * 11008 + c0 + 4 * n); bb[n] = ld16f(cbias + c0 + 4 * n); }
        {
            float rs[2][4];
#pragma unroll
            for (int ai = 0; ai < 2; ++ai)
#pragma unroll
                for (int m = 0; m < 4; ++m) rs[ai][m] = *(const PG8_GAS float*)(rstat + pm * BM + wr * 64 + fr + ai * HALF + m * 16);
#pragma unroll
            for (int ai = 0; ai < 2; ++ai)
#pragma unroll
                for (int bj = 0; bj < 2; ++bj)
#pragma unroll
                    for (int m = 0; m < 4; ++m)
#pragma unroll
                        for (int n = 0; n < 2; ++n) acc[ai][bj][m][n] *= rs[ai][m];
        }
        if (pm == PAN_S) {
            f32x4 s0[4][2], s1[4][2];
#pragma unroll
            for (int m = 0; m < 4; ++m)
#pragma unroll
                for (int n = 0; n < 2; ++n) { const int b = rbase + m * 16 - ROWS_P; s0[m][n] = ld16f(st + ((size_t)b * 2 + 0) * 11008 + c0 + 4 * n); s1[m][n] = ld16f(st + ((size_t)b * 2 + 1) * 11008 + c0 + 4 * n); }
#pragma unroll
            for (int m = 0; m < 4; ++m) { const int b = rbase + m * 16 - ROWS_P; f32x4 f[2];
#pragma unroll
                for (int n = 0; n < 2; ++n) { const f32x4 g = acc[0][0][m][n];
                    st16f(out + O_SF + ((size_t)b * 2 + 0) * 11008 + c0 + 4 * n, s1[m][n]); st16f(out + O_SF + ((size_t)b * 2 + 1) * 11008 + c0 + 4 * n, g);
                    f[n] = silu_mul4(((w0[n] * s0[m][n] + w1[n] * s1[m][n]) + w2[n] * g) + bb[n], acc[0][1][m][n]); }
                st16nt(F + (size_t)(rbase + m * 16) * 11008 + c0, pack8(f[0], f[1])); }
            asm volatile("s_waitcnt lgkmcnt(0)" ::: "memory"); __builtin_amdgcn_s_barrier(); asm volatile("" ::: "memory");
            return;
        }
        if (fr >= 14) {
#pragma unroll
            for (int ai = 0; ai < 2; ++ai)
#pragma unroll
                for (int n = 0; n < 2; ++n) *(PG8_LAS f32x4*)(xch + ((ai * 2 + wr) * 2 + (fr - 14)) * 128 + cl + 4 * n) = acc[ai][0][3][n];
        }
        asm volatile("s_waitcnt lgkmcnt(0)" ::: "memory"); __builtin_amdgcn_s_barrier(); asm volatile("" ::: "memory");
        const int lane_ = fr + 16 * fq, i1 = ((lane_ & 48) | ((fr + 15) & 15)) << 2, i2 = ((lane_ & 48) | ((fr + 14) & 15)) << 2;
        const bool winp = ((pm & 7) == 7);
#pragma unroll
        for (int ai = 0; ai < 2; ++ai) {
            f32x4 c1[2], c2[2];
            if (ai == 0 && wr == 0) {
#pragma unroll
                for (int n = 0; n < 2; ++n) { c1[n] = (f32x4){0.f, 0.f, 0.f, 0.f}; c2[n] = (f32x4){0.f, 0.f, 0.f, 0.f}; }
            } else {
                const int sa = (wr == 1) ? ai : ai - 1, sw = (wr == 1) ? 0 : 1;
#pragma unroll
                for (int n = 0; n < 2; ++n) { const f32x4 l2 = *(const PG8_LAS f32x4*)(xch + ((sa * 2 + sw) * 2 + 0) * 128 + cl + 4 * n), l1 = *(const PG8_LAS f32x4*)(xch + ((sa * 2 + sw) * 2 + 1) * 128 + cl + 4 * n);
                    c1[n] = l1; c2[n] = (fr == 0) ? l2 : l1; }
            }
#pragma unroll
            for (int m = 0; m < 4; ++m) { const int row = rbase + ai * HALF + m * 16; f32x4 f[2];
#pragma unroll
                for (int n = 0; n < 2; ++n) { const f32x4 g = acc[ai][0][m][n], r1 = rot(g, i1), r2 = rot(g, i2);
                    f32x4 p1, p2;
#pragma unroll
                    for (int e = 0; e < 4; ++e) { p1[e] = (fr >= 1) ? r1[e] : c1[n][e]; p2[e] = (fr >= 2) ? r2[e] : c2[n][e]; }
                    c1[n] = r1; c2[n] = r2;
                    f[n] = silu_mul4(((w0[n] * p2 + w1[n] * p1) + w2[n] * g) + bb[n], acc[ai][1][m][n]); }
                st16nt(F + (size_t)row * 11008 + c0, pack8(f[0], f[1]));
                if (ai == 0 && m == 0 && wr == 0 && fr < 2) {
#pragma unroll
                    for (int n = 0; n < 2; ++n) { st16f(sideG + ((size_t)pm * 4 + fr) * 11008 + c0 + 4 * n, acc[0][0][0][n]); st16f(sideU + ((size_t)pm * 2 + fr) * 11008 + c0 + 4 * n, acc[0][1][0][n]); } }
                if (ai == 1 && m == 3 && wr == 1 && fr >= 14) {
#pragma unroll
                    for (int n = 0; n < 2; ++n) { st16f(sideG + ((size_t)pm * 4 + 2 + (fr - 14)) * 11008 + c0 + 4 * n, acc[1][0][3][n]);
                        if (winp) st16f(out + O_PF + ((size_t)(row >> 11) * 2 + (fr - 14)) * 11008 + c0 + 4 * n, acc[1][0][3][n]); } }
            }
        }
    }
};

struct EpiSlab {
    static constexpr bool PERM = true, AFTER_DRAIN = false, MIDK = false;
    float* slab; int np;
    __device__ __forceinline__ void mid(f32x4 (&)[2][2][4][2], const Unit&, int, int, int, int) const {}
    __device__ __forceinline__ void operator()(const f32x4 (&acc)[2][2][4][2], const Unit& u, int wr, int wc, int fr, int fq) const {
        const int sl = (8 * (u.kn & 0xffff) + np - 1) / np;
        float* sp = slab + ((size_t)sl * 128 + wr * 64 + fr) * 4096 + u.pn * BM + wc * 32 + 8 * fq;
#pragma unroll
        for (int m = 0; m < 4; ++m)
#pragma unroll
            for (int bj = 0; bj < 2; ++bj) { st16f(sp + (size_t)(m * 16) * 4096 + bj * HALF, acc[0][bj][m][0]); st16f(sp + (size_t)(m * 16) * 4096 + bj * HALF + 4, acc[0][bj][m][1]); }
    }
};
struct EpiNull {
    static constexpr bool PERM = true, AFTER_DRAIN = false, MIDK = false;
    float* sink;
    __device__ __forceinline__ void mid(f32x4 (&)[2][2][4][2], const Unit&, int, int, int, int) const {}
    __device__ __forceinline__ void operator()(const f32x4 (&acc)[2][2][4][2], const Unit& u, int wr, int wc, int fr, int fq) const {
        f32x4 s = acc[0][0][0][0];
#pragma unroll
        for (int ai = 0; ai < 2; ++ai)
#pragma unroll
            for (int bj = 0; bj < 2; ++bj)
#pragma unroll
                for (int m = 0; m < 4; ++m)
#pragma unroll
                    for (int n = 0; n < 2; ++n) s += acc[ai][bj][m][n];
        if (s[0] == 123456.789f && s[1] == 1.f && s[2] == 2.f && s[3] == 3.f) *(PG8_GAS float*)sink = s[0];
    }
};
template <class Epi, class Sched, bool ALIGN_EPI = false, bool SP2 = false, bool TA = false, bool TB = false, bool BNT = false, bool VARK = false, bool SKIP32 = false>
__device__ __forceinline__ void gemm_phase(PG8_LAS unsigned char* lds, const Gemm g, const Sched& S, const Epi& E) {
    int tid_ = threadIdx.x; asm volatile("" : "+v"(tid_));
    const int tid = tid_, wid = __builtin_amdgcn_readfirstlane(tid >> 6), lane = tid & 63, wr = wid >> 2, wc = wid & 3, fr = lane & 15, fq = lane >> 4;
    const int K = g.K, nt = K / BK;
    unsigned voffA[2], voffB[2];
#pragma unroll
    for (int i = 0; i < 2; ++i) { int R, C; stage_rc(tid * 16 + i * 8192, R, C); const int Rb = Epi::PERM ? ((R & ~31) + perm32(R & 31)) : R;
        voffA[i] = (unsigned)(R * (TA ? BK : K) + C) * 2u; voffB[i] = (unsigned)(Rb * (TB ? BK : K) + C) * 2u; }
    const size_t kstepA = TA ? (size_t)BM * BK * 2 : (size_t)(BK * 2), kstepB = TB ? (size_t)BM * BK * 2 : (size_t)(BK * 2);
    const size_t hstepA = TA ? (size_t)HALF * BK * 2 : (size_t)HALF * K * 2, hstepB = TB ? (size_t)HALF * BK * 2 : (size_t)HALF * K * 2;
    const size_t tstepA = (size_t)BM * K * 2, tstepB = (size_t)BM * K * 2;
    const unsigned ldsw = (unsigned)wid * 1024u;
    const int aoff = lds_byte(wr * 64 + fr, fq * 8), boff = lds_byte(wc * 32 + fr, fq * 8);
#define PG8_SA(b, h) (((b) * 2 + (h)) * HTB)
#define PG8_SB(b, h) ((4 + (b) * 2 + (h)) * HTB)
#define PG8_STAGE(bufoff, gbase, voff) do { _Pragma("unroll") for (int _i = 0; _i < 2; ++_i) \
        __builtin_amdgcn_global_load_lds((const unsigned*)((const char*)(gbase) + (voff)[_i]), (PG8_LAS unsigned*)(lds + (bufoff) + ldsw + _i * 8192), 16, 0, 0); } while (0)
#define PG8_STAGEB(bufoff, gbase, voff) do { if constexpr (BNT) { _Pragma("unroll") for (int _i = 0; _i < 2; ++_i) \
        __builtin_amdgcn_global_load_lds((const unsigned*)((const char*)(gbase) + (voff)[_i]), (PG8_LAS unsigned*)(lds + (bufoff) + ldsw + _i * 8192), 16, 0, 2); } else PG8_STAGE(bufoff, gbase, voff); } while (0)
#define PG8_LDA(dst, b, h) do { _Pragma("unroll") for (int m = 0; m < 4; ++m) _Pragma("unroll") for (int k = 0; k < 2; ++k) dst[m][k] = *(const PG8_LAS bf16x8*)(lds + PG8_SA(b, h) + aoff + m * 2048 + k * 1024); } while (0)
#define PG8_LDB(dst, b, h) do { _Pragma("unroll") for (int n = 0; n < 2; ++n) _Pragma("unroll") for (int k = 0; k < 2; ++k) dst[n][k] = *(const PG8_LAS bf16x8*)(lds + PG8_SB(b, h) + boff + n * 2048 + k * 1024); } while (0)
#ifdef PG8_STATIC_PRIO
#define PG8_MMA(ai, bj, At, Bt) do { _Pragma("unroll") for (int m = 0; m < 4; ++m) _Pragma("unroll") for (int n = 0; n < 2; ++n) _Pragma("unroll") for (int k = 0; k < 2; ++k) \
        acc[ai][bj][m][n] = __builtin_amdgcn_mfma_f32_16x16x32_bf16(Bt[n][k], At[m][k], acc[ai][bj][m][n], 0, 0, 0); } while (0)
#else
#define PG8_MMA(ai, bj, At, Bt) do { __builtin_amdgcn_s_setprio(1); _Pragma("unroll") for (int m = 0; m < 4; ++m) _Pragma("unroll") for (int n = 0; n < 2; ++n) _Pragma("unroll") for (int k = 0; k < 2; ++k) \
        acc[ai][bj][m][n] = __builtin_amdgcn_mfma_f32_16x16x32_bf16(Bt[n][k], At[m][k], acc[ai][bj][m][n], 0, 0, 0); __builtin_amdgcn_s_setprio(0); } while (0)
#endif
#define PG8_WAIT_V(n) asm volatile("s_waitcnt vmcnt(" #n ")" ::: "memory")
#define PG8_WAIT_L(n) asm volatile("s_waitcnt lgkmcnt(" #n ")" ::: "memory")
#define PG8_BAR __builtin_amdgcn_s_barrier()
#define PG8_SCHED __builtin_amdgcn_sched_barrier(0)
    Unit cur, nxt; int ui = 0;
    if (!S.next(0, cur)) return;
#ifdef PG8_STATIC_PRIO
    if (wr == 1) __builtin_amdgcn_s_setprio(1);
#endif
    f32x4 acc[2][2][4][2];
#pragma unroll
    for (int a = 0; a < 2; ++a)
#pragma unroll
        for (int b = 0; b < 2; ++b)
#pragma unroll
            for (int m = 0; m < 4; ++m)
#pragma unroll
                for (int n = 0; n < 2; ++n) acc[a][b][m][n] = (f32x4){0.f, 0.f, 0.f, 0.f};
    bf16x8 At[4][2], B0[2][2], B1[2][2];
    const char* cA = (const char*)g.A + (size_t)cur.pm * tstepA + (VARK ? (size_t)(cur.kn & 0xffff) * kstepA : (size_t)0); const char* cB = (const char*)g.Bt + (size_t)cur.pn * tstepB + (VARK ? (size_t)(cur.kn & 0xffff) * kstepB : (size_t)0);
    S.a_ready(cur);
    if constexpr (SP2) {
        PG8_STAGEB(PG8_SB(0, 0), cB, voffB); PG8_STAGEB(PG8_SB(0, 1), cB + hstepB, voffB); PG8_STAGE(PG8_SA(0, 0), cA, voffA); PG8_STAGE(PG8_SA(0, 1), cA + hstepA, voffA);
        if (wr == 1) PG8_BAR;
        PG8_WAIT_V(2); PG8_BAR;
        PG8_STAGEB(PG8_SB(1, 0), cB + kstepB, voffB); PG8_STAGE(PG8_SA(1, 0), cA + kstepA, voffA); PG8_STAGEB(PG8_SB(1, 1), cB + hstepB + kstepB, voffB);
        PG8_WAIT_V(6); PG8_BAR;
    } else {
        PG8_STAGEB(PG8_SB(0, 0), cB, voffB); PG8_STAGE(PG8_SA(0, 0), cA, voffA); PG8_STAGEB(PG8_SB(0, 1), cB + hstepB, voffB); PG8_STAGE(PG8_SA(0, 1), cA + hstepA, voffA);
        if (wr == 1) PG8_BAR;
        PG8_WAIT_V(4); PG8_BAR;
        PG8_STAGEB(PG8_SB(1, 0), cB + kstepB, voffB); PG8_STAGE(PG8_SA(1, 0), cA + kstepA, voffA); PG8_STAGEB(PG8_SB(1, 1), cB + hstepB + kstepB, voffB);
        PG8_WAIT_V(6); PG8_BAR;
    }
    for (;;) {
        const bool has_next = S.next(ui + 1, nxt);
        const char* nA = has_next ? (const char*)g.A + (size_t)nxt.pm * tstepA + (VARK ? (size_t)(nxt.kn & 0xffff) * kstepA : (size_t)0) : cA; const char* nB = has_next ? (const char*)g.Bt + (size_t)nxt.pn * tstepB + (VARK ? (size_t)(nxt.kn & 0xffff) * kstepB : (size_t)0) : cB;
        const int ntu = VARK ? (cur.kn >> 16) : nt;
        const bool fullm = !(VARK || SKIP32) || cur.pm < 32;
        for (int t = 0; t < ntu; t += 2) {
            if constexpr (Epi::MIDK) { if (t == (nt >> 1)) E.mid(acc, cur, wr, wc, fr, fq); }
            const bool last = (t == ntu - 2);
            const char* a1 = cA + (size_t)(t + 1) * kstepA;
            const char* a2 = last ? nA : cA + (size_t)(t + 2) * kstepA; const char* b2 = last ? nB : cB + (size_t)(t + 2) * kstepB;
            const char* a3 = a2 + kstepA; const char* b3 = b2 + kstepB;
            if (last && has_next) S.a_ready(nxt);
            if constexpr (SP2) {
            PG8_LDB(B0, 0, 0); PG8_LDB(B1, 0, 1); PG8_SCHED; PG8_LDA(At, 0, 0); PG8_STAGE(PG8_SA(1, 1), a1 + hstepA, voffA);
            PG8_WAIT_V(8); PG8_WAIT_L(0); PG8_BAR; PG8_MMA(0, 0, At, B0); PG8_MMA(0, 1, At, B1); PG8_BAR; PG8_SCHED;
            PG8_LDA(At, 0, 1); PG8_STAGEB(PG8_SB(0, 0), b2, voffB); PG8_STAGEB(PG8_SB(0, 1), b2 + hstepB, voffB); PG8_STAGE(PG8_SA(0, 0), a2, voffA);
            PG8_WAIT_V(8); PG8_WAIT_L(0); PG8_BAR; if (fullm) { PG8_MMA(1, 0, At, B0); PG8_MMA(1, 1, At, B1); } PG8_BAR; PG8_SCHED;
            PG8_LDB(B0, 1, 0); PG8_LDB(B1, 1, 1); PG8_SCHED; PG8_LDA(At, 1, 0); PG8_STAGE(PG8_SA(0, 1), a2 + hstepA, voffA);
            PG8_WAIT_V(8); PG8_WAIT_L(0); PG8_BAR; PG8_MMA(0, 0, At, B0); PG8_MMA(0, 1, At, B1); PG8_BAR; PG8_SCHED;
            PG8_LDA(At, 1, 1); PG8_STAGEB(PG8_SB(1, 0), b3, voffB); PG8_STAGEB(PG8_SB(1, 1), b3 + hstepB, voffB); PG8_STAGE(PG8_SA(1, 0), a3, voffA);
            PG8_WAIT_V(8); PG8_WAIT_L(0); PG8_BAR; if (fullm) { PG8_MMA(1, 0, At, B0); PG8_MMA(1, 1, At, B1); } PG8_BAR; PG8_SCHED;
            } else {
            PG8_LDB(B0, 0, 0); PG8_SCHED; PG8_LDA(At, 0, 0); PG8_STAGE(PG8_SA(1, 1), a1 + hstepA, voffA);
            PG8_WAIT_L(8); PG8_BAR; PG8_WAIT_L(0); PG8_MMA(0, 0, At, B0); PG8_BAR; PG8_SCHED;
            PG8_LDB(B1, 0, 1); PG8_STAGEB(PG8_SB(0, 0), b2, voffB);
            PG8_BAR; PG8_WAIT_L(0); PG8_MMA(0, 1, At, B1); PG8_BAR;
            PG8_LDA(At, 0, 1); PG8_STAGE(PG8_SA(0, 0), a2, voffA);
            PG8_BAR; PG8_WAIT_L(0); PG8_MMA(1, 0, At, B0); PG8_BAR; PG8_SCHED;
            PG8_STAGEB(PG8_SB(0, 1), b2 + hstepB, voffB);
            PG8_WAIT_V(6); PG8_BAR; PG8_MMA(1, 1, At, B1); PG8_BAR;
            PG8_LDB(B0, 1, 0); PG8_SCHED; PG8_LDA(At, 1, 0); PG8_STAGE(PG8_SA(0, 1), a2 + hstepA, voffA);
            PG8_WAIT_L(8); PG8_BAR; PG8_WAIT_L(0); PG8_MMA(0, 0, At, B0); PG8_BAR; PG8_SCHED;
            PG8_LDB(B1, 1, 1); PG8_STAGEB(PG8_SB(1, 0), b3, voffB);
            PG8_BAR; PG8_WAIT_L(0); PG8_MMA(0, 1, At, B1); PG8_BAR;
            PG8_LDA(At, 1, 1); PG8_STAGE(PG8_SA(1, 0), a3, voffA);
            PG8_BAR; PG8_WAIT_L(0); PG8_MMA(1, 0, At, B0); PG8_BAR; PG8_SCHED;
            PG8_STAGEB(PG8_SB(1, 1), b3 + hstepB, voffB);
            PG8_WAIT_V(6); PG8_BAR; PG8_MMA(1, 1, At, B1); PG8_BAR;
            }
        }
        if constexpr (ALIGN_EPI) { if (wr == 0) PG8_BAR; }
        if constexpr (!Epi::AFTER_DRAIN) { E(acc, cur, wr, wc, fr, fq); S.done(cur); }
        if (!has_next) break;
#pragma unroll
        for (int a = 0; a < 2; ++a)
#pragma unroll
            for (int b = 0; b < 2; ++b)
#pragma unroll
                for (int m = 0; m < 4; ++m)
#pragma unroll
                    for (int n = 0; n < 2; ++n) acc[a][b][m][n] = (f32x4){0.f, 0.f, 0.f, 0.f};
        cur = nxt; cA = nA; cB = nB; ++ui;
        if constexpr (ALIGN_EPI) { if (wr == 1) PG8_BAR; }
    }
#ifdef PG8_STATIC_PRIO
    __builtin_amdgcn_s_setprio(0);
#endif
    PG8_WAIT_V(0);
    if constexpr (!ALIGN_EPI) { if (wr == 0) PG8_BAR; }
    PG8_BAR;
    if constexpr (Epi::AFTER_DRAIN) { E.fused(acc, cur, wr, wc, fr, fq, lds, wid, lane); S.done(cur); }
#undef PG8_SA
#undef PG8_SB
#undef PG8_STAGE
#undef PG8_STAGEB
#undef PG8_LDA
#undef PG8_LDB
#undef PG8_MMA
#undef PG8_WAIT_V
#undef PG8_WAIT_L
#undef PG8_BAR
#undef PG8_SCHED
}
}
#define GAS __attribute__((address_space(1)))
#define LAS __attribute__((address_space(3)))
typedef unsigned short bf16;
typedef unsigned v4u __attribute__((ext_vector_type(4)));
typedef float f32x4 __attribute__((ext_vector_type(4)));
typedef short bf16x8 __attribute__((ext_vector_type(8)));
typedef GAS unsigned gu32;
typedef GAS unsigned long long gu64;
#define RLX_AGENT __ATOMIC_RELAXED, __HIP_MEMORY_SCOPE_AGENT
#define LDS_WAIT() asm volatile("s_waitcnt lgkmcnt(0)" ::: "memory")
#define VM_WAIT() asm volatile("s_waitcnt vmcnt(0)" ::: "memory")
__device__ __forceinline__ unsigned long long rt() { return __builtin_amdgcn_s_memrealtime(); }
__device__ __forceinline__ unsigned f2bf(float f) { unsigned u = __builtin_bit_cast(unsigned, f); return (u + 0x7fffu + ((u >> 16) & 1u)) >> 16; }
__device__ __forceinline__ unsigned pk2(float lo, float hi) { return f2bf(lo) | (f2bf(hi) << 16); }

#define XB_TMO      128
#define XB_XCNT(j)  (256  + 64 * (j))
#define XB_XSUB(j)  (1280 + 64 * (j))
#define XB_XGEN(j)  (2304 + 64 * (j))
#define XB_TOP      3328
#define XB_TOPGEN   3392
#define XCD_BAR_WORDS 3456
#define XB_SPIN_CAP (1u << 18)

__device__ __forceinline__ unsigned xb_ld(unsigned* p)              { return __hip_atomic_load(p, __ATOMIC_RELAXED, __HIP_MEMORY_SCOPE_AGENT); }
__device__ __forceinline__ unsigned xb_add(unsigned* p, unsigned v) { return __hip_atomic_fetch_add(p, v, __ATOMIC_RELAXED, __HIP_MEMORY_SCOPE_AGENT); }
__device__ __forceinline__ unsigned xb_xcc_id() { return (unsigned)__builtin_amdgcn_s_getreg((3 << 11) | 20) & 0xFu; }
#define XB_SPIN(cond, bar) do { unsigned _sp = 0; while (cond) { __builtin_amdgcn_s_sleep(1); \
    if ((++_sp & 255u) == 0u) { if (xb_ld(&(bar)[XB_TMO])) break; if (_sp > XB_SPIN_CAP) { atomicAdd(&(bar)[XB_TMO], 1u); break; } } } } while (0)

struct XcdBarrier {
    unsigned* bar; unsigned x;
    volatile LAS unsigned* st;
};

__device__ __forceinline__ XcdBarrier xcd_barrier_post(unsigned* bar, volatile LAS unsigned* st) {
    XcdBarrier b; b.bar = bar; b.x = xb_xcc_id(); b.st = st;
    if (threadIdx.x == 0) (void)xb_add(&bar[XB_XCNT(b.x)], 1u);
    return b;
}
__device__ __forceinline__ void xcd_barrier_complete(unsigned* bar, unsigned x, unsigned& nloc, unsigned& nx) {
    const unsigned G = gridDim.x * gridDim.y * gridDim.z;
    unsigned sum, cnt, mine, sp = 0u;
    for (;;) {
        sum = 0u; cnt = 0u; mine = 0u;
#pragma unroll
        for (unsigned j = 0; j < 16; ++j) { const unsigned c = xb_ld(&bar[XB_XCNT(j)]); sum += c; cnt += (c > 0u) ? 1u : 0u; mine = (j == x) ? c : mine; }
        if (sum == G) break;
        __builtin_amdgcn_s_sleep(1);
        if ((++sp & 255u) == 0u) { if (xb_ld(&bar[XB_TMO])) break; if (sp > XB_SPIN_CAP) { atomicAdd(&bar[XB_TMO], 1u); break; } }
    }
    nloc = mine > 0u ? mine : 1u; nx = cnt > 0u ? cnt : 1u;
}

__device__ __forceinline__ void xcd_barrier(const XcdBarrier& b) {
    asm volatile("s_waitcnt vmcnt(0)" ::: "memory");
    __syncthreads();
    if (threadIdx.x == 0) {
        unsigned* bar = b.bar;
        __builtin_amdgcn_s_waitcnt(0);
        unsigned nloc = b.st[0], nx = b.st[1];
        if (nloc == 0u) { xcd_barrier_complete(bar, b.x, nloc, nx); b.st[0] = nloc; b.st[1] = nx; }
        const unsigned old = xb_add(&bar[XB_XSUB(b.x)], 1u);
        const unsigned gen = old / nloc;
        if (old + 1u == (gen + 1u) * nloc) {
            __builtin_amdgcn_fence(__ATOMIC_RELEASE, "agent");
            asm volatile("s_waitcnt vmcnt(0)" ::: "memory");
            const unsigned og = xb_add(&bar[XB_TOP], 1u);
            const unsigned tg = og / nx;
            if (og + 1u == (tg + 1u) * nx) xb_add(&bar[XB_TOPGEN], 1u);
            else XB_SPIN(xb_ld(&bar[XB_TOPGEN]) == tg, bar);
            __builtin_amdgcn_fence(__ATOMIC_ACQUIRE, "agent");
            xb_add(&bar[XB_XGEN(b.x)], 1u);
            asm volatile("s_waitcnt vmcnt(0)" ::: "memory");
        } else {
            XB_SPIN(xb_ld(&bar[XB_XGEN(b.x)]) == gen, bar);
            __builtin_amdgcn_fence(__ATOMIC_ACQUIRE, "agent");
            asm volatile("s_waitcnt vmcnt(0)" ::: "memory");
        }
    }
    __syncthreads();
}


constexpr int NWAVES = 8;
constexpr int DM = 4096, SEQ = 2048, CONVW = 2048, KVW = 512, DFF = 11008, INW = 17408;
constexpr int ROWS_P = pg8::ROWS_P, ROWS_R = pg8::ROWS_R, MPAD = pg8::ROWS_PAD;
constexpr float EPS = 1e-5f, LOG2E = 1.4426950408889634f;
using pg8::O_YP; using pg8::O_YS; using pg8::O_SK; using pg8::O_SV; using pg8::O_SC; using pg8::O_SF; using pg8::O_END;

constexpr size_t MiB = 1u << 20;
constexpr size_t WS_CTL = 0, CTL_ZERO_BYTES = 1 * MiB;
constexpr size_t WS_WGU = 1 * MiB;
constexpr size_t WS_WD  = WS_WGU + (size_t)2 * DFF * DM * 2;
constexpr size_t WS_XN  = WS_WD + (size_t)DM * DFF * 2;
constexpr size_t WS_X1  = WS_XN + (size_t)MPAD * DM * 2;
constexpr size_t WS_A   = WS_X1 + (size_t)MPAD * DM * 4;
constexpr size_t WS_WIN = WS_A;
constexpr size_t WS_WAB = WS_WIN + (size_t)INW * DM * 2;
constexpr size_t WS_WO  = WS_WAB + (size_t)DM * DM * 2;
constexpr size_t WS_CB  = WS_WO + (size_t)DM * DM * 2;
constexpr size_t WS_UU  = WS_CB + (size_t)MPAD * 2048 * 2;
constexpr size_t WS_Q   = WS_UU + (size_t)MPAD * 2048 * 2;
constexpr size_t WS_K   = WS_Q + (size_t)MPAD * 2048 * 2;
constexpr size_t WS_VT  = WS_K + (size_t)MPAD * 512 * 2;
constexpr size_t WS_RAT = WS_VT + (size_t)MPAD * 512 * 2;
constexpr size_t WS_SGB = WS_RAT + (size_t)MPAD * DM * 2;
constexpr size_t WS_AO  = WS_SGB + (size_t)MPAD * DM * 2;
constexpr size_t WS_MG  = WS_AO + (size_t)MPAD * DM * 2;
constexpr size_t WS_A_END = WS_MG + (size_t)MPAD * DM * 2;
constexpr size_t WS_G   = WS_A;
constexpr size_t WS_U   = WS_G + (size_t)MPAD * DFF * 2;
constexpr size_t WS_F   = WS_U + (size_t)MPAD * DFF * 2;
constexpr size_t WS_OV_END = WS_F + (size_t)MPAD * DFF * 2;
constexpr size_t WS_SIDEG = WS_A_END > WS_OV_END ? WS_A_END : WS_OV_END;
constexpr size_t WS_SIDEU = WS_SIDEG + (size_t)32 * 4 * DFF * 4;
constexpr size_t WS_PART1 = WS_SIDEU + (size_t)32 * 2 * DFF * 4;
constexpr size_t WS_PART2 = WS_PART1 + (size_t)ROWS_P * 256 * 4;
constexpr size_t WS_RSTAT = WS_PART2 + (size_t)ROWS_P * 256 * 4;
constexpr size_t WS_END = WS_RSTAT + (size_t)MPAD * 4;
constexpr size_t WS_SLAB4 = WS_WIN;
constexpr size_t WS_SLAB = WS_XN;
constexpr int CW_BAR = 4096;
static_assert((CW_BAR + XCD_BAR_WORDS) * 4 <= (int)CTL_ZERO_BYTES, "control words inside the memset region");

constexpr int RING_OFF = 0, RING_BYTES = 131072;
constexpr int LDSCTL_OFF = RING_BYTES, MISC_OFF = LDSCTL_OFF + 320;
constexpr int LDS_BYTES = 147456;
static_assert(MISC_OFF + 128 <= LDS_BYTES, "LDS map");
constexpr int XCH_OFF = LDSCTL_OFF + 1024;
static_assert(XCH_OFF + 8192 <= LDS_BYTES, "LDS map");
constexpr int BIAS_LD = 132;
constexpr int SCR_OFF = 20480, SCR_WAVE = 4096;

typedef float f32x16 __attribute__((ext_vector_type(16)));
typedef short s16x4 __attribute__((ext_vector_type(4)));
typedef unsigned v2u __attribute__((ext_vector_type(2)));
__device__ __forceinline__ float blo(unsigned w) { return __uint_as_float(w << 16); }
__device__ __forceinline__ float bhi(unsigned w) { return __uint_as_float(w & 0xffff0000u); }
__device__ __forceinline__ void unpack8(const v4u w, float (&f)[8]) { f[0] = blo(w.x); f[1] = bhi(w.x); f[2] = blo(w.y); f[3] = bhi(w.y); f[4] = blo(w.z); f[5] = bhi(w.z); f[6] = blo(w.w); f[7] = bhi(w.w); }
__device__ __forceinline__ v4u ldg16(const void* p) { return *(const GAS v4u*)p; }
__device__ __forceinline__ f32x4 ldg4f(const float* p) { return *(const GAS f32x4*)p; }
__device__ __forceinline__ void ld8f(const float* p, float (&f)[8]) { const f32x4 a = ldg4f(p), b = ldg4f(p + 4); f[0] = a[0]; f[1] = a[1]; f[2] = a[2]; f[3] = a[3]; f[4] = b[0]; f[5] = b[1]; f[6] = b[2]; f[7] = b[3]; }
__device__ __forceinline__ void st8f(float* p, const float (&f)[8]) { *(GAS f32x4*)p = (f32x4){f[0], f[1], f[2], f[3]}; *(GAS f32x4*)(p + 4) = (f32x4){f[4], f[5], f[6], f[7]}; }
__device__ __forceinline__ unsigned cvtpk(float lo, float hi) { return pg8::cvt_pk_bf16(lo, hi); }
__device__ __forceinline__ float ex2(float x) { return __builtin_amdgcn_exp2f(x); }
__device__ __forceinline__ float wave_sum(float v) {
#pragma unroll
    for (int o = 1; o < 64; o <<= 1) v += __shfl_xor(v, o);
    return v;
}
__device__ __forceinline__ float wave_max(float v) {
#pragma unroll
    for (int o = 1; o < 64; o <<= 1) v = fmaxf(v, __shfl_xor(v, o));
    return v;
}

struct P0Ref { const float* src; bf16* dst; int N; };
__device__ __forceinline__ void p0_load(const P0Ref& r, f32x4 (&v)[8], int lane) {
#pragma unroll
#ifdef P0_PLAIN_LOADS
    for (int i = 0; i < 8; ++i) v[i] = *(const GAS f32x4*)(r.src + (size_t)(8 * i + (lane >> 3)) * r.N + 4 * (lane & 7));
#else
    for (int i = 0; i < 8; ++i) v[i] = __builtin_nontemporal_load((const GAS f32x4*)(r.src + (size_t)(8 * i + (lane >> 3)) * r.N + 4 * (lane & 7)));
#endif
}
__device__ __forceinline__ void p0_store(const P0Ref& r, const f32x4 (&v)[8], LAS float* scr, int lane) {
#pragma unroll
    for (int i = 0; i < 8; ++i) { LAS float* w = scr + (8 * i + (lane >> 3)) * 33 + 4 * (lane & 7); w[0] = v[i][0]; w[1] = v[i][1]; w[2] = v[i][2]; w[3] = v[i][3]; }
    LDS_WAIT(); asm volatile("" ::: "memory");
    const int c = lane & 7;
#pragma unroll
    for (int j = 0; j < 4; ++j) { const int n = (lane >> 3) + 8 * j; const LAS float* q = scr + (8 * c) * 33 + n;
        v4u o; o.x = cvtpk(q[0 * 33], q[1 * 33]); o.y = cvtpk(q[2 * 33], q[3 * 33]); o.z = cvtpk(q[4 * 33], q[5 * 33]); o.w = cvtpk(q[6 * 33], q[7 * 33]);
        *(GAS v4u*)(r.dst + (size_t)n * 64 + 8 * c) = o; }
    LDS_WAIT(); asm volatile("" ::: "memory");
}
__host__ __device__ __forceinline__ int win_map(int n) {
    if (n < 2048) return n;
    if (n < 6144) { int t = n - 2048; const int h = t >= 2048 ? 1 : 0; t -= h * 2048; return 2048 + (t >> 7) * 256 + h * 128 + (t & 127); }
    if (n < 9216) return n;
    int t = n - 9216; const int h = t >= 4096 ? 1 : 0; t -= h * 4096; return 9216 + (t >> 7) * 256 + h * 128 + (t & 127);
}
__host__ __device__ __forceinline__ size_t tiled_off(int n, int kt, int nt) { return ((size_t)(n >> 8) * nt + kt) * 16384 + (size_t)(n & 255) * 64; }
__device__ __forceinline__ void load_gain(const float* g, f32x4 (&gv)[16], int lane) {
    const GAS f32x4* gr = (const GAS f32x4*)g + lane;
#pragma unroll
    for (int j = 0; j < 16; ++j) gv[j] = gr[64 * j];
}
template <bool OUT_BF16, bool TILED = false> __device__ __forceinline__ void rms_row(const float* xrow, const f32x4 (&gv)[16], void* orow, int lane) {
    const GAS f32x4* xr = (const GAS f32x4*)xrow + lane;
    f32x4 v[16]; float s = 0.f;
#pragma unroll
    for (int j = 0; j < 16; ++j) { v[j] = xr[64 * j]; s += (v[j].x * v[j].x + v[j].y * v[j].y) + (v[j].z * v[j].z + v[j].w * v[j].w); }
    const float r = 1.0f / sqrtf(wave_sum(s) * (1.0f / DM) + EPS);
#pragma unroll
    for (int j = 0; j < 16; ++j) { const f32x4 y = (v[j] * r) * gv[j];
        if (OUT_BF16) { v2u w; w.x = cvtpk(y.x, y.y); w.y = cvtpk(y.z, y.w);
            if (TILED) { const int c = 4 * (lane + 64 * j); *(GAS v2u*)((bf16*)orow + (size_t)(c >> 6) * 16384 + (c & 63)) = w; } else ((GAS v2u*)orow)[lane + 64 * j] = w; }
        else ((GAS f32x4*)orow)[lane + 64 * j] = y; }
}

__device__ __forceinline__ void load_row(const float* xrow, f32x4 (&v)[16], int lane) {
    const GAS f32x4* xr = (const GAS f32x4*)xrow + lane;
#pragma unroll
    for (int j = 0; j < 16; ++j) v[j] = __builtin_nontemporal_load(xr + 64 * j);
}
__device__ __forceinline__ void rms_row_pre_tiled(const f32x4 (&v)[16], const f32x4 (&gv)[16], bf16* orow, int lane) {
    float s = 0.f;
#pragma unroll
    for (int j = 0; j < 16; ++j) s += (v[j].x * v[j].x + v[j].y * v[j].y) + (v[j].z * v[j].z + v[j].w * v[j].w);
    const float r = 1.0f / sqrtf(wave_sum(s) * (1.0f / DM) + EPS);
#pragma unroll
    for (int j = 0; j < 16; ++j) { const f32x4 y = (v[j] * r) * gv[j]; v2u w; w.x = cvtpk(y.x, y.y); w.y = cvtpk(y.z, y.w); const int c = 4 * (lane + 64 * j);
        *(GAS v2u*)(orow + (size_t)(c >> 6) * 16384 + (c & 63)) = w; }
}
__device__ __forceinline__ void rms_raw_row(const float* xrow, const f32x4 (&gv)[16], bf16* orow, float* rstat, int lane) {
    const GAS f32x4* xr = (const GAS f32x4*)xrow + lane;
    f32x4 v[16]; float s = 0.f;
#pragma unroll
    for (int j = 0; j < 16; ++j) { v[j] = xr[64 * j]; s += (v[j].x * v[j].x + v[j].y * v[j].y) + (v[j].z * v[j].z + v[j].w * v[j].w); }
    const float r = 1.0f / sqrtf(wave_sum(s) * (1.0f / DM) + EPS);
    if (lane == 0) *(GAS float*)rstat = r;
#pragma unroll
    for (int j = 0; j < 16; ++j) { const f32x4 y = v[j] * gv[j]; v2u w; w.x = cvtpk(y.x, y.y); w.y = cvtpk(y.z, y.w); const int c = 4 * (lane + 64 * j);
        *(GAS v2u*)(orow + (size_t)(c >> 6) * 16384 + (c & 63)) = w; }
}
__device__ __forceinline__ float row16_sum(float v) {
    v += __builtin_bit_cast(float, __builtin_amdgcn_update_dpp(0, __builtin_bit_cast(int, v), 0xB1, 0xF, 0xF, false));
    v += __builtin_bit_cast(float, __builtin_amdgcn_update_dpp(0, __builtin_bit_cast(int, v), 0x4E, 0xF, 0xF, false));
    v += __builtin_bit_cast(float, __builtin_amdgcn_update_dpp(0, __builtin_bit_cast(int, v), 0x141, 0xF, 0xF, false));
    v += __builtin_bit_cast(float, __builtin_amdgcn_update_dpp(0, __builtin_bit_cast(int, v), 0x140, 0xF, 0xF, false));
    return v;
}
__device__ __forceinline__ int crow(int r, int hi) { return (r & 3) + 8 * (r >> 2) + 4 * hi; }
__device__ __forceinline__ void attn_prompt_task(int t, const bf16* Q, const bf16* KB, const bf16* VT, bf16* AO, const float* sinks, const LAS float* biasT, int lane) {
    const int g = t & 3, i32 = (t >> 2) & 63, kvh = (t >> 8) & 7, b = t >> 11, head = kvh * 4 + g;
    const int r32 = lane & 31, hi = lane >> 5;
    const int rowbase = b * SEQ, t0 = i32 * 32;
    const int kb_lo = (t0 >= 128) ? 0 : ((128 - t0) >> 5);
    bf16x8 qf[4];
    { const bf16* qp = Q + (size_t)(rowbase + t0 + r32) * 2048 + head * 64 + hi * 8;
#pragma unroll
      for (int ks = 0; ks < 4; ++ks) qf[ks] = *(const GAS bf16x8*)(qp + ks * 16); }
    f32x16 s[5];
    bf16x8 kf[5][4];
#pragma unroll
    for (int kb = 0; kb < 5; ++kb) if (kb >= kb_lo) {
        const bf16* kp = KB + (size_t)(rowbase + t0 - 128 + 32 * kb + r32) * KVW + kvh * 64 + hi * 8;
#pragma unroll
        for (int ks = 0; ks < 4; ++ks) kf[kb][ks] = *(const GAS bf16x8*)(kp + ks * 16);
    }
#pragma unroll
    for (int kb = 0; kb < 5; ++kb) {
#pragma unroll
        for (int r = 0; r < 16; ++r) s[kb][r] = 0.f;
        if (kb >= kb_lo) {
#pragma unroll
            for (int ks = 0; ks < 4; ++ks) s[kb] = __builtin_amdgcn_mfma_f32_32x32x16_bf16(kf[kb][ks], qf[ks], s[kb], 0, 0, 0);
        }
    }
    __builtin_amdgcn_sched_barrier(0);
    v2u vl[5][2][2], vh[5][2][2];
#pragma unroll
    for (int kb = 0; kb < 5; ++kb) if (kb >= kb_lo) {
#pragma unroll
        for (int sx = 0; sx < 2; ++sx) { const int tk = rowbase + t0 - 128 + 32 * kb + 16 * sx;
#pragma unroll
            for (int db = 0; db < 2; ++db) { const bf16* vp = VT + (size_t)(kvh * 64 + db * 32 + r32) * MPAD + tk + 4 * hi;
                vl[kb][sx][db] = *(const GAS v2u*)vp; vh[kb][sx][db] = *(const GAS v2u*)(vp + 8); } }
    }
    const LAS float* bt = biasT + head * BIAS_LD;
    const float sink = *(const GAS float*)(sinks + head);
    float mx = sink;
#pragma unroll
    for (int kb = 0; kb < 5; ++kb)
#pragma unroll
        for (int r = 0; r < 16; ++r) {
            const int dist = r32 + 128 - 32 * kb - crow(r, hi);
            const bool valid = (kb >= kb_lo) && dist >= 0 && dist <= 128;
            const int dc = dist < 0 ? 0 : (dist > 128 ? 128 : dist);
            float v = s[kb][r] * 0.125f + bt[dc];
            v = valid ? v : -INFINITY;
            s[kb][r] = v; mx = fmaxf(mx, v);
        }
    mx = fmaxf(mx, __shfl_xor(mx, 32));
    float sum = 0.f;
#pragma unroll
    for (int kb = 0; kb < 5; ++kb)
#pragma unroll
        for (int r = 0; r < 16; ++r) { const float e = ex2((s[kb][r] - mx) * LOG2E); s[kb][r] = e; sum += e; }
    sum += __shfl_xor(sum, 32);
    const float inv = 1.0f / (sum + ex2((sink - mx) * LOG2E));
    f32x16 o[2];
#pragma unroll
    for (int r = 0; r < 16; ++r) { o[0][r] = 0.f; o[1][r] = 0.f; }
#pragma unroll
    for (int kb = 0; kb < 5; ++kb) if (kb >= kb_lo) {
#pragma unroll
        for (int sx = 0; sx < 2; ++sx) {
            v4u pw; pw.x = cvtpk(s[kb][8 * sx + 0], s[kb][8 * sx + 1]); pw.y = cvtpk(s[kb][8 * sx + 2], s[kb][8 * sx + 3]); pw.z = cvtpk(s[kb][8 * sx + 4], s[kb][8 * sx + 5]); pw.w = cvtpk(s[kb][8 * sx + 6], s[kb][8 * sx + 7]);
            const bf16x8 pb = __builtin_bit_cast(bf16x8, pw);
#pragma unroll
            for (int db = 0; db < 2; ++db) {
                v4u vw; vw.x = vl[kb][sx][db].x; vw.y = vl[kb][sx][db].y; vw.z = vh[kb][sx][db].x; vw.w = vh[kb][sx][db].y;
                o[db] = __builtin_amdgcn_mfma_f32_32x32x16_bf16(__builtin_bit_cast(bf16x8, vw), pb, o[db], 0, 0, 0);
            }
        }
    }
    bf16* op = AO + (size_t)(rowbase + t0 + r32) * 4096 + 2048 + head * 64 + 4 * hi;
#pragma unroll
    for (int db = 0; db < 2; ++db)
#pragma unroll
        for (int rg = 0; rg < 4; ++rg) { v2u w; w.x = cvtpk(o[db][4 * rg] * inv, o[db][4 * rg + 1] * inv); w.y = cvtpk(o[db][4 * rg + 2] * inv, o[db][4 * rg + 3] * inv);
            *(GAS v2u*)(op + db * 32 + 8 * rg) = w; }
}
template <bool copy_win> __device__ __forceinline__ void attn_sample_task(int t, const bf16* Q, const float* sk, const float* sv, float* out, bf16* AO, const float* sinks, const LAS float* biasT, LAS float* sc, int lane) {
    const int kvh = t & 7, b = t >> 3;
    const int kq = lane >> 4, d4 = lane & 15;
    float qv[4][4];
#pragma unroll
    for (int g = 0; g < 4; ++g) { const v2u w = *(const GAS v2u*)(Q + (size_t)(ROWS_P + b) * 2048 + (kvh * 4 + g) * 64 + 4 * d4);
        qv[g][0] = blo(w.x) * 0.125f; qv[g][1] = bhi(w.x) * 0.125f; qv[g][2] = blo(w.y) * 0.125f; qv[g][3] = bhi(w.y) * 0.125f; }
    const size_t woff = (size_t)b * 128 * 512 + kvh * 64 + 4 * d4;
#pragma unroll 1
    for (int i0 = 0; i0 < 33; i0 += 17) {
        f32x4 kv[17];
#pragma unroll
        for (int u = 0; u < 17; ++u) { const int j = 4 * (i0 + u) + kq; kv[u] = (f32x4){0.f, 0.f, 0.f, 0.f};
            if (j < 128) kv[u] = __builtin_nontemporal_load((const GAS f32x4*)(sk + woff + (size_t)j * 512)); else if (j == 128) kv[u] = ldg4f(out + O_SK + woff + (size_t)127 * 512); }
#pragma unroll
        for (int u = 0; u < 17; ++u) { const int j = 4 * (i0 + u) + kq;
            if (copy_win && j >= 1 && j < 128) __builtin_nontemporal_store(kv[u], (GAS f32x4*)(out + O_SK + woff + (size_t)(j - 1) * 512));
#pragma unroll
            for (int g = 0; g < 4; ++g) { float p = (qv[g][0] * kv[u][0] + qv[g][1] * kv[u][1]) + (qv[g][2] * kv[u][2] + qv[g][3] * kv[u][3]);
                p = row16_sum(p);
                if (d4 == 0 && j <= 128) sc[g * BIAS_LD + j] = p + biasT[(kvh * 4 + g) * BIAS_LD + (128 - j)]; } }
    }
    asm volatile("s_waitcnt lgkmcnt(0)" ::: "memory");
    float inv[4];
#pragma unroll
    for (int g = 0; g < 4; ++g) {
        const float sink = *(const GAS float*)(sinks + kvh * 4 + g);
        const float v0 = sc[g * BIAS_LD + lane], v1 = sc[g * BIAS_LD + 64 + lane], v2 = (lane == 0) ? sc[g * BIAS_LD + 128] : -INFINITY;
        const float m = fmaxf(wave_max(fmaxf(fmaxf(v0, v1), v2)), sink);
        const float e0 = ex2((v0 - m) * LOG2E), e1 = ex2((v1 - m) * LOG2E), e2 = (lane == 0) ? ex2((v2 - m) * LOG2E) : 0.f;
        inv[g] = 1.0f / (wave_sum(e0 + e1 + e2) + ex2((sink - m) * LOG2E));
        sc[g * BIAS_LD + lane] = e0; sc[g * BIAS_LD + 64 + lane] = e1; if (lane == 0) sc[g * BIAS_LD + 128] = e2;
    }
    asm volatile("s_waitcnt lgkmcnt(0)" ::: "memory");
    float acc[4][4];
#pragma unroll
    for (int g = 0; g < 4; ++g)
#pragma unroll
        for (int e = 0; e < 4; ++e) acc[g][e] = 0.f;
#pragma unroll 1
    for (int i0 = 0; i0 < 33; i0 += 17) {
        f32x4 vv[17];
#pragma unroll
        for (int u = 0; u < 17; ++u) { const int j = 4 * (i0 + u) + kq; vv[u] = (f32x4){0.f, 0.f, 0.f, 0.f};
            if (j < 128) vv[u] = __builtin_nontemporal_load((const GAS f32x4*)(sv + woff + (size_t)j * 512)); else if (j == 128) vv[u] = ldg4f(out + O_SV + woff + (size_t)127 * 512); }
#pragma unroll
        for (int u = 0; u < 17; ++u) { const int j = 4 * (i0 + u) + kq;
            if (copy_win && j >= 1 && j < 128) __builtin_nontemporal_store(vv[u], (GAS f32x4*)(out + O_SV + woff + (size_t)(j - 1) * 512));
            if (j <= 128) {
#pragma unroll
                for (int g = 0; g < 4; ++g) { const float p = sc[g * BIAS_LD + j];
#pragma unroll
                    for (int e = 0; e < 4; ++e) acc[g][e] += p * vv[u][e]; }
            } }
    }
#pragma unroll
    for (int g = 0; g < 4; ++g)
#pragma unroll
        for (int e = 0; e < 4; ++e) { acc[g][e] += __shfl_xor(acc[g][e], 16); acc[g][e] += __shfl_xor(acc[g][e], 32); }
    if (kq == 0) {
#pragma unroll
        for (int g = 0; g < 4; ++g) { v2u w; w.x = cvtpk(acc[g][0] * inv[g], acc[g][1] * inv[g]); w.y = cvtpk(acc[g][2] * inv[g], acc[g][3] * inv[g]);
            *(GAS v2u*)(AO + (size_t)(ROWS_P + b) * 4096 + 2048 + (kvh * 4 + g) * 64 + 4 * d4) = w; }
    }
    asm volatile("s_waitcnt lgkmcnt(0)" ::: "memory");
}
__device__ __forceinline__ void conv_row(int row, const bf16* CB, const bf16* UU, bf16* AO, const float* cw, const float* st, float* out, int lane) {
    const bool samp = row >= ROWS_P; const int tl = row & (SEQ - 1);
    v4u a0[4], ac[4], a1[4], a2[4]; f32x4 s1[4][2], s2[4][2];
#pragma unroll
    for (int j = 0; j < 4; ++j) { const int c = 8 * lane + 512 * j;
        a0[j] = ldg16(UU + (size_t)row * 2048 + c); ac[j] = ldg16(CB + (size_t)row * 2048 + c); a1[j] = (v4u){0u, 0u, 0u, 0u}; a2[j] = (v4u){0u, 0u, 0u, 0u};
        if (!samp) { if (tl >= 1) a1[j] = ldg16(UU + (size_t)(row - 1) * 2048 + c); if (tl >= 2) a2[j] = ldg16(UU + (size_t)(row - 2) * 2048 + c); }
        else { const int b = row - ROWS_P; const float* p2 = st + ((size_t)b * 2 + 0) * 2048 + c; const float* p1 = st + ((size_t)b * 2 + 1) * 2048 + c;
            s2[j][0] = ldg4f(p2); s2[j][1] = ldg4f(p2 + 4); s1[j][0] = ldg4f(p1); s1[j][1] = ldg4f(p1 + 4); } }
#pragma unroll
    for (int j = 0; j < 4; ++j) { const int c = 8 * lane + 512 * j;
        float u0[8], u1[8], u2[8], cbv[8], w0[8], w1[8], w2[8];
        unpack8(a0[j], u0); unpack8(ac[j], cbv);
        if (!samp) { unpack8(a1[j], u1); unpack8(a2[j], u2); }
        else { const int b = row - ROWS_P;
#pragma unroll
            for (int e = 0; e < 4; ++e) { u1[e] = s1[j][0][e]; u1[4 + e] = s1[j][1][e]; u2[e] = s2[j][0][e]; u2[4 + e] = s2[j][1][e]; }
            st8f(out + O_SC + ((size_t)b * 2 + 0) * 2048 + c, u1); }
        ld8f(cw + c, w0); ld8f(cw + 2048 + c, w1); ld8f(cw + 4096 + c, w2);
        float a[8];
#pragma unroll
        for (int e = 0; e < 8; ++e) a[e] = cbv[e] * ((w0[e] * u2[e] + w1[e] * u1[e]) + w2[e] * u0[e]);
        v4u w; w.x = cvtpk(a[0], a[1]); w.y = cvtpk(a[2], a[3]); w.z = cvtpk(a[4], a[5]); w.w = cvtpk(a[6], a[7]);
        *(GAS v4u*)(AO + (size_t)row * 4096 + c) = w; }
}
__device__ __forceinline__ void conv_run8(int r0, const bf16* CB, const bf16* UU, bf16* AO, const float* cw, int lane) {
    const bool head = (r0 & (SEQ - 1)) == 0;
#pragma unroll 1
    for (int j = 0; j < 4; ++j) { const int c = 8 * lane + 512 * j;
        v4u u[10], cb[8];
        u[0] = (v4u){0u, 0u, 0u, 0u}; u[1] = (v4u){0u, 0u, 0u, 0u};
        if (!head) { u[0] = ldg16(UU + (size_t)(r0 - 2) * 2048 + c); u[1] = ldg16(UU + (size_t)(r0 - 1) * 2048 + c); }
#pragma unroll
        for (int i = 0; i < 8; ++i) { u[2 + i] = ldg16(UU + (size_t)(r0 + i) * 2048 + c); cb[i] = ldg16(CB + (size_t)(r0 + i) * 2048 + c); }
        float w0[8], w1[8], w2[8], p2[8], p1[8];
        ld8f(cw + c, w0); ld8f(cw + 2048 + c, w1); ld8f(cw + 4096 + c, w2);
        unpack8(u[0], p2); unpack8(u[1], p1);
#pragma unroll
        for (int i = 0; i < 8; ++i) { float u0[8], cbv[8], a[8];
            unpack8(u[2 + i], u0); unpack8(cb[i], cbv);
#pragma unroll
            for (int e = 0; e < 8; ++e) a[e] = cbv[e] * ((w0[e] * p2[e] + w1[e] * p1[e]) + w2[e] * u0[e]);
            v4u w; w.x = cvtpk(a[0], a[1]); w.y = cvtpk(a[2], a[3]); w.z = cvtpk(a[4], a[5]); w.w = cvtpk(a[6], a[7]);
            *(GAS v4u*)(AO + (size_t)(r0 + i) * 4096 + c) = w;
#pragma unroll
            for (int e = 0; e < 8; ++e) { p2[e] = p1[e]; p1[e] = u0[e]; } }
    }
}
__device__ __forceinline__ float silu_mul(float gc, float u) { return gc * __builtin_amdgcn_rcpf(1.0f + ex2(-gc * LOG2E)) * u; }
__device__ __forceinline__ void ffn_act_block(int task, const bf16* G, const bf16* U, bf16* F, const float* cw, const float* cbias, const float* st, float* out, int lane) {
    const int ch = task % 22, rb = task / 22, c = ch * 512 + lane * 8;
    if (c >= DFF) return;
    float w0[8], w1[8], w2[8], bb[8];
    ld8f(cw + c, w0); ld8f(cw + DFF + c, w1); ld8f(cw + 2 * DFF + c, w2); ld8f(cbias + c, bb);
    const int row0 = rb * 32;
    if (rb < ROWS_P / 32) {
        float g1[8], g2[8];
        if ((row0 & (SEQ - 1)) != 0) { unpack8(ldg16(G + (size_t)(row0 - 1) * DFF + c), g1); unpack8(ldg16(G + (size_t)(row0 - 2) * DFF + c), g2); }
        else {
#pragma unroll
            for (int e = 0; e < 8; ++e) { g1[e] = 0.f; g2[e] = 0.f; } }
        for (int r0 = 0; r0 < 32; r0 += 8) {
            v4u gw_[8], uw_[8];
#pragma unroll
            for (int r = 0; r < 8; ++r) { gw_[r] = ldg16(G + (size_t)(row0 + r0 + r) * DFF + c); uw_[r] = ldg16(U + (size_t)(row0 + r0 + r) * DFF + c); }
#pragma unroll
            for (int r = 0; r < 8; ++r) { float g0[8], uv[8], f[8]; unpack8(gw_[r], g0); unpack8(uw_[r], uv);
#pragma unroll
                for (int e = 0; e < 8; ++e) { f[e] = silu_mul(((w0[e] * g2[e] + w1[e] * g1[e]) + w2[e] * g0[e]) + bb[e], uv[e]); g2[e] = g1[e]; g1[e] = g0[e]; }
                v4u w; w.x = cvtpk(f[0], f[1]); w.y = cvtpk(f[2], f[3]); w.z = cvtpk(f[4], f[5]); w.w = cvtpk(f[6], f[7]);
                *(GAS v4u*)(F + (size_t)(row0 + r0 + r) * DFF + c) = w; }
        }
    } else {
        for (int r0 = 0; r0 < 32; r0 += 4) {
            v4u gw_[4], uw_[4]; float s0[4][8], s1[4][8];
#pragma unroll
            for (int r = 0; r < 4; ++r) { const int row = row0 + r0 + r, b = row - ROWS_P; gw_[r] = ldg16(G + (size_t)row * DFF + c); uw_[r] = ldg16(U + (size_t)row * DFF + c);
                ld8f(st + ((size_t)b * 2 + 0) * DFF + c, s0[r]); ld8f(st + ((size_t)b * 2 + 1) * DFF + c, s1[r]); }
#pragma unroll
            for (int r = 0; r < 4; ++r) { const int row = row0 + r0 + r, b = row - ROWS_P; float g0[8], uv[8], f[8]; unpack8(gw_[r], g0); unpack8(uw_[r], uv);
                st8f(out + O_SF + ((size_t)b * 2 + 0) * DFF + c, s1[r]);
#pragma unroll
                for (int e = 0; e < 8; ++e) f[e] = silu_mul(((w0[e] * s0[r][e] + w1[e] * s1[r][e]) + w2[e] * g0[e]) + bb[e], uv[e]);
                v4u w; w.x = cvtpk(f[0], f[1]); w.y = cvtpk(f[2], f[3]); w.z = cvtpk(f[4], f[5]); w.w = cvtpk(f[6], f[7]);
                *(GAS v4u*)(F + (size_t)row * DFF + c) = w; }
        }
    }
}

template <int NB, int NR, bool PIPE>
__device__ __forceinline__ void skinny_ksplit(f32x4 (&acc)[NB * NR], const bf16* A  , int lda, int ags  ,
                                              const bf16* const (&brow)[NB]  , int bgs  , int gfirst, int gstride, int gcount, int rot, int fr, int fq) {
    const bf16* a0 = A + (size_t)fr * lda + 16 * fq;
    auto ld = [&](int i, bf16x8 (&a)[NR][2], bf16x8 (&b)[NB][2]) {
        int ii = i + rot; if (ii >= gcount) ii -= gcount;
        const int gi = gfirst + gstride * ii; const size_t ka_ = (size_t)gi * ags, kb_ = (size_t)gi * bgs;
#pragma unroll
        for (int j = 0; j < NB; ++j) { b[j][0] = *(const GAS bf16x8*)(brow[j] + 16 * fq + kb_); b[j][1] = *(const GAS bf16x8*)(brow[j] + 16 * fq + kb_ + 8); }
#pragma unroll
        for (int rg = 0; rg < NR; ++rg) { a[rg][0] = *(const GAS bf16x8*)(a0 + (size_t)(16 * rg) * lda + ka_); a[rg][1] = *(const GAS bf16x8*)(a0 + (size_t)(16 * rg) * lda + ka_ + 8); }
    };
    auto mm = [&](const bf16x8 (&a)[NR][2], const bf16x8 (&b)[NB][2]) {
#pragma unroll
        for (int u = 0; u < 2; ++u)
#pragma unroll
            for (int j = 0; j < NB; ++j)
#pragma unroll
                for (int rg = 0; rg < NR; ++rg) acc[j * NR + rg] = __builtin_amdgcn_mfma_f32_16x16x32_bf16(b[j][u], a[rg][u], acc[j * NR + rg], 0, 0, 0);
    };
    if constexpr (PIPE) {
        bf16x8 a0s[NR][2], b0s[NB][2], a1s[NR][2], b1s[NB][2];
        if (gcount > 0) ld(0, a0s, b0s);
#pragma unroll 1
        for (int i = 0; i < gcount; i += 2) {
            if (i + 1 < gcount) ld(i + 1, a1s, b1s);
            mm(a0s, b0s);
            if (i + 1 < gcount) { if (i + 2 < gcount) ld(i + 2, a0s, b0s); mm(a1s, b1s); }
        }
    } else {
#pragma unroll 1
        for (int i = 0; i < gcount; ++i) { bf16x8 a[NR][2], b[NB][2]; ld(i, a, b); mm(a, b); }
    }
}
__device__ __forceinline__ void skinny_reduce(const f32x4 (&acc)[8], LAS f32x4* red, int wave, int lane, f32x4& lo, f32x4& hi) {
#pragma unroll
    for (int rg = 0; rg < 8; ++rg) red[(wave * 8 + rg) * 64 + lane] = acc[rg];
    __syncthreads();
    lo = (red[(0 * 8 + wave) * 64 + lane] + red[(1 * 8 + wave) * 64 + lane]) + (red[(2 * 8 + wave) * 64 + lane] + red[(3 * 8 + wave) * 64 + lane]);
    hi = (red[(4 * 8 + wave) * 64 + lane] + red[(5 * 8 + wave) * 64 + lane]) + (red[(6 * 8 + wave) * 64 + lane] + red[(7 * 8 + wave) * 64 + lane]);
    __syncthreads();
}
__device__ __forceinline__ f32x4 unpack4(const v2u w) { return (f32x4){blo(w.x), bhi(w.x), blo(w.y), bhi(w.y)}; }
__device__ __forceinline__ v2u pack4(const f32x4 v) { v2u w; w.x = cvtpk(v[0], v[1]); w.y = cvtpk(v[2], v[3]); return w; }

constexpr bool P1_HOLE_COPY = false;
#ifndef P6_BNT
#define P6_BNT false
#endif
constexpr int P6_SAMPLE_TILES = 64;
struct OrderXcd {
    int nN, E, G, c, x, r, Rm, nfull; bool xm;
    __device__ void init(int nN_, int E_, int G_, int c_) { nN = nN_; E = E_; G = G_; c = c_; x = c_ & 7; r = c_ >> 3; Rm = (nN_ + 7) >> 3; nfull = nN_ - 8 * (Rm - 1); xm = (G_ == 256); }
    __device__ bool next(int i, pg8::Unit& u) const {
        if (!xm) { const long Lx = (long)i * G + c; if (Lx < 32L * nN) { u.pm = (int)(Lx / nN); u.pn = (int)(Lx % nN); return true; } if (Lx - 32L * nN < E) { u.pm = 32; u.pn = (int)(Lx - 32L * nN); return true; } return false; }
        if (i >= Rm) return false;
        const int pn = 8 * i + (r >> 2);
        if (pn < nN) { u.pm = 4 * x + (r & 3); u.pn = pn; return true; }
        const int sidx = x + 8 * ((r & 3) + 4 * ((r >> 2) - nfull));
        if (sidx < E) { u.pm = 32; u.pn = sidx; return true; }
        return false; }
    __device__ __forceinline__ void a_ready(const pg8::Unit&) const {}
    __device__ __forceinline__ void done(const pg8::Unit&) const {}
};
struct OrderSame { int n; __device__ bool next(int i, pg8::Unit& u) const { if (i >= n) return false; u.pm = 0; u.pn = 0; return true; }
    __device__ __forceinline__ void a_ready(const pg8::Unit&) const {} __device__ __forceinline__ void done(const pg8::Unit&) const {} };
struct OrderSlices { int np, G, c;
    __device__ bool next(int i, pg8::Unit& u) const {
        const long id = (long)i * G + c; if (id >= 256) return false;
        const int sl = (int)id & 15, p0 = (np * sl) >> 4, p1 = (np * (sl + 1)) >> 4;
        u.pm = 32; u.pn = (int)id >> 4; u.kn = 2 * p0 + ((2 * (p1 - p0)) << 16); return true; }
    __device__ __forceinline__ void a_ready(const pg8::Unit&) const {}
    __device__ __forceinline__ void done(const pg8::Unit&) const {}
};
#ifndef PH_MASK
#define PH_MASK 0x3ff
#endif
#define PH(k) ((PH_MASK >> (k)) & 1)
#ifndef REP_MASK
#define REP_MASK 0
#endif
#define REPN(k) (((REP_MASK >> (k)) & 1) ? 2 : 1)
struct Args { const float* in[21]; float* out; unsigned char* ws; };
__global__ void __launch_bounds__(NWAVES * 64, 2) mega_fwd(Args args) {
    extern __shared__ __attribute__((aligned(16))) unsigned char lds[];
    LAS unsigned char* L = (LAS unsigned char*)lds;
    volatile LAS unsigned* MISC = (volatile LAS unsigned*)(L + MISC_OFF);
    const int tid = threadIdx.x;
#define PHASE_IDS() int tid_p_ = threadIdx.x; asm volatile("" : "+v"(tid_p_)); const int lane = tid_p_ & 63, wave = __builtin_amdgcn_readfirstlane(tid_p_ >> 6), gw = vcu * NWAVES + wave; (void)lane; (void)gw
    const int G = gridDim.x, bx = blockIdx.x;
    const int vcu = (G % 8 == 0) ? (bx % 8) * (G / 8) + bx / 8 : bx;
    const int NGW = G * NWAVES;
    unsigned char* ws = args.ws; float* out = args.out;
#define INP(k) (args.in[k])
#define WSB(off) ((bf16*)(ws + (off)))
    gu32* ctl = (gu32*)(ws + WS_CTL);
    for (int u = tid; u < (LDS_BYTES - LDSCTL_OFF) / 4; u += NWAVES * 64) ((LAS unsigned*)(L + LDSCTL_OFF))[u] = 0u;
    __syncthreads();
    XcdBarrier bar = xcd_barrier_post((unsigned*)(ctl + CW_BAR), MISC + 8);
#ifdef PROBE_PHASES
    unsigned long long pt0_ = 0, probe_acc_ = 0;
#ifdef PROBE_P2SUB
#define PTS(k) do { if (PROBE_P2SUB == (k)) pt0_ = __builtin_amdgcn_s_memrealtime(); } while (0)
#define PTE(k) do { if (PROBE_P2SUB == (k)) probe_acc_ += __builtin_amdgcn_s_memrealtime() - pt0_; } while (0)
#else
#define PTS(k)
#define PTE(k)
#endif
#define PT_BEGIN(k) do { if ((PROBE_PHASES >> (k)) & 1) pt0_ = __builtin_amdgcn_s_memrealtime(); } while (0)
#define PT_END(k) do { if ((PROBE_PHASES >> (k)) & 1) probe_acc_ += __builtin_amdgcn_s_memrealtime() - pt0_; } while (0)
#else
#define PT_BEGIN(k)
#define PT_END(k)
#define PTS(k)
#define PTE(k)
#endif
#ifdef PROBE_CLOCK
    unsigned long long probe_dc_ = 0, probe_dr_ = 1;
#endif

#define SCR() ((LAS float*)(L + RING_OFF + wave * 16384))
        constexpr int I0 = 64 * 544, I1 = 32 * 128, I3 = 64 * 128, I4 = 64 * 344, I6 = 172 * 128;
        constexpr int NITEMS = I0 + 2 * I1 + I3 + 2 * I4 + I6;
        auto decode = [&](int it) -> P0Ref {
            int r = (it < NITEMS - I0) ? it + I0 : it - (NITEMS - I0);
            if (r < I0) { const int kb = r / 544, nb = r % 544; return P0Ref{INP(7) + (size_t)(64 * kb) * INW + 32 * nb, WSB(WS_WIN) + tiled_off(win_map(32 * nb), kb, 64), INW}; } r -= I0;
            if (r < I1) { const int kb = r / 128, nb = r % 128; return P0Ref{INP(9) + (size_t)(64 * kb) * DM + 32 * nb, WSB(WS_WAB) + tiled_off(32 * nb, kb, 64), DM}; } r -= I1;
            if (r < I1) { const int kb = r / 128, nb = r % 128; return P0Ref{INP(10) + (size_t)(64 * kb) * DM + 32 * nb, WSB(WS_WAB) + tiled_off(32 * nb, 32 + kb, 64), DM}; } r -= I1;
            if (r < I3) { const int kb = r / 128, nb = r % 128; return P0Ref{INP(12) + (size_t)(64 * kb) * DM + 32 * nb, WSB(WS_WO) + tiled_off(32 * nb, kb, 64), DM}; } r -= I3;
            if (r < I4) { const int kb = r / 344, nb = r % 344; return P0Ref{INP(14) + (size_t)(64 * kb) * DFF + 32 * nb, WSB(WS_WGU) + tiled_off(((32 * nb) >> 7) * 256 + ((32 * nb) & 127), kb, 64), DFF}; } r -= I4;
            if (r < I4) { const int kb = r / 344, nb = r % 344; return P0Ref{INP(15) + (size_t)(64 * kb) * DFF + 32 * nb, WSB(WS_WGU) + tiled_off(((32 * nb) >> 7) * 256 + 128 + ((32 * nb) & 127), kb, 64), DFF}; } r -= I4;
            const int kb = r / 128, nb = r % 128; return P0Ref{INP(18) + (size_t)(64 * kb) * DM + 32 * nb, WSB(WS_WD) + tiled_off(32 * nb, kb, 172), DM};
        };
    const int p1_units = (MPAD / 256) * (INW / 256), p1_hole = (p1_units % G) ? G - (p1_units % G) : 0;
    const int DEFER = 0;
    constexpr int R_AB0 = 0, R_AB1 = 2 * I1, R_O1 = R_AB1 + I3, R_GU1 = R_O1 + 2 * I4, R_D1 = R_GU1 + I6, R_IN1 = NITEMS;
    static_assert(R_D1 == NITEMS - I0, "item ranges");
#define CONVERT_RANGE(FIRST, LAST, SCRP) do { const int f_ = (FIRST), l_ = (LAST); if (f_ + gw < l_) { P0Ref cur = decode(f_ + gw); f32x4 va[8], vb[8]; p0_load(cur, va, lane); \
        for (int it = f_ + gw; it < l_; it += NGW) { const int nx = it + NGW; P0Ref nr = cur; if (nx < l_) { nr = decode(nx); p0_load(nr, vb, lane); } p0_store(cur, va, (SCRP), lane); \
            _Pragma("unroll") for (int i = 0; i < 8; ++i) va[i] = vb[i]; cur = nr; } } } while (0)
    PT_BEGIN(0);
    for (int rep_ = 0; rep_ < REPN(0); ++rep_) {
    if (PH(0)) {
        PHASE_IDS();
        f32x4 g1v[16]; load_gain(INP(6), g1v, lane);
        {
            f32x4 va[16], vb[16];
            if (gw < ROWS_R) load_row(gw < ROWS_P ? INP(0) + (size_t)gw * DM : INP(1) + (size_t)(gw - ROWS_P) * DM, va, lane);
#pragma unroll 1
            for (int m = gw; m < MPAD; m += NGW) {
                const int mn = m + NGW;
                if (mn < ROWS_R) load_row(mn < ROWS_P ? INP(0) + (size_t)mn * DM : INP(1) + (size_t)(mn - ROWS_P) * DM, vb, lane);
                if (m < ROWS_R) rms_row_pre_tiled(va, g1v, WSB(WS_XN) + tiled_off(m, 0, 64), lane);
                else {
#pragma unroll
                    for (int j = 0; j < 8; ++j) { const int c = 8 * (lane + 64 * j); *(GAS v4u*)(WSB(WS_XN) + tiled_off(m, c >> 6, 64) + (c & 63)) = (v4u){0u, 0u, 0u, 0u}; } }
#pragma unroll
                for (int j = 0; j < 16; ++j) va[j] = vb[j];
            }
        }
        CONVERT_RANGE(R_D1, R_IN1, SCR());
    }
    xcd_barrier(bar);
    }
    PT_END(0);

    PT_BEGIN(1);
    for (int rep_ = 0; rep_ < REPN(1); ++rep_) {
    if (PH(1)) {
        PHASE_IDS();
        pg8::Gemm g{WSB(WS_XN), WSB(WS_WIN), MPAD, INW, DM}; OrderXcd S; S.init(INW / 256, INW / 256, G, bx);
        pg8::EpiProj E{WSB(WS_CB), WSB(WS_UU), WSB(WS_Q), WSB(WS_K), WSB(WS_VT), WSB(WS_RAT), WSB(WS_SGB), out, (LAS bf16*)(L + XCH_OFF)};
#if defined(PROBE_CLOCK) && PROBE_CLOCK == 1
        const unsigned long long pc0_ = __builtin_amdgcn_s_memtime(), pr0_ = __builtin_amdgcn_s_memrealtime();
#endif
        pg8::gemm_phase<pg8::EpiProj, OrderXcd, false, true, true, true, false, false, true>(L + RING_OFF, g, S, E);
#if defined(PROBE_CLOCK) && PROBE_CLOCK == 1
        probe_dc_ = __builtin_amdgcn_s_memtime() - pc0_; probe_dr_ = __builtin_amdgcn_s_memrealtime() - pr0_;
#endif
        if (P1_HOLE_COPY && G == 256 && ((bx >> 3) >> 2) >= 4) {
            const int sidx = (bx & 7) + 8 * (((bx >> 3) & 3) + 4 * (((bx >> 3) >> 2) - 4));
            if (sidx >= INW / 256) { const int h = sidx - INW / 256, nh = 128 - INW / 256;
                for (int blk = h; blk < 256; blk += nh) { const int tensor = blk >> 7, b = blk & 127;
                    const GAS f32x4* src = (const GAS f32x4*)((tensor ? INP(3) : INP(2)) + ((size_t)b * 128 + 1) * 512); GAS f32x4* dst = (GAS f32x4*)(out + (tensor ? O_SV : O_SK) + (size_t)b * 128 * 512);
#pragma unroll 1
                    for (int i0 = threadIdx.x; i0 < 127 * 128; i0 += 8 * 512) {
                        const int ia = i0, ib = min(i0 + 512, 127 * 128 - 1), ic = min(i0 + 1024, 127 * 128 - 1), id = min(i0 + 1536, 127 * 128 - 1), ie = min(i0 + 2048, 127 * 128 - 1), ig = min(i0 + 2560, 127 * 128 - 1), ih = min(i0 + 3072, 127 * 128 - 1), ii = min(i0 + 3584, 127 * 128 - 1);
                        const f32x4 va = src[ia], vb = src[ib], vc = src[ic], vd = src[id], ve = src[ie], vg = src[ig], vh = src[ih], vi = src[ii];
                        dst[ia] = va; dst[ib] = vb; dst[ic] = vc; dst[id] = vd; dst[ie] = ve; dst[ig] = vg; dst[ih] = vh; dst[ii] = vi; } } } }
        if (DEFER && bx >= G - p1_hole) {
            const int hw = (bx - (G - p1_hole)) * NWAVES + wave, nhw = p1_hole * NWAVES, first = NITEMS - DEFER;
            if (first + hw < NITEMS) {
                P0Ref cur = decode(first + hw); f32x4 va[8], vb[8];
                p0_load(cur, va, lane);
                for (int it = first + hw; it < NITEMS; it += nhw) {
                    const int nx = it + nhw; P0Ref nr = cur;
                    if (nx < NITEMS) { nr = decode(nx); p0_load(nr, vb, lane); }
                    p0_store(cur, va, SCR(), lane);
#pragma unroll
                    for (int i = 0; i < 8; ++i) va[i] = vb[i];
                    cur = nr;
                }
            }
        }
#ifdef PROBE_P1_NULL
#ifdef PROBE_SAME
        { pg8::EpiNull EN{(float*)(ws + WS_CTL + 512)}; OrderSame SS{9}; pg8::gemm_phase<pg8::EpiNull, OrderSame, true, true, true, true>(L + RING_OFF, g, SS, EN); }
#else
        { pg8::EpiNull EN{(float*)(ws + WS_CTL + 512)}; pg8::gemm_phase<pg8::EpiNull, OrderXcd, true, true, true, true>(L + RING_OFF, g, S, EN); }
#endif
#endif
    }
    xcd_barrier(bar);
    }
    PT_END(1);

    PT_BEGIN(2);
    for (int rep_ = 0; rep_ < REPN(2); ++rep_) {
    if (PH(2)) {
        PHASE_IDS();
        LAS float* biasT = (LAS float*)(L + RING_OFF);
        PTS(1);
        for (int i = tid; i < 32 * 129; i += NWAVES * 64) { const int h = i / 129, d = i - h * 129;
            int bk = d;
            if (d >= 16) { bk = 16 + (int)(log2f((float)d * 0.0625f) * (16.0f / 3.0f)); bk = bk > 31 ? 31 : bk; }
            biasT[h * BIAS_LD + d] = *(const GAS float*)(INP(19) + bk * 32 + h); }
        __syncthreads();
        LAS float* sc = (LAS float*)(L + SCR_OFF + wave * SCR_WAVE);
        if (wave >= 4) CONVERT_RANGE(R_AB0, R_AB1, (LAS float*)(L + 61440 + wave * 8448));
        for (int t = gw; t < 4 * 8 * 64 * 4; t += NGW) attn_prompt_task(t, WSB(WS_Q), WSB(WS_K), WSB(WS_VT), WSB(WS_AO), INP(11), biasT, lane);
        PTE(1); PTS(2);
        if (P1_HOLE_COPY && G == 256) { for (int t = NGW - 1 - gw; t < 128 * 8; t += NGW) attn_sample_task<false>(t, WSB(WS_Q), INP(2), INP(3), out, WSB(WS_AO), INP(11), biasT, sc, lane); }
        else { for (int t = NGW - 1 - gw; t < 128 * 8; t += NGW) attn_sample_task<true>(t, WSB(WS_Q), INP(2), INP(3), out, WSB(WS_AO), INP(11), biasT, sc, lane); }
        { const int cwn = NGW > 128 * 8 ? NGW - 128 * 8 : NGW;
          if (gw < cwn) {
            for (int run = gw; run < ROWS_P / 8; run += cwn) conv_run8(8 * run, WSB(WS_CB), WSB(WS_UU), WSB(WS_AO), INP(8), lane);
            for (int m = ROWS_P + gw; m < ROWS_R; m += cwn) conv_row(m, WSB(WS_CB), WSB(WS_UU), WSB(WS_AO), INP(8), INP(4), out, lane); } }
        PTE(2); PTS(3);
        if (wave < 4) CONVERT_RANGE(R_AB0, R_AB1, (LAS float*)(L + 61440 + wave * 8448));
        PTE(3);
#ifdef PROBE_P2A
        for (int t = gw; t < 4 * 8 * 64 * 4; t += NGW) attn_prompt_task(t, WSB(WS_Q), WSB(WS_K), WSB(WS_VT), WSB(WS_AO), INP(11), biasT, lane);
#endif
#ifdef PROBE_P2S
        for (int t = NGW - 1 - gw; t < 128 * 8; t += NGW) attn_sample_task<true>(t, WSB(WS_Q), INP(2), INP(3), out, WSB(WS_AO), INP(11), biasT, sc, lane);
#endif
    }
    xcd_barrier(bar);
    }
    PT_END(2);

    PT_BEGIN(3);
    for (int rep_ = 0; rep_ < REPN(3); ++rep_) {
    if (PH(3)) {
        PHASE_IDS();
        pg8::Gemm g{WSB(WS_AO), WSB(WS_WAB), ROWS_P, DM, DM}; OrderXcd S; S.init(DM / 256, 0, G, bx);
        pg8::EpiMerged E{WSB(WS_RAT), WSB(WS_SGB), WSB(WS_MG)};
        pg8::gemm_phase<pg8::EpiMerged, OrderXcd, true, true, false, true>(L + RING_OFF, g, S, E);
        if (vcu & 1) { CONVERT_RANGE(R_AB1, R_O1, SCR()); __syncthreads(); }
        { const int fr = lane & 15, fq = lane >> 4;
#ifdef PROBE_SK2
          for (int rp_ = 0; rp_ < 2; ++rp_)
#endif
          for (int t = vcu; t < 2 * (DM / 32); t += G) { const int cp = t >> 1, rh = t & 1;
            f32x4 acc[8];
#pragma unroll
            for (int q = 0; q < 8; ++q) acc[q] = (f32x4){0.f, 0.f, 0.f, 0.f};
            const bf16* const bp[2] = {WSB(WS_WAB) + tiled_off(32 * cp + fr, 0, 64), WSB(WS_WAB) + tiled_off(32 * cp + 16 + fr, 0, 64)};
            const size_t o = (size_t)(ROWS_P + 64 * rh + 16 * (wave & 3) + fr) * DM + 32 * cp + 16 * (wave >> 2) + 4 * fq;
            const v2u rat_ = *(const GAS v2u*)(WSB(WS_RAT) + o), sgb_ = *(const GAS v2u*)(WSB(WS_SGB) + o);
            skinny_ksplit<2, 4, true>(acc, WSB(WS_AO) + (size_t)(ROWS_P + 64 * rh) * DM, DM, 64, bp, 16384, (wave >> 2) * 32 + (wave & 3), 4, 8, vcu & 7, fr, fq);
            f32x4 lo, hi; skinny_reduce(acc, (LAS f32x4*)(L + RING_OFF), wave, lane, lo, hi);
            *(GAS v2u*)(WSB(WS_MG) + o) = pack4((lo * unpack4(rat_) + hi) * unpack4(sgb_));
          } }
        if (!(vcu & 1)) CONVERT_RANGE(R_AB1, R_O1, SCR());
    }
    xcd_barrier(bar);
    }
    PT_END(3);

    PT_BEGIN(4);
    for (int rep_ = 0; rep_ < REPN(4); ++rep_) {
    if (PH(4)) {
        PHASE_IDS();
        pg8::Gemm g{WSB(WS_MG), WSB(WS_WO), ROWS_P, DM, DM}; OrderXcd S; S.init(DM / 256, 0, G, bx);
        pg8::EpiResidB<false> E{INP(0), WSB(WS_X1), WSB(WS_XN), INP(13), (float*)(ws + WS_PART1)};
        pg8::gemm_phase<pg8::EpiResidB<false>, OrderXcd, true, true, false, true>(L + RING_OFF, g, S, E);
        { OrderSlices S2{DM / 128, G, bx}; pg8::EpiSlab E2{(float*)(ws + WS_SLAB4), DM / 128};
          pg8::gemm_phase<pg8::EpiSlab, OrderSlices, false, true, false, true, false, true>(L + RING_OFF, g, S2, E2); }
    }
    xcd_barrier(bar);
    }
    PT_END(4);

    PT_BEGIN(5);
    for (int rep_ = 0; rep_ < REPN(5); ++rep_) {
    if (PH(5)) { PHASE_IDS();
        for (int m0 = gw; m0 < ROWS_P; m0 += 4 * NGW) { f32x4 p[4];
#pragma unroll
            for (int i = 0; i < 4; ++i) { const int m = m0 + i * NGW; p[i] = (f32x4){0.f, 0.f, 0.f, 0.f}; if (m < ROWS_P) p[i] = *(const GAS f32x4*)((const float*)(ws + WS_PART1) + (size_t)m * 256 + 4 * lane); }
#pragma unroll
            for (int i = 0; i < 4; ++i) { const int m = m0 + i * NGW; const float ss = wave_sum((p[i].x + p[i].y) + (p[i].z + p[i].w)); if (m < ROWS_P && lane == 0) *(GAS float*)((float*)(ws + WS_RSTAT) + m) = 1.0f / sqrtf(ss * (1.0f / DM) + EPS); } }
        for (int r = bx; r < ROWS_R - ROWS_P; r += G) {
            const int c = 512 * wave + 8 * lane;
            const float* sl = (const float*)(ws + WS_SLAB4) + (size_t)r * DM + c;
            f32x4 a0 = ldg4f(INP(1) + (size_t)r * DM + c), a1 = ldg4f(INP(1) + (size_t)r * DM + c + 4);
#pragma unroll
            for (int h = 0; h < 2; ++h) { f32x4 t0[8], t1[8];
#pragma unroll
                for (int q = 0; q < 8; ++q) { t0[q] = ldg4f(sl + (size_t)(8 * h + q) * 128 * DM); t1[q] = ldg4f(sl + (size_t)(8 * h + q) * 128 * DM + 4); }
#pragma unroll
                for (int q = 0; q < 8; ++q) { a0 += t0[q]; a1 += t1[q]; } }
            float* xo = (float*)(ws + WS_X1) + (size_t)(ROWS_P + r) * DM + c;
            *(GAS f32x4*)xo = a0; *(GAS f32x4*)(xo + 4) = a1;
            const float ssw = wave_sum(((a0.x * a0.x + a0.y * a0.y) + (a0.z * a0.z + a0.w * a0.w)) + ((a1.x * a1.x + a1.y * a1.y) + (a1.z * a1.z + a1.w * a1.w)));
            LAS float* red = (LAS float*)(L + RING_OFF);
            if (lane == 0) red[wave] = ssw;
            __syncthreads();
            const float tot = ((red[0] + red[1]) + (red[2] + red[3])) + ((red[4] + red[5]) + (red[6] + red[7]));
            __syncthreads();
            if (wave == 0 && lane == 0) *(GAS float*)((float*)(ws + WS_RSTAT) + ROWS_P + r) = 1.0f / sqrtf(tot * (1.0f / DM) + EPS);
            const f32x4 y0 = a0 * ldg4f(INP(13) + c), y1 = a1 * ldg4f(INP(13) + c + 4);
            v4u w; w.x = cvtpk(y0.x, y0.y); w.y = cvtpk(y0.z, y0.w); w.z = cvtpk(y1.x, y1.y); w.w = cvtpk(y1.z, y1.w);
            *(GAS v4u*)(WSB(WS_XN) + tiled_off(ROWS_P + r, c >> 6, 64) + (c & 63)) = w;
        }
        CONVERT_RANGE(R_O1, R_GU1, SCR());
    }
    xcd_barrier(bar);
    }
    PT_END(5);

    PT_BEGIN(6);
    for (int rep_ = 0; rep_ < REPN(6); ++rep_) {
    if (PH(6)) {
        PHASE_IDS();
        pg8::Gemm g{WSB(WS_XN), WSB(WS_WGU), MPAD, 2 * DFF, DM}; OrderXcd S; S.init(2 * DFF / 256, P6_SAMPLE_TILES, G, bx);
        pg8::EpiGateUpF E{WSB(WS_F), (float*)(ws + WS_SIDEG), (float*)(ws + WS_SIDEU), INP(16), INP(17), INP(5), out, (LAS float*)(L + XCH_OFF), (const float*)(ws + WS_RSTAT)};
#if defined(PROBE_CLOCK) && PROBE_CLOCK == 6
        const unsigned long long pc6_ = __builtin_amdgcn_s_memtime(), pr6_ = __builtin_amdgcn_s_memrealtime();
#endif
        pg8::gemm_phase<pg8::EpiGateUpF, OrderXcd, true, true, true, true, P6_BNT>(L + RING_OFF, g, S, E);
#if defined(PROBE_CLOCK) && PROBE_CLOCK == 6
        probe_dc_ = __builtin_amdgcn_s_memtime() - pc6_; probe_dr_ = __builtin_amdgcn_s_memrealtime() - pr6_;
#endif
        { const int fr = lane & 15, fq = lane >> 4; LAS f32x4* red = (LAS f32x4*)(L + RING_OFF);
          for (int t = vcu; t < 2 * ((DFF - P6_SAMPLE_TILES * 128) / 16); t += G) { const int j = t >> 1, rh = t & 1;
            const int ch = P6_SAMPLE_TILES * 128 + 16 * j, nrow = (ch >> 7) * 256 + (ch & 127) + fr;
            f32x4 acc[8];
#pragma unroll
            for (int q = 0; q < 8; ++q) acc[q] = (f32x4){0.f, 0.f, 0.f, 0.f};
            const bf16* const bp[2] = {WSB(WS_WGU) + tiled_off(nrow, 0, 64), WSB(WS_WGU) + tiled_off(nrow + 128, 0, 64)};
            skinny_ksplit<2, 4, true>(acc, WSB(WS_XN) + tiled_off(ROWS_P + 64 * rh, 0, 64), 64, 16384, bp, 16384, wave, 8, 8, vcu & 7, fr, fq);
#pragma unroll
            for (int q = 0; q < 8; ++q) red[(wave * 8 + q) * 64 + lane] = acc[q];
            __syncthreads();
            if (wave < 4) {
                f32x4 gv = (f32x4){0.f, 0.f, 0.f, 0.f}, uv = (f32x4){0.f, 0.f, 0.f, 0.f};
#pragma unroll
                for (int ww = 0; ww < 8; ++ww) { gv += red[(ww * 8 + wave) * 64 + lane]; uv += red[(ww * 8 + 4 + wave) * 64 + lane]; }
                const size_t b = 64 * rh + 16 * wave + fr; const int c = ch + 4 * fq;
                { const float rs = *(const GAS float*)((const float*)(ws + WS_RSTAT) + ROWS_P + b); gv *= rs; uv *= rs; }
                const f32x4 s0 = ldg4f(INP(5) + (b * 2 + 0) * DFF + c), s1 = ldg4f(INP(5) + (b * 2 + 1) * DFF + c);
                const f32x4 gc = ((ldg4f(INP(16) + c) * s0 + ldg4f(INP(16) + DFF + c) * s1) + ldg4f(INP(16) + 2 * DFF + c) * gv) + ldg4f(INP(17) + c);
                *(GAS f32x4*)(out + O_SF + (b * 2 + 0) * DFF + c) = s1; *(GAS f32x4*)(out + O_SF + (b * 2 + 1) * DFF + c) = gv;
                *(GAS v2u*)(WSB(WS_F) + (ROWS_P + b) * DFF + c) = pack4((f32x4){silu_mul(gc[0], uv[0]), silu_mul(gc[1], uv[1]), silu_mul(gc[2], uv[2]), silu_mul(gc[3], uv[3])});
            }
            __syncthreads();
          } }
    }
    xcd_barrier(bar);
    }
    PT_END(6);

    PT_BEGIN(7);
    for (int rep_ = 0; rep_ < REPN(7); ++rep_) {
    if (PH(7)) { PHASE_IDS(); for (int idx = gw * 64 + lane; idx < 32 * 2 * (DFF / 8); idx += NGW * 64) {
        const int c = 8 * (idx % (DFF / 8)), rr = (idx / (DFF / 8)) & 1, pm = idx / (2 * (DFF / 8));
        if ((pm & 7) != 0) {
            const float* sg = (const float*)(ws + WS_SIDEG); const float* su = (const float*)(ws + WS_SIDEU);
            float g0[8], gm1[8], gm2[8], uv[8], w0[8], w1[8], w2[8], bb[8], f[8];
            ld8f(sg + ((size_t)pm * 4 + rr) * DFF + c, g0); ld8f(su + ((size_t)pm * 2 + rr) * DFF + c, uv);
            ld8f(rr == 0 ? sg + ((size_t)(pm - 1) * 4 + 3) * DFF + c : sg + ((size_t)pm * 4 + 0) * DFF + c, gm1);
            ld8f(rr == 0 ? sg + ((size_t)(pm - 1) * 4 + 2) * DFF + c : sg + ((size_t)(pm - 1) * 4 + 3) * DFF + c, gm2);
            ld8f(INP(16) + c, w0); ld8f(INP(16) + DFF + c, w1); ld8f(INP(16) + 2 * DFF + c, w2); ld8f(INP(17) + c, bb);
#pragma unroll
            for (int e = 0; e < 8; ++e) f[e] = silu_mul(((w0[e] * gm2[e] + w1[e] * gm1[e]) + w2[e] * g0[e]) + bb[e], uv[e]);
            v4u w; w.x = cvtpk(f[0], f[1]); w.y = cvtpk(f[2], f[3]); w.z = cvtpk(f[4], f[5]); w.w = cvtpk(f[6], f[7]);
            *(GAS v4u*)(WSB(WS_F) + ((size_t)pm * 256 + rr) * DFF + c) = w;
        }
    }     CONVERT_RANGE(R_GU1, R_D1, SCR());
    }
    xcd_barrier(bar);
    }
    PT_END(7);

    PT_BEGIN(8);
    if (PH(8)) {
        PHASE_IDS();
        pg8::Gemm g{WSB(WS_F), WSB(WS_WD), ROWS_P, DM, DFF}; OrderXcd S; S.init(DM / 256, 0, G, bx);
        pg8::EpiResidB<true> E{WSB(WS_X1), WSB(WS_X1) + (size_t)ROWS_P * DM, nullptr, nullptr, (float*)(ws + WS_PART2)};
        pg8::gemm_phase<pg8::EpiResidB<true>, OrderXcd, true, true, false, true>(L + RING_OFF, g, S, E);
        { OrderSlices S2{DFF / 128, G, bx}; pg8::EpiSlab E2{(float*)(ws + WS_SLAB), DFF / 128};
          pg8::gemm_phase<pg8::EpiSlab, OrderSlices, false, true, false, true, false, true>(L + RING_OFF, g, S2, E2); }
    }
    xcd_barrier(bar);
    PT_END(8);

    PT_BEGIN(9);
    if (PH(9)) { PHASE_IDS();
        const GAS f32x4* gr = (const GAS f32x4*)INP(20); f32x4 g[16];
#pragma unroll
        for (int j = 0; j < 8; ++j) { const int q = 2 * (lane + 64 * j); g[2 * j] = gr[q]; g[2 * j + 1] = gr[q + 1]; }
        v4u w[8]; f32x4 p4 = (f32x4){0.f, 0.f, 0.f, 0.f};
        if (gw < ROWS_P) { const GAS v4u* xr = (const GAS v4u*)(WSB(WS_X1) + (size_t)(ROWS_P + gw) * DM) + lane;
#pragma unroll
            for (int j = 0; j < 8; ++j) w[j] = xr[64 * j];
            p4 = *(const GAS f32x4*)((const float*)(ws + WS_PART2) + (size_t)gw * 256 + 4 * lane); }
#pragma unroll 1
        for (int m = gw; m < ROWS_P; m += NGW) {
            const int mn = m + NGW; v4u wn[8]; f32x4 pn = (f32x4){0.f, 0.f, 0.f, 0.f};
#pragma unroll
            for (int j = 0; j < 8; ++j) wn[j] = (v4u){0u, 0u, 0u, 0u};
            if (mn < ROWS_P) { const GAS v4u* xr = (const GAS v4u*)(WSB(WS_X1) + (size_t)(ROWS_P + mn) * DM) + lane;
#pragma unroll
                for (int j = 0; j < 8; ++j) wn[j] = xr[64 * j];
                pn = *(const GAS f32x4*)((const float*)(ws + WS_PART2) + (size_t)mn * 256 + 4 * lane); }
            const float r = 1.0f / sqrtf(wave_sum((p4.x + p4.y) + (p4.z + p4.w)) * (1.0f / DM) + EPS);
            GAS f32x4* orow = (GAS f32x4*)(out + O_YP + (size_t)m * DM);
#pragma unroll
            for (int j = 0; j < 8; ++j) { float x[8]; unpack8(w[j], x); const int q = 2 * (lane + 64 * j); const f32x4 g0 = g[2 * j], g1 = g[2 * j + 1];
                orow[q] = (f32x4){(x[0] * r) * g0.x, (x[1] * r) * g0.y, (x[2] * r) * g0.z, (x[3] * r) * g0.w}; orow[q + 1] = (f32x4){(x[4] * r) * g1.x, (x[5] * r) * g1.y, (x[6] * r) * g1.z, (x[7] * r) * g1.w}; }
#pragma unroll
            for (int j = 0; j < 8; ++j) w[j] = wn[j];
            p4 = pn;
        }
        for (int r = bx; r < ROWS_R - ROWS_P; r += G) {
            const int c = 512 * wave + 8 * lane;
            const float* xr = (const float*)(ws + WS_X1) + (size_t)(ROWS_P + r) * DM + c; const float* sl = (const float*)(ws + WS_SLAB) + (size_t)r * DM + c;
            f32x4 a0 = ldg4f(xr), a1 = ldg4f(xr + 4);
#pragma unroll
            for (int h = 0; h < 2; ++h) { f32x4 t0[8], t1[8];
#pragma unroll
                for (int q = 0; q < 8; ++q) { t0[q] = ldg4f(sl + (size_t)(8 * h + q) * 128 * DM); t1[q] = ldg4f(sl + (size_t)(8 * h + q) * 128 * DM + 4); }
#pragma unroll
                for (int q = 0; q < 8; ++q) { a0 += t0[q]; a1 += t1[q]; } }
            const float ssw = wave_sum(((a0.x * a0.x + a0.y * a0.y) + (a0.z * a0.z + a0.w * a0.w)) + ((a1.x * a1.x + a1.y * a1.y) + (a1.z * a1.z + a1.w * a1.w)));
            LAS float* red = (LAS float*)(L + RING_OFF);
            if (lane == 0) red[wave] = ssw;
            __syncthreads();
            const float tot = ((red[0] + red[1]) + (red[2] + red[3])) + ((red[4] + red[5]) + (red[6] + red[7]));
            __syncthreads();
            const float rr = 1.0f / sqrtf(tot * (1.0f / DM) + EPS);
            const f32x4 g0 = ldg4f(INP(20) + c), g1 = ldg4f(INP(20) + c + 4);
            float* yo = out + O_YS + (size_t)r * DM + c;
            *(GAS f32x4*)yo = (a0 * rr) * g0; *(GAS f32x4*)(yo + 4) = (a1 * rr) * g1;
        }
    }
    PT_END(9);
#ifdef PROBE_PHASES
#ifndef PROBE_BLOCK
#define PROBE_BLOCK 0
#endif
    if (blockIdx.x == PROBE_BLOCK) { const unsigned long long t0_ = __builtin_amdgcn_s_memrealtime(); while (__builtin_amdgcn_s_memrealtime() - t0_ < probe_acc_) __builtin_amdgcn_s_sleep(8); }
#endif
#ifdef PROBE_CLOCK
    if (blockIdx.x == 0) {
#ifdef PROBE_CYCLES
        const unsigned long long want = probe_dc_ * 20ull / 576ull, t0_ = __builtin_amdgcn_s_memrealtime();
#else
        const unsigned long long want = probe_dc_ * 5000ull / probe_dr_, t0_ = __builtin_amdgcn_s_memrealtime();
#endif
        while (__builtin_amdgcn_s_memrealtime() - t0_ < want) __builtin_amdgcn_s_sleep(8);
    }
#endif
}

extern "C" void kernel_launch(void* const* d_in, const int* in_sizes, int n_in, void* d_out, int out_size, void* d_ws, size_t ws_size, hipStream_t stream) {
    static int grid = 0;
    if (grid == 0) {
        if (n_in != 21 || in_sizes[0] != ROWS_P * DM || (size_t)out_size != O_END || ws_size < WS_END) {
            fprintf(stderr, "kernel_launch: built for 21 inputs, x_prompt of %d floats, %zu outputs, >= %zu bytes of workspace; got n_in %d, in0 %d, out %d, ws %zu; nothing launched\n", ROWS_P * DM, (size_t)O_END, (size_t)WS_END, n_in, n_in > 0 ? in_sizes[0] : -1, out_size, ws_size);
            grid = -1; return; }
        int dev = 0, cus = 0, per_cu = 0;
        if (hipGetDevice(&dev) != hipSuccess || hipDeviceGetAttribute(&cus, hipDeviceAttributeMultiprocessorCount, dev) != hipSuccess) { fprintf(stderr, "kernel_launch: hipGetDevice / hipDeviceGetAttribute failed; nothing launched\n"); grid = -1; return; }
        if (hipFuncSetAttribute((const void*)mega_fwd, hipFuncAttributeMaxDynamicSharedMemorySize, LDS_BYTES) != hipSuccess) { fprintf(stderr, "kernel_launch: hipFuncSetAttribute failed; nothing launched\n"); grid = -1; return; }
        if (hipOccupancyMaxActiveBlocksPerMultiprocessor(&per_cu, (const void*)mega_fwd, NWAVES * 64, LDS_BYTES) != hipSuccess || per_cu < 1)
            fprintf(stderr, "kernel_launch: note: the occupancy query reports %d workgroups per CU\n", per_cu);
        (void)hipGetLastError();
        grid = cus;
    }
    if (grid < 0) return;
    if (hipMemsetAsync((char*)d_ws + WS_CTL, 0, CTL_ZERO_BYTES, stream) != hipSuccess) { fprintf(stderr, "kernel_launch: hipMemsetAsync failed; nothing launched\n"); return; }
    Args a{};
    for (int i = 0; i < 21; ++i) a.in[i] = (const float*)d_in[i];
    a.out = (float*)d_out; a.ws = (unsigned char*)d_ws;
    hipLaunchKernelGGL(mega_fwd, dim3(grid), dim3(NWAVES * 64), LDS_BYTES, stream, a);
    const hipError_t le = hipPeekAtLastError();
    if (le != hipSuccess) fprintf(stderr, "kernel_launch: launch failed: %s (grid %d x %d threads, %d B LDS)\n", hipGetErrorName(le), grid, NWAVES * 64, LDS_BYTES);
}
```

```cpp
#include <hip/hip_runtime.h>
#include <cstdio>
#include <cstdint>
#include <cmath>
namespace pg8 {
#define PG8_LAS __attribute__((address_space(3)))
typedef unsigned short bf16_t;
typedef short bf16x8 __attribute__((ext_vector_type(8)));
typedef float f32x4 __attribute__((ext_vector_type(4)));
typedef unsigned u32x4 __attribute__((ext_vector_type(4)));
constexpr int BM = 256, BK = 64, HALF = 128, HTB = HALF * BK * 2  , STAGE_BYTES = 8 * HTB, NXCD = 8, WGM = 8;

__host__ __device__ __forceinline__ int lds_byte(int r, int c) { const int st = (r >> 4) * 2 + (c >> 5), rr = r & 15, cc = c & 31, ob = rr * 64 + cc * 2; return st * 1024 + (ob ^ (((ob >> 9) & 1) << 5)); }
__host__ __device__ __forceinline__ void stage_rc(int b, int& R, int& C) { const int st = b / 1024, sb = b % 1024, swz = sb ^ (((sb >> 9) & 1) << 5); R = (st >> 1) * 16 + swz / 64; C = (st & 1) * 32 + (swz % 64) / 2; }
__host__ __device__ __forceinline__ int perm32(int rho) { const int n = rho >> 4, i = rho & 15; return 8 * (i >> 2) + 4 * n + (i & 3); }

struct Unit { int pm, pn, kn; };
struct Gemm { const bf16_t* A; const bf16_t* Bt; int M, N, K; };

struct StaticOrder {
    int nM, nN, nwg, G, c;
    __host__ __device__ void init(int M, int N, int G_, int c_) { nM = M / BM; nN = N / BM; nwg = nM * nN; G = G_; c = c_; }
    __host__ __device__ bool next(int i, Unit& u) const {
        const long L = (long)i * G + c; if (L >= nwg) return false;
        int wgid = (int)L; { const int q = nwg / NXCD, r = nwg % NXCD, xcd = wgid % NXCD, off = wgid / NXCD; wgid = (xcd < r ? xcd * (q + 1) : r * (q + 1) + (xcd - r) * q) + off; }
        const int nig = WGM * nN, gid = wgid / nig, fm = gid * WGM, gsz = (nM - fm) < WGM ? (nM - fm) : WGM;
        u.pm = fm + ((wgid % nig) % gsz); u.pn = (wgid % nig) / gsz; return true;
    }
    __device__ __forceinline__ void a_ready(const Unit&) const {}
    __device__ __forceinline__ void done(const Unit&) const {}
};

__device__ __forceinline__ unsigned cvt_pk_bf16(float lo, float hi) { unsigned r; asm volatile("v_cvt_pk_bf16_f32 %0, %1, %2" : "=v"(r) : "v"(lo), "v"(hi)); return r; }
typedef float f32x2 __attribute__((ext_vector_type(2)));

#define PG8_GAS __attribute__((address_space(1)))
constexpr int ROWS_P = 8192, ROWS_R = 8320, ROWS_PAD = 8448, PAN_S = 32;
constexpr size_t O_YP = 0, O_YS = 33554432, O_PK = 34078720, O_PV = 34340864, O_PC = 34603008, O_PF = 34619392, O_SK = 34707456, O_SV = 43096064, O_SC = 51484672, O_SF = 52008960, O_END = 54827008;

__device__ __forceinline__ u32x4 pack8(const f32x4 a, const f32x4 b) { u32x4 w; w.x = cvt_pk_bf16(a[0], a[1]); w.y = cvt_pk_bf16(a[2], a[3]); w.z = cvt_pk_bf16(b[0], b[1]); w.w = cvt_pk_bf16(b[2], b[3]); return w; }
__device__ __forceinline__ float bf_lo(unsigned w) { return __uint_as_float(w << 16); }
__device__ __forceinline__ float bf_hi(unsigned w) { return __uint_as_float(w & 0xffff0000u); }
__device__ __forceinline__ void st16(void* p, u32x4 v) { *(PG8_GAS u32x4*)p = v; }
__device__ __forceinline__ void st16f(float* p, f32x4 v) { *(PG8_GAS f32x4*)p = v; }
__device__ __forceinline__ u32x4 ld16(const void* p) { return *(const PG8_GAS u32x4*)p; }
__device__ __forceinline__ f32x4 ld16f(const float* p) { return *(const PG8_GAS f32x4*)p; }
__device__ __forceinline__ u32x4 ld16nt(const void* p) { return __builtin_nontemporal_load((const PG8_GAS u32x4*)p); }
__device__ __forceinline__ f32x4 ld16fnt(const float* p) { return __builtin_nontemporal_load((const PG8_GAS f32x4*)p); }
__device__ __forceinline__ void st16nt(void* p, u32x4 v) { __builtin_nontemporal_store(v, (PG8_GAS u32x4*)p); }
__device__ __forceinline__ float fast_exp(float x) { return __builtin_amdgcn_exp2f(x * 1.4426950408889634f); }

struct EpiProj {
    static constexpr bool PERM = true, AFTER_DRAIN = false, MIDK = false;
    bf16_t *CB, *UU, *Q, *KB, *VT, *RAT, *SGB; float* out; PG8_LAS bf16_t* vt_lds;
    __device__ __forceinline__ void mid(f32x4 (&)[2][2][4][2], const Unit&, int, int, int, int) const {}
    __device__ __forceinline__ void operator()(const f32x4 (&acc)[2][2][4][2], const Unit& u, int wr, int wc, int fr, int fq) const {
        const int pn = u.pn, pm = u.pm;
        const int rbase = pm * BM + wr * 64 + fr;
        const int cl = wc * 32 + 8 * fq;
        const int nai = (pm == PAN_S) ? 1 : 2;
        const bool winp = ((pm & 7) == 7) && (pm < PAN_S);
        if (pn < 8 || (pn >= 24 && pn < 34)) {
            bf16_t* base; int ld, c0;
            if (pn < 8) { base = CB; ld = 2048; c0 = pn * 256; }
            else if (pn < 32) { base = Q; ld = 2048; c0 = (pn - 24) * 256; }
            else { base = KB; ld = 512; c0 = (pn - 32) * 256; }
#pragma unroll
            for (int ai = 0; ai < 2; ++ai) if (ai < nai)
#pragma unroll
                for (int m = 0; m < 4; ++m) { const int row = rbase + ai * HALF + m * 16;
#pragma unroll
                    for (int bj = 0; bj < 2; ++bj) { bf16_t* d_ = base + (size_t)row * ld + c0 + bj * HALF + cl; const u32x4 w_ = pack8(acc[ai][bj][m][0], acc[ai][bj][m][1]);
                        if (pn < 8) st16nt(d_, w_); else st16(d_, w_); } }
            if (pn >= 32) {
                if (pm == PAN_S) {
#pragma unroll
                    for (int m = 0; m < 4; ++m) { const int b = rbase + m * 16 - ROWS_P;
#pragma unroll
                        for (int bj = 0; bj < 2; ++bj) { float* d = out + O_SK + ((size_t)b * 128 + 127) * 512 + c0 + bj * HALF + cl; st16f(d, acc[0][bj][m][0]); st16f(d + 4, acc[0][bj][m][1]); } }
                } else if (winp) {
#pragma unroll
                    for (int m = 0; m < 4; ++m) { const int row = rbase + HALF + m * 16, b = row >> 11, j = (row & 2047) - 1920;
#pragma unroll
                        for (int bj = 0; bj < 2; ++bj) { float* d = out + O_PK + ((size_t)b * 128 + j) * 512 + c0 + bj * HALF + cl; st16f(d, acc[1][bj][m][0]); st16f(d + 4, acc[1][bj][m][1]); } }
                }
            }
        } else if (pn < 24) {
            const int c0 = (pn - 8) * 128 + cl;
#pragma unroll
            for (int ai = 0; ai < 2; ++ai) if (ai < nai)
#pragma unroll
                for (int m = 0; m < 4; ++m) { const int row = rbase + ai * HALF + m * 16;
                    const f32x4 u0 = acc[ai][0][m][0] * acc[ai][1][m][0], u1 = acc[ai][0][m][1] * acc[ai][1][m][1];
                    st16nt(UU + (size_t)row * 2048 + c0, pack8(u0, u1));
                    if (pm == PAN_S) { float* d = out + O_SC + ((size_t)(row - ROWS_P) * 2 + 1) * 2048 + c0; st16f(d, u0); st16f(d + 4, u1); }
                    else if (winp && ai == 1 && m == 3 && wr == 1 && fr >= 14) { float* d = out + O_PC + ((size_t)(row >> 11) * 2 + (fr - 14)) * 2048 + c0; st16f(d, u0); st16f(d + 4, u1); }
                }
        } else if (pn < 36) {
            const int c0 = (pn - 34) * 256;
            if (pm < PAN_S) {
                PG8_LAS bf16_t* T = vt_lds + (wr * 4 + wc) * 512;
                const int l = fr + 16 * fq, rch = l >> 1, rh = l & 1;
#pragma unroll
                for (int ai = 0; ai < 2; ++ai)
#pragma unroll
                    for (int m = 0; m < 4; ++m)
#pragma unroll
                        for (int bj = 0; bj < 2; ++bj) {
#pragma unroll
                            for (int n = 0; n < 2; ++n) { const f32x4 v = acc[ai][bj][m][n]; const unsigned w0 = cvt_pk_bf16(v[0], v[1]), w1 = cvt_pk_bf16(v[2], v[3]);
                                PG8_LAS bf16_t* t = T + (8 * fq + 4 * n) * 16 + fr;
                                t[0] = (bf16_t)(w0 & 0xffffu); t[16] = (bf16_t)(w0 >> 16); t[32] = (bf16_t)(w1 & 0xffffu); t[48] = (bf16_t)(w1 >> 16); }
                            asm volatile("" ::: "memory");
                            const u32x4 tv = *(const PG8_LAS u32x4*)(T + rch * 16 + 8 * rh);
                            asm volatile("" ::: "memory");
                            st16(VT + (size_t)(c0 + bj * HALF + wc * 32 + rch) * ROWS_PAD + pm * BM + ai * HALF + wr * 64 + m * 16 + 8 * rh, tv); }
            }
            if (pm == PAN_S) {
#pragma unroll
                for (int m = 0; m < 4; ++m) { const int b = rbase + m * 16 - ROWS_P;
#pragma unroll
                    for (int bj = 0; bj < 2; ++bj) { float* d = out + O_SV + ((size_t)b * 128 + 127) * 512 + c0 + bj * HALF + cl; st16f(d, acc[0][bj][m][0]); st16f(d + 4, acc[0][bj][m][1]); } }
            } else if (winp) {
#pragma unroll
                for (int m = 0; m < 4; ++m) { const int row = rbase + HALF + m * 16, b = row >> 11, j = (row & 2047) - 1920;
#pragma unroll
                    for (int bj = 0; bj < 2; ++bj) { float* d = out + O_PV + ((size_t)b * 128 + j) * 512 + c0 + bj * HALF + cl; st16f(d, acc[1][bj][m][0]); st16f(d + 4, acc[1][bj][m][1]); } }
            }
        } else {
            const int c0 = (pn - 36) * 128 + cl;
#pragma unroll
            for (int ai = 0; ai < 2; ++ai) if (ai < nai)
#pragma unroll
                for (int m = 0; m < 4; ++m) { const int row = rbase + ai * HALF + m * 16;
                    f32x4 rt[2], sb[2];
#pragma unroll
                    for (int n = 0; n < 2; ++n)
#pragma unroll
                        for (int e = 0; e < 4; ++e) { const float ea = 1.0f + fast_exp(-acc[ai][0][m][n][e]), eb = 1.0f + fast_exp(-acc[ai][1][m][n][e]);
                            sb[n][e] = __builtin_amdgcn_rcpf(eb); rt[n][e] = eb * __builtin_amdgcn_rcpf(ea); }
                    st16nt(RAT + (size_t)row * 4096 + c0, pack8(rt[0], rt[1])); st16nt(SGB + (size_t)row * 4096 + c0, pack8(sb[0], sb[1])); }
        }
    }
};

struct EpiMerged {
    static constexpr bool PERM = true, AFTER_DRAIN = false, MIDK = true;
    const bf16_t *RAT, *SGB; bf16_t* MG;
    __device__ __forceinline__ void scale(f32x4 (&acc)[2][2][4][2], const bf16_t* S, const Unit& u, int wr, int wc, int fr, int fq) const {
        int rbase = u.pm * BM + wr * 64 + fr; const int c0 = u.pn * BM + wc * 32 + 8 * fq, nai = (u.pm == PAN_S) ? 1 : 2;
        asm volatile("" : "+v"(rbase));
        u32x4 r[2][4][2];
#pragma unroll
        for (int ai = 0; ai < 2; ++ai) if (ai < nai)
#pragma unroll
            for (int m = 0; m < 4; ++m)
#pragma unroll
                for (int bj = 0; bj < 2; ++bj) r[ai][m][bj] = ld16nt(S + (size_t)(rbase + ai * HALF + m * 16) * 4096 + c0 + bj * HALF);
#pragma unroll
        for (int ai = 0; ai < 2; ++ai) if (ai < nai)
#pragma unroll
            for (int m = 0; m < 4; ++m)
#pragma unroll
                for (int bj = 0; bj < 2; ++bj) { const u32x4 q = r[ai][m][bj];
                    acc[ai][bj][m][0] *= (f32x4){bf_lo(q.x), bf_hi(q.x), bf_lo(q.y), bf_hi(q.y)}; acc[ai][bj][m][1] *= (f32x4){bf_lo(q.z), bf_hi(q.z), bf_lo(q.w), bf_hi(q.w)}; }
    }
    __device__ __forceinline__ void mid(f32x4 (&acc)[2][2][4][2], const Unit& u, int wr, int wc, int fr, int fq) const { scale(acc, RAT, u, wr, wc, fr, fq); }
    __device__ __forceinline__ void operator()(f32x4 (&acc)[2][2][4][2], const Unit& u, int wr, int wc, int fr, int fq) const {
        scale(acc, SGB, u, wr, wc, fr, fq);
        const int rbase = u.pm * BM + wr * 64 + fr, c0 = u.pn * BM + wc * 32 + 8 * fq, nai = (u.pm == PAN_S) ? 1 : 2;
#pragma unroll
        for (int ai = 0; ai < 2; ++ai) if (ai < nai)
#pragma unroll
            for (int m = 0; m < 4; ++m) { const int row = rbase + ai * HALF + m * 16;
#pragma unroll
                for (int bj = 0; bj < 2; ++bj) st16(MG + (size_t)row * 4096 + c0 + bj * HALF, pack8(acc[ai][bj][m][0], acc[ai][bj][m][1])); }
    }
};

template <bool BASE_BF16> struct EpiResidB {
    static constexpr bool PERM = true, AFTER_DRAIN = false, MIDK = false;
    const void* base; bf16_t* Xo; bf16_t* XN2; const float* g2; float* part;
    __device__ __forceinline__ void mid(f32x4 (&)[2][2][4][2], const Unit&, int, int, int, int) const {}
    __device__ __forceinline__ void operator()(const f32x4 (&acc)[2][2][4][2], const Unit& u, int wr, int wc, int fr, int fq) const {
        const int rbase = u.pm * BM + wr * 64 + fr, c0 = u.pn * BM + wc * 32 + 8 * fq;
        f32x4 gv[2][2];
        if (XN2) {
#pragma unroll
            for (int bj = 0; bj < 2; ++bj)
#pragma unroll
                for (int n = 0; n < 2; ++n) gv[bj][n] = ld16f(g2 + c0 + bj * HALF + 4 * n); }
        u32x4 wb[2][4][2];
        if (BASE_BF16) {
#pragma unroll
            for (int ai = 0; ai < 2; ++ai)
#pragma unroll
                for (int m = 0; m < 4; ++m)
#pragma unroll
                    for (int bj = 0; bj < 2; ++bj) wb[ai][m][bj] = ld16nt((const bf16_t*)base + (size_t)(rbase + ai * HALF + m * 16) * 4096 + c0 + bj * HALF); }
#pragma unroll
        for (int ai = 0; ai < 2; ++ai) {
            f32x4 xb[4][2][2];
            if (!BASE_BF16) {
#pragma unroll
                for (int m = 0; m < 4; ++m)
#pragma unroll
                    for (int bj = 0; bj < 2; ++bj) { const size_t o = (size_t)(rbase + ai * HALF + m * 16) * 4096 + c0 + bj * HALF; xb[m][bj][0] = ld16fnt((const float*)base + o); xb[m][bj][1] = ld16fnt((const float*)base + o + 4); } }
#pragma unroll
            for (int m = 0; m < 4; ++m) { const int row = rbase + ai * HALF + m * 16; f32x4 xo[2][2]; float ss = 0.f;
#pragma unroll
                for (int bj = 0; bj < 2; ++bj) {
                    if (BASE_BF16) { const u32x4 w = wb[ai][m][bj];
                        xo[bj][0] = (f32x4){bf_lo(w.x), bf_hi(w.x), bf_lo(w.y), bf_hi(w.y)} + acc[ai][bj][m][0]; xo[bj][1] = (f32x4){bf_lo(w.z), bf_hi(w.z), bf_lo(w.w), bf_hi(w.w)} + acc[ai][bj][m][1]; }
                    else { xo[bj][0] = xb[m][bj][0] + acc[ai][bj][m][0]; xo[bj][1] = xb[m][bj][1] + acc[ai][bj][m][1]; } }
#pragma unroll
                for (int bj = 0; bj < 2; ++bj) { st16(Xo + (size_t)row * 4096 + c0 + bj * HALF, pack8(xo[bj][0], xo[bj][1]));
#pragma unroll
                    for (int n = 0; n < 2; ++n) ss += (xo[bj][n][0] * xo[bj][n][0] + xo[bj][n][1] * xo[bj][n][1]) + (xo[bj][n][2] * xo[bj][n][2] + xo[bj][n][3] * xo[bj][n][3]);
                    if (XN2) { const int c = c0 + bj * HALF; st16(XN2 + ((size_t)(row >> 8) * 64 + (c >> 6)) * 16384 + (size_t)(row & 255) * 64 + (c & 63), pack8(xo[bj][0] * gv[bj][0], xo[bj][1] * gv[bj][1])); } }
                *(PG8_GAS float*)(part + (size_t)row * 256 + 16 * u.pn + 4 * wc + fq) = ss; }
            asm volatile("" ::: "memory"); }
    }
};

struct EpiGateUpF {
    static constexpr bool PERM = true, AFTER_DRAIN = false, MIDK = false;
    bf16_t* F; float* sideG; float* sideU; const float* cw; const float* cbias; const float* st; float* out; PG8_LAS float* xch; const float* rstat;
    __device__ __forceinline__ void mid(f32x4 (&)[2][2][4][2], const Unit&, int, int, int, int) const {}
    static __device__ __forceinline__ float rot1(float x, int idx) { return __builtin_bit_cast(float, __builtin_amdgcn_ds_bpermute(idx, __builtin_bit_cast(int, x))); }
    static __device__ __forceinline__ f32x4 rot(const f32x4 v, int idx) {
        const float a = rot1(v.x, idx), b = rot1(v.y, idx), c = rot1(v.z, idx), d = rot1(v.w, idx);
        return (f32x4){a, b, c, d}; }
    static __device__ __forceinline__ f32x4 silu_mul4(const f32x4 gc, const f32x4 u) { f32x4 r;
#pragma unroll
        for (int e = 0; e < 4; ++e) r[e] = gc[e] * __builtin_amdgcn_rcpf(1.0f + __builtin_amdgcn_exp2f(-gc[e] * 1.4426950408889634f)) * u[e];
        return r; }
    __device__ __forceinline__ void operator()(f32x4 (&acc)[2][2][4][2], const Unit& u, int wr, int wc, int fr, int fq) const {
        const int pn = u.pn, pm = u.pm;
        const int cl = wc * 32 + 8 * fq, c0 = pn * 128 + cl;
        const int rbase = pm * BM + wr * 64 + fr;
        f32x4 w0[2], w1[2], w2[2], bb[2];
#pragma unroll
        for (int n = 0; n < 2; ++n) { w0[n] = ld16f(cw + c0 + 4 * n); w1[n] = ld16f(cw + 11008 + c0 + 4 * n); w2[n] = ld16f(cw + 2 * 11008 + c0 + 4 * n); bb[n] = ld16f(cbias + c0 + 4 * n); }
        {
            float rs[2][4];
#pragma unroll
            for (int ai = 0; ai < 2; ++ai)
#pragma unroll
                for (int m = 0; m < 4; ++m) rs[ai][m] = *(const PG8_GAS float*)(rstat + pm * BM + wr * 64 + fr + ai * HALF + m * 16);
#pragma unroll
            for (int ai = 0; ai < 2; ++ai)
#pragma unroll
                for (int bj = 0; bj < 2; ++bj)
#pragma unroll
                    for (int m = 0; m < 4; ++m)
#pragma unroll
                        for (int n = 0; n < 2; ++n) acc[ai][bj][m][n] *= rs[ai][m];
        }
        if (pm == PAN_S) {
            f32x4 s0[4][2], s1[4][2];
#pragma unroll
            for (int m = 0; m < 4; ++m)
#pragma unroll
                for (int n = 0; n < 2; ++n) { const int b = rbase + m * 16 - ROWS_P; s0[m][n] = ld16f(st + ((size_t)b * 2 + 0) * 11008 + c0 + 4 * n); s1[m][n] = ld16f(st + ((size_t)b * 2 + 1) * 11008 + c0 + 4 * n); }
#pragma unroll
            for (int m = 0; m < 4; ++m) { const int b = rbase + m * 16 - ROWS_P; f32x4 f[2];
#pragma unroll
                for (int n = 0; n < 2; ++n) { const f32x4 g = acc[0][0][m][n];
                    st16f(out + O_SF + ((size_t)b * 2 + 0) * 11008 + c0 + 4 * n, s1[m][n]); st16f(out + O_SF + ((size_t)b * 2 + 1) * 11008 + c0 + 4 * n, g);
                    f[n] = silu_mul4(((w0[n] * s0[m][n] + w1[n] * s1[m][n]) + w2[n] * g) + bb[n], acc[0][1][m][n]); }
                st16nt(F + (size_t)(rbase + m * 16) * 11008 + c0, pack8(f[0], f[1])); }
            asm volatile("s_waitcnt lgkmcnt(0)" ::: "memory"); __builtin_amdgcn_s_barrier(); asm volatile("" ::: "memory");
            return;
        }
        if (fr >= 14) {
#pragma unroll
            for (int ai = 0; ai < 2; ++ai)
#pragma unroll
                for (int n = 0; n < 2; ++n) *(PG8_LAS f32x4*)(xch + ((ai * 2 + wr) * 2 + (fr - 14)) * 128 + cl + 4 * n) = acc[ai][0][3][n];
        }
        asm volatile("s_waitcnt lgkmcnt(0)" ::: "memory"); __builtin_amdgcn_s_barrier(); asm volatile("" ::: "memory");
        const int lane_ = fr + 16 * fq, i1 = ((lane_ & 48) | ((fr + 15) & 15)) << 2, i2 = ((lane_ & 48) | ((fr + 14) & 15)) << 2;
        const bool winp = ((pm & 7) == 7);
#pragma unroll
        for (int ai = 0; ai < 2; ++ai) {
            f32x4 c1[2], c2[2];
            if (ai == 0 && wr == 0) {
#pragma unroll
                for (int n = 0; n < 2; ++n) { c1[n] = (f32x4){0.f, 0.f, 0.f, 0.f}; c2[n] = (f32x4){0.f, 0.f, 0.f, 0.f}; }
            } else {
                const int sa = (wr == 1) ? ai : ai - 1, sw = (wr == 1) ? 0 : 1;
#pragma unroll
                for (int n = 0; n < 2; ++n) { const f32x4 l2 = *(const PG8_LAS f32x4*)(xch + ((sa * 2 + sw) * 2 + 0) * 128 + cl + 4 * n), l1 = *(const PG8_LAS f32x4*)(xch + ((sa * 2 + sw) * 2 + 1) * 128 + cl + 4 * n);
                    c1[n] = l1; c2[n] = (fr == 0) ? l2 : l1; }
            }
#pragma unroll
            for (int m = 0; m < 4; ++m) { const int row = rbase + ai * HALF + m * 16; f32x4 f[2];
#pragma unroll
                for (int n = 0; n < 2; ++n) { const f32x4 g = acc[ai][0][m][n], r1 = rot(g, i1), r2 = rot(g, i2);
                    f32x4 p1, p2;
#pragma unroll
                    for (int e = 0; e < 4; ++e) { p1[e] = (fr >= 1) ? r1[e] : c1[n][e]; p2[e] = (fr >= 2) ? r2[e] : c2[n][e]; }
                    c1[n] = r1; c2[n] = r2;
                    f[n] = silu_mul4(((w0[n] * p2 + w1[n] * p1) + w2[n] * g) + bb[n], acc[ai][1][m][n]); }
                st16nt(F + (size_t)row * 11008 + c0, pack8(f[0], f[1]));
                if (ai == 0 && m == 0 && wr == 0 && fr < 2) {
#pragma unroll
                    for (int n = 0; n < 2; ++n) { st16f(sideG + ((size_t)pm * 4 + fr) * 11008 + c0 + 4 * n, acc[0][0][0][n]); st16f(sideU + ((size_t)pm * 2 + fr) * 11008 + c0 + 4 * n, acc[0][1][0][n]); } }
                if (ai == 1 && m == 3 && wr == 1 && fr >= 14) {
#pragma unroll
                    for (int n = 0; n < 2; ++n) { st16f(sideG + ((size_t)pm * 4 + 2 + (fr - 14)) * 11008 + c0 + 4 * n, acc[1][0][3][n]);
                        if (winp) st16f(out + O_PF + ((size_t)(row >> 11) * 2 + (fr - 14)) * 11008 + c0 + 4 * n, acc[1][0][3][n]); } }
            }
        }
    }
};

struct EpiSlab {
    static constexpr bool PERM = true, AFTER_DRAIN = false, MIDK = false;
    float* slab; int np;
    __device__ __forceinline__ void mid(f32x4 (&)[2][2][4][2], const Unit&, int, int, int, int) const {}
    __device__ __forceinline__ void operator()(const f32x4 (&acc)[2][2][4][2], const Unit& u, int wr, int wc, int fr, int fq) const {
        const int sl = (8 * (u.kn & 0xffff) + np - 1) / np;
        float* sp = slab + ((size_t)sl * 128 + wr * 64 + fr) * 4096 + u.pn * BM + wc * 32 + 8 * fq;
#pragma unroll
        for (int m = 0; m < 4; ++m)
#pragma unroll
            for (int bj = 0; bj < 2; ++bj) { st16f(sp + (size_t)(m * 16) * 4096 + bj * HALF, acc[0][bj][m][0]); st16f(sp + (size_t)(m * 16) * 4096 + bj * HALF + 4, acc[0][bj][m][1]); }
    }
};
struct EpiNull {
    static constexpr bool PERM = true, AFTER_DRAIN = false, MIDK = false;
    float* sink;
    __device__ __forceinline__ void mid(f32x4 (&)[2][2][4][2], const Unit&, int, int, int, int) const {}
    __device__ __forceinline__ void operator()(const f32x4 (&acc)[2][2][4][2], const Unit& u, int wr, int wc, int fr, int fq) const {
        f32x4 s = acc[0][0][0][0];
#pragma unroll
        for (int ai = 0; ai < 2; ++ai)
#pragma unroll
            for (int bj = 0; bj < 2; ++bj)
#pragma unroll
                for (int m = 0; m < 4; ++m)
#pragma unroll
                    for (int n = 0; n < 2; ++n) s += acc[ai][bj][m][n];
        if (s[0] == 123456.789f && s[1] == 1.f && s[2] == 2.f && s[3] == 3.f) *(PG8_GAS float*)sink = s[0];
    }
};
template <class Epi, class Sched, bool ALIGN_EPI = false, bool SP2 = false, bool TA = false, bool TB = false, bool BNT = false, bool VARK = false, bool SKIP32 = false>
__device__ __forceinline__ void gemm_phase(PG8_LAS unsigned char* lds, const Gemm g, const Sched& S, const Epi& E) {
    int tid_ = threadIdx.x; asm volatile("" : "+v"(tid_));
    const int tid = tid_, wid = __builtin_amdgcn_readfirstlane(tid >> 6), lane = tid & 63, wr = wid >> 2, wc = wid & 3, fr = lane & 15, fq = lane >> 4;
    const int K = g.K, nt = K / BK;
    unsigned voffA[2], voffB[2];
#pragma unroll
    for (int i = 0; i < 2; ++i) { int R, C; stage_rc(tid * 16 + i * 8192, R, C); const int Rb = Epi::PERM ? ((R & ~31) + perm32(R & 31)) : R;
        voffA[i] = (unsigned)(R * (TA ? BK : K) + C) * 2u; voffB[i] = (unsigned)(Rb * (TB ? BK : K) + C) * 2u; }
    const size_t kstepA = TA ? (size_t)BM * BK * 2 : (size_t)(BK * 2), kstepB = TB ? (size_t)BM * BK * 2 : (size_t)(BK * 2);
    const size_t hstepA = TA ? (size_t)HALF * BK * 2 : (size_t)HALF * K * 2, hstepB = TB ? (size_t)HALF * BK * 2 : (size_t)HALF * K * 2;
    const size_t tstepA = (size_t)BM * K * 2, tstepB = (size_t)BM * K * 2;
    const unsigned ldsw = (unsigned)wid * 1024u;
    const int aoff = lds_byte(wr * 64 + fr, fq * 8), boff = lds_byte(wc * 32 + fr, fq * 8);
#define PG8_SA(b, h) (((b) * 2 + (h)) * HTB)
#define PG8_SB(b, h) ((4 + (b) * 2 + (h)) * HTB)
#define PG8_STAGE(bufoff, gbase, voff) do { _Pragma("unroll") for (int _i = 0; _i < 2; ++_i) \
        __builtin_amdgcn_global_load_lds((const unsigned*)((const char*)(gbase) + (voff)[_i]), (PG8_LAS unsigned*)(lds + (bufoff) + ldsw + _i * 8192), 16, 0, 0); } while (0)
#define PG8_STAGEB(bufoff, gbase, voff) do { if constexpr (BNT) { _Pragma("unroll") for (int _i = 0; _i < 2; ++_i) \
        __builtin_amdgcn_global_load_lds((const unsigned*)((const char*)(gbase) + (voff)[_i]), (PG8_LAS unsigned*)(lds + (bufoff) + ldsw + _i * 8192), 16, 0, 2); } else PG8_STAGE(bufoff, gbase, voff); } while (0)
#define PG8_LDA(dst, b, h) do { _Pragma("unroll") for (int m = 0; m < 4; ++m) _Pragma("unroll") for (int k = 0; k < 2; ++k) dst[m][k] = *(const PG8_LAS bf16x8*)(lds + PG8_SA(b, h) + aoff + m * 2048 + k * 1024); } while (0)
#define PG8_LDB(dst, b, h) do { _Pragma("unroll") for (int n = 0; n < 2; ++n) _Pragma("unroll") for (int k = 0; k < 2; ++k) dst[n][k] = *(const PG8_LAS bf16x8*)(lds + PG8_SB(b, h) + boff + n * 2048 + k * 1024); } while (0)
#ifdef PG8_STATIC_PRIO
#define PG8_MMA(ai, bj, At, Bt) do { _Pragma("unroll") for (int m = 0; m < 4; ++m) _Pragma("unroll") for (int n = 0; n < 2; ++n) _Pragma("unroll") for (int k = 0; k < 2; ++k) \
        acc[ai][bj][m][n] = __builtin_amdgcn_mfma_f32_16x16x32_bf16(Bt[n][k], At[m][k], acc[ai][bj][m][n], 0, 0, 0); } while (0)
#else
#define PG8_MMA(ai, bj, At, Bt) do { __builtin_amdgcn_s_setprio(1); _Pragma("unroll") for (int m = 0; m < 4; ++m) _Pragma("unroll") for (int n = 0; n < 2; ++n) _Pragma("unroll") for (int k = 0; k < 2; ++k) \
        acc[ai][bj][m][n] = __builtin_amdgcn_mfma_f32_16x16x32_bf16(Bt[n][k], At[m][k], acc[ai][bj][m][n], 0, 0, 0); __builtin_amdgcn_s_setprio(0); } while (0)
#endif
#define PG8_WAIT_V(n) asm volatile("s_waitcnt vmcnt(" #n ")" ::: "memory")
#define PG8_WAIT_L(n) asm volatile("s_waitcnt lgkmcnt(" #n ")" ::: "memory")
#define PG8_BAR __builtin_amdgcn_s_barrier()
#define PG8_SCHED __builtin_amdgcn_sched_barrier(0)
    Unit cur, nxt; int ui = 0;
    if (!S.next(0, cur)) return;
#ifdef PG8_STATIC_PRIO
    if (wr == 1) __builtin_amdgcn_s_setprio(1);
#endif
    f32x4 acc[2][2][4][2];
#pragma unroll
    for (int a = 0; a < 2; ++a)
#pragma unroll
        for (int b = 0; b < 2; ++b)
#pragma unroll
            for (int m = 0; m < 4; ++m)
#pragma unroll
                for (int n = 0; n < 2; ++n) acc[a][b][m][n] = (f32x4){0.f, 0.f, 0.f, 0.f};
    bf16x8 At[4][2], B0[2][2], B1[2][2];
    const char* cA = (const char*)g.A + (size_t)cur.pm * tstepA + (VARK ? (size_t)(cur.kn & 0xffff) * kstepA : (size_t)0); const char* cB = (const char*)g.Bt + (size_t)cur.pn * tstepB + (VARK ? (size_t)(cur.kn & 0xffff) * kstepB : (size_t)0);
    S.a_ready(cur);
    if constexpr (SP2) {
        PG8_STAGEB(PG8_SB(0, 0), cB, voffB); PG8_STAGEB(PG8_SB(0, 1), cB + hstepB, voffB); PG8_STAGE(PG8_SA(0, 0), cA, voffA); PG8_STAGE(PG8_SA(0, 1), cA + hstepA, voffA);
        if (wr == 1) PG8_BAR;
        PG8_WAIT_V(2); PG8_BAR;
        PG8_STAGEB(PG8_SB(1, 0), cB + kstepB, voffB); PG8_STAGE(PG8_SA(1, 0), cA + kstepA, voffA); PG8_STAGEB(PG8_SB(1, 1), cB + hstepB + kstepB, voffB);
        PG8_WAIT_V(6); PG8_BAR;
    } else {
        PG8_STAGEB(PG8_SB(0, 0), cB, voffB); PG8_STAGE(PG8_SA(0, 0), cA, voffA); PG8_STAGEB(PG8_SB(0, 1), cB + hstepB, voffB); PG8_STAGE(PG8_SA(0, 1), cA + hstepA, voffA);
        if (wr == 1) PG8_BAR;
        PG8_WAIT_V(4); PG8_BAR;
        PG8_STAGEB(PG8_SB(1, 0), cB + kstepB, voffB); PG8_STAGE(PG8_SA(1, 0), cA + kstepA, voffA); PG8_STAGEB(PG8_SB(1, 1), cB + hstepB + kstepB, voffB);
        PG8_WAIT_V(6); PG8_BAR;
    }
    for (;;) {
        const bool has_next = S.next(ui + 1, nxt);
        const char* nA = has_next ? (const char*)g.A + (size_t)nxt.pm * tstepA + (VARK ? (size_t)(nxt.kn & 0xffff) * kstepA : (size_t)0) : cA; const char* nB = has_next ? (const char*)g.Bt + (size_t)nxt.pn * tstepB + (VARK ? (size_t)(nxt.kn & 0xffff) * kstepB : (size_t)0) : cB;
        const int ntu = VARK ? (cur.kn >> 16) : nt;
        const bool fullm = !(VARK || SKIP32) || cur.pm < 32;
        for (int t = 0; t < ntu; t += 2) {
            if constexpr (Epi::MIDK) { if (t == (nt >> 1)) E.mid(acc, cur, wr, wc, fr, fq); }
            const bool last = (t == ntu - 2);
            const char* a1 = cA + (size_t)(t + 1) * kstepA;
            const char* a2 = last ? nA : cA + (size_t)(t + 2) * kstepA; const char* b2 = last ? nB : cB + (size_t)(t + 2) * kstepB;
            const char* a3 = a2 + kstepA; const char* b3 = b2 + kstepB;
            if (last && has_next) S.a_ready(nxt);
            if constexpr (SP2) {
            PG8_LDB(B0, 0, 0); PG8_LDB(B1, 0, 1); PG8_SCHED; PG8_LDA(At, 0, 0); PG8_STAGE(PG8_SA(1, 1), a1 + hstepA, voffA);
            PG8_WAIT_V(8); PG8_WAIT_L(0); PG8_BAR; PG8_MMA(0, 0, At, B0); PG8_MMA(0, 1, At, B1); PG8_BAR; PG8_SCHED;
            PG8_LDA(At, 0, 1); PG8_STAGEB(PG8_SB(0, 0), b2, voffB); PG8_STAGEB(PG8_SB(0, 1), b2 + hstepB, voffB); PG8_STAGE(PG8_SA(0, 0), a2, voffA);
            PG8_WAIT_V(8); PG8_WAIT_L(0); PG8_BAR; if (fullm) { PG8_MMA(1, 0, At, B0); PG8_MMA(1, 1, At, B1); } PG8_BAR; PG8_SCHED;
            PG8_LDB(B0, 1, 0); PG8_LDB(B1, 1, 1); PG8_SCHED; PG8_LDA(At, 1, 0); PG8_STAGE(PG8_SA(0, 1), a2 + hstepA, voffA);
            PG8_WAIT_V(8); PG8_WAIT_L(0); PG8_BAR; PG8_MMA(0, 0, At, B0); PG8_MMA(0, 1, At, B1); PG8_BAR; PG8_SCHED;
            PG8_LDA(At, 1, 1); PG8_STAGEB(PG8_SB(1, 0), b3, voffB); PG8_STAGEB(PG8_SB(1, 1), b3 + hstepB, voffB); PG8_STAGE(PG8_SA(1, 0), a3, voffA);
            PG8_WAIT_V(8); PG8_WAIT_L(0); PG8_BAR; if (fullm) { PG8_MMA(1, 0, At, B0); PG8_MMA(1, 1, At, B1); } PG8_BAR; PG8_SCHED;
            } else {
            PG8_LDB(B0, 0, 0); PG8_SCHED; PG8_LDA(At, 0, 0); PG8_STAGE(PG8_SA(1, 1), a1 + hstepA, voffA);
            PG8_WAIT_L(8); PG8_BAR; PG8_WAIT_L(0); PG8_MMA(0, 0, At, B0); PG8_BAR; PG8_SCHED;
            PG8_LDB(B1, 0, 1); PG8_STAGEB(PG8_SB(0, 0), b2, voffB);
            PG8_BAR; PG8_WAIT_L(0); PG8_MMA(0, 1, At, B1); PG8_BAR;
            PG8_LDA(At, 0, 1); PG8_STAGE(PG8_SA(0, 0), a2, voffA);
            PG8_BAR; PG8_WAIT_L(0); PG8_MMA(1, 0, At, B0); PG8_BAR; PG8_SCHED;
            PG8_STAGEB(PG8_SB(0, 1), b2 + hstepB, voffB);
            PG8_WAIT_V(6); PG8_BAR; PG8_MMA(1, 1, At, B1); PG8_BAR;
            PG8_LDB(B0, 1, 0); PG8_SCHED; PG8_LDA(At, 1, 0); PG8_STAGE(PG8_SA(0, 1), a2 + hstepA, voffA);
            PG8_WAIT_L(8); PG8_BAR; PG8_WAIT_L(0); PG8_MMA(0, 0, At, B0); PG8_BAR; PG8_SCHED;
            PG8_LDB(B1, 1, 1); PG8_STAGEB(PG8_SB(1, 0), b3, voffB);
            PG8_BAR; PG8_WAIT_L(0); PG8_MMA(0, 1, At, B1); PG8_BAR;
            PG8_LDA(At, 1, 1); PG8_STAGE(PG8_SA(1, 0), a3, voffA);
            PG8_BAR; PG8_WAIT_L(0); PG8_MMA(1, 0, At, B0); PG8_BAR; PG8_SCHED;
            PG8_STAGEB(PG8_SB(1, 1), b3 + hstepB, voffB);
            PG8_WAIT_V(6); PG8_BAR; PG8_MMA(1, 1, At, B1); PG8_BAR;
            }
        }
        if constexpr (ALIGN_EPI) { if (wr == 0) PG8_BAR; }
        if constexpr (!Epi::AFTER_DRAIN) { E(acc, cur, wr, wc, fr, fq); S.done(cur); }
        if (!has_next) break;
#pragma unroll
        for (int a = 0; a < 2; ++a)
#pragma unroll
            for (int b = 0; b < 2; ++b)
#pragma unroll
                for (int m = 0; m < 4; ++m)
#pragma unroll
                    for (int n = 0; n < 2; ++n) acc[a][b][m][n] = (f32x4){0.f, 0.f, 0.f, 0.f};
        cur = nxt; cA = nA; cB = nB; ++ui;
        if constexpr (ALIGN_EPI) { if (wr == 1) PG8_BAR; }
    }
#ifdef PG8_STATIC_PRIO
    __builtin_amdgcn_s_setprio(0);
#endif
    PG8_WAIT_V(0);
    if constexpr (!ALIGN_EPI) { if (wr == 0) PG8_BAR; }
    PG8_BAR;
    if constexpr (Epi::AFTER_DRAIN) { E.fused(acc, cur, wr, wc, fr, fq, lds, wid, lane); S.done(cur); }
#undef PG8_SA
#undef PG8_SB
#undef PG8_STAGE
#undef PG8_STAGEB
#undef PG8_LDA
#undef PG8_LDB
#undef PG8_MMA
#undef PG8_WAIT_V
#undef PG8_WAIT_L
#undef PG8_BAR
#undef PG8_SCHED
}
}
#define GAS __attribute__((address_space(1)))
#define LAS __attribute__((address_space(3)))
typedef unsigned short bf16;
typedef unsigned v4u __attribute__((ext_vector_type(4)));
typedef float f32x4 __attribute__((ext_vector_type(4)));
typedef short bf16x8 __attribute__((ext_vector_type(8)));
typedef GAS unsigned gu32;
typedef GAS unsigned long long gu64;
#define RLX_AGENT __ATOMIC_RELAXED, __HIP_MEMORY_SCOPE_AGENT
#define LDS_WAIT() asm volatile("s_waitcnt lgkmcnt(0)" ::: "memory")
#define VM_WAIT() asm volatile("s_waitcnt vmcnt(0)" ::: "memory")
__device__ __forceinline__ unsigned long long rt() { return __builtin_amdgcn_s_memrealtime(); }
__device__ __forceinline__ unsigned f2bf(float f) { unsigned u = __builtin_bit_cast(unsigned, f); return (u + 0x7fffu + ((u >> 16) & 1u)) >> 16; }
__device__ __forceinline__ unsigned pk2(float lo, float hi) { return f2bf(lo) | (f2bf(hi) << 16); }

#define XB_TMO      128
#define XB_XCNT(j)  (256  + 64 * (j))
#define XB_XSUB(j)  (1280 + 64 * (j))
#define XB_XGEN(j)  (2304 + 64 * (j))
#define XB_TOP      3328
#define XB_TOPGEN   3392
#define XCD_BAR_WORDS 3456
#define XB_SPIN_CAP (1u << 18)

__device__ __forceinline__ unsigned xb_ld(unsigned* p)              { return __hip_atomic_load(p, __ATOMIC_RELAXED, __HIP_MEMORY_SCOPE_AGENT); }
__device__ __forceinline__ unsigned xb_add(unsigned* p, unsigned v) { return __hip_atomic_fetch_add(p, v, __ATOMIC_RELAXED, __HIP_MEMORY_SCOPE_AGENT); }
__device__ __forceinline__ unsigned xb_xcc_id() { return (unsigned)__builtin_amdgcn_s_getreg((3 << 11) | 20) & 0xFu; }
#define XB_SPIN(cond, bar) do { unsigned _sp = 0; while (cond) { __builtin_amdgcn_s_sleep(1); \
    if ((++_sp & 255u) == 0u) { if (xb_ld(&(bar)[XB_TMO])) break; if (_sp > XB_SPIN_CAP) { atomicAdd(&(bar)[XB_TMO], 1u); break; } } } } while (0)

struct XcdBarrier {
    unsigned* bar; unsigned x;
    volatile LAS unsigned* st;
};

__device__ __forceinline__ XcdBarrier xcd_barrier_post(unsigned* bar, volatile LAS unsigned* st) {
    XcdBarrier b; b.bar = bar; b.x = xb_xcc_id(); b.st = st;
    if (threadIdx.x == 0) (void)xb_add(&bar[XB_XCNT(b.x)], 1u);
    return b;
}
__device__ __forceinline__ void xcd_barrier_complete(unsigned* bar, unsigned x, unsigned& nloc, unsigned& nx) {
    const unsigned G = gridDim.x * gridDim.y * gridDim.z;
    unsigned sum, cnt, mine, sp = 0u;
    for (;;) {
        sum = 0u; cnt = 0u; mine = 0u;
#pragma unroll
        for (unsigned j = 0; j < 16; ++j) { const unsigned c = xb_ld(&bar[XB_XCNT(j)]); sum += c; cnt += (c > 0u) ? 1u : 0u; mine = (j == x) ? c : mine; }
        if (sum == G) break;
        __builtin_amdgcn_s_sleep(1);
        if ((++sp & 255u) == 0u) { if (xb_ld(&bar[XB_TMO])) break; if (sp > XB_SPIN_CAP) { atomicAdd(&bar[XB_TMO], 1u); break; } }
    }
    nloc = mine > 0u ? mine : 1u; nx = cnt > 0u ? cnt : 1u;
}

__device__ __forceinline__ void xcd_barrier(const XcdBarrier& b) {
    asm volatile("s_waitcnt vmcnt(0)" ::: "memory");
    __syncthreads();
    if (threadIdx.x == 0) {
        unsigned* bar = b.bar;
        __builtin_amdgcn_s_waitcnt(0);
        unsigned nloc = b.st[0], nx = b.st[1];
        if (nloc == 0u) { xcd_barrier_complete(bar, b.x, nloc, nx); b.st[0] = nloc; b.st[1] = nx; }
        const unsigned old = xb_add(&bar[XB_XSUB(b.x)], 1u);
        const unsigned gen = old / nloc;
        if (old + 1u == (gen + 1u) * nloc) {
            __builtin_amdgcn_fence(__ATOMIC_RELEASE, "agent");
            asm volatile("s_waitcnt vmcnt(0)" ::: "memory");
            const unsigned og = xb_add(&bar[XB_TOP], 1u);
            const unsigned tg = og / nx;
            if (og + 1u == (tg + 1u) * nx) xb_add(&bar[XB_TOPGEN], 1u);
            else XB_SPIN(xb_ld(&bar[XB_TOPGEN]) == tg, bar);
            __builtin_amdgcn_fence(__ATOMIC_ACQUIRE, "agent");
            xb_add(&bar[XB_XGEN(b.x)], 1u);
            asm volatile("s_waitcnt vmcnt(0)" ::: "memory");
        } else {
            XB_SPIN(xb_ld(&bar[XB_XGEN(b.x)]) == gen, bar);
            __builtin_amdgcn_fence(__ATOMIC_ACQUIRE, "agent");
            asm volatile("s_waitcnt vmcnt(0)" ::: "memory");
        }
    }
    __syncthreads();
}


constexpr int NWAVES = 8;
constexpr int DM = 4096, SEQ = 2048, CONVW = 2048, KVW = 512, DFF = 11008, INW = 17408;
constexpr int ROWS_P = pg8::ROWS_P, ROWS_R = pg8::ROWS_R, MPAD = pg8::ROWS_PAD;
constexpr float EPS = 1e-5f, LOG2E = 1.4426950408889634f;
using pg8::O_YP; using pg8::O_YS; using pg8::O_SK; using pg8::O_SV; using pg8::O_SC; using pg8::O_SF; using pg8::O_END;

constexpr size_t MiB = 1u << 20;
constexpr size_t WS_CTL = 0, CTL_ZERO_BYTES = 1 * MiB;
constexpr size_t WS_WGU = 1 * MiB;
constexpr size_t WS_WD  = WS_WGU + (size_t)2 * DFF * DM * 2;
constexpr size_t WS_XN  = WS_WD + (size_t)DM * DFF * 2;
constexpr size_t WS_X1  = WS_XN + (size_t)MPAD * DM * 2;
constexpr size_t WS_A   = WS_X1 + (size_t)MPAD * DM * 4;
constexpr size_t WS_WIN = WS_A;
constexpr size_t WS_WAB = WS_WIN + (size_t)INW * DM * 2;
constexpr size_t WS_WO  = WS_WAB + (size_t)DM * DM * 2;
constexpr size_t WS_CB  = WS_WO + (size_t)DM * DM * 2;
constexpr size_t WS_UU  = WS_CB + (size_t)MPAD * 2048 * 2;
constexpr size_t WS_Q   = WS_UU + (size_t)MPAD * 2048 * 2;
constexpr size_t WS_K   = WS_Q + (size_t)MPAD * 2048 * 2;
constexpr size_t WS_VT  = WS_K + (size_t)MPAD * 512 * 2;
constexpr size_t WS_RAT = WS_VT + (size_t)MPAD * 512 * 2;
constexpr size_t WS_SGB = WS_RAT + (size_t)MPAD * DM * 2;
constexpr size_t WS_AO  = WS_SGB + (size_t)MPAD * DM * 2;
constexpr size_t WS_MG  = WS_AO + (size_t)MPAD * DM * 2;
constexpr size_t WS_A_END = WS_MG + (size_t)MPAD * DM * 2;
constexpr size_t WS_G   = WS_A;
constexpr size_t WS_U   = WS_G + (size_t)MPAD * DFF * 2;
constexpr size_t WS_F   = WS_U + (size_t)MPAD * DFF * 2;
constexpr size_t WS_OV_END = WS_F + (size_t)MPAD * DFF * 2;
constexpr size_t WS_SIDEG = WS_A_END > WS_OV_END ? WS_A_END : WS_OV_END;
constexpr size_t WS_SIDEU = WS_SIDEG + (size_t)32 * 4 * DFF * 4;
constexpr size_t WS_PART1 = WS_SIDEU + (size_t)32 * 2 * DFF * 4;
constexpr size_t WS_PART2 = WS_PART1 + (size_t)ROWS_P * 256 * 4;
constexpr size_t WS_RSTAT = WS_PART2 + (size_t)ROWS_P * 256 * 4;
constexpr size_t WS_END = WS_RSTAT + (size_t)MPAD * 4;
constexpr size_t WS_SLAB4 = WS_WIN;
constexpr size_t WS_SLAB = WS_XN;
constexpr int CW_BAR = 4096;
static_assert((CW_BAR + XCD_BAR_WORDS) * 4 <= (int)CTL_ZERO_BYTES, "control words inside the memset region");

constexpr int RING_OFF = 0, RING_BYTES = 131072;
constexpr int LDSCTL_OFF = RING_BYTES, MISC_OFF = LDSCTL_OFF + 320;
constexpr int LDS_BYTES = 147456;
static_assert(MISC_OFF + 128 <= LDS_BYTES, "LDS map");
constexpr int XCH_OFF = LDSCTL_OFF + 1024;
static_assert(XCH_OFF + 8192 <= LDS_BYTES, "LDS map");
constexpr int BIAS_LD = 132;
constexpr int SCR_OFF = 20480, SCR_WAVE = 4096;

typedef float f32x16 __attribute__((ext_vector_type(16)));
typedef short s16x4 __attribute__((ext_vector_type(4)));
typedef unsigned v2u __attribute__((ext_vector_type(2)));
__device__ __forceinline__ float blo(unsigned w) { return __uint_as_float(w << 16); }
__device__ __forceinline__ float bhi(unsigned w) { return __uint_as_float(w & 0xffff0000u); }
__device__ __forceinline__ void unpack8(const v4u w, float (&f)[8]) { f[0] = blo(w.x); f[1] = bhi(w.x); f[2] = blo(w.y); f[3] = bhi(w.y); f[4] = blo(w.z); f[5] = bhi(w.z); f[6] = blo(w.w); f[7] = bhi(w.w); }
__device__ __forceinline__ v4u ldg16(const void* p) { return *(const GAS v4u*)p; }
__device__ __forceinline__ f32x4 ldg4f(const float* p) { return *(const GAS f32x4*)p; }
__device__ __forceinline__ void ld8f(const float* p, float (&f)[8]) { const f32x4 a = ldg4f(p), b = ldg4f(p + 4); f[0] = a[0]; f[1] = a[1]; f[2] = a[2]; f[3] = a[3]; f[4] = b[0]; f[5] = b[1]; f[6] = b[2]; f[7] = b[3]; }
__device__ __forceinline__ void st8f(float* p, const float (&f)[8]) { *(GAS f32x4*)p = (f32x4){f[0], f[1], f[2], f[3]}; *(GAS f32x4*)(p + 4) = (f32x4){f[4], f[5], f[6], f[7]}; }
__device__ __forceinline__ unsigned cvtpk(float lo, float hi) { return pg8::cvt_pk_bf16(lo, hi); }
__device__ __forceinline__ float ex2(float x) { return __builtin_amdgcn_exp2f(x); }
__device__ __forceinline__ float wave_sum(float v) {
#pragma unroll
    for (int o = 1; o < 64; o <<= 1) v += __shfl_xor(v, o);
    return v;
}
__device__ __forceinline__ float wave_max(float v) {
#pragma unroll
    for (int o = 1; o < 64; o <<= 1) v = fmaxf(v, __shfl_xor(v, o));
    return v;
}

struct P0Ref { const float* src; bf16* dst; int N; };
__device__ __forceinline__ void p0_load(const P0Ref& r, f32x4 (&v)[8], int lane) {
#pragma unroll
#ifdef P0_PLAIN_LOADS
    for (int i = 0; i < 8; ++i) v[i] = *(const GAS f32x4*)(r.src + (size_t)(8 * i + (lane >> 3)) * r.N + 4 * (lane & 7));
#else
    for (int i = 0; i < 8; ++i) v[i] = __builtin_nontemporal_load((const GAS f32x4*)(r.src + (size_t)(8 * i + (lane >> 3)) * r.N + 4 * (lane & 7)));
#endif
}
__device__ __forceinline__ void p0_store(const P0Ref& r, const f32x4 (&v)[8], LAS float* scr, int lane) {
#pragma unroll
    for (int i = 0; i < 8; ++i) { LAS float* w = scr + (8 * i + (lane >> 3)) * 33 + 4 * (lane & 7); w[0] = v[i][0]; w[1] = v[i][1]; w[2] = v[i][2]; w[3] = v[i][3]; }
    LDS_WAIT(); asm volatile("" ::: "memory");
    const int c = lane & 7;
#pragma unroll
    for (int j = 0; j < 4; ++j) { const int n = (lane >> 3) + 8 * j; const LAS float* q = scr + (8 * c) * 33 + n;
        v4u o; o.x = cvtpk(q[0 * 33], q[1 * 33]); o.y = cvtpk(q[2 * 33], q[3 * 33]); o.z = cvtpk(q[4 * 33], q[5 * 33]); o.w = cvtpk(q[6 * 33], q[7 * 33]);
        *(GAS v4u*)(r.dst + (size_t)n * 64 + 8 * c) = o; }
    LDS_WAIT(); asm volatile("" ::: "memory");
}
__host__ __device__ __forceinline__ int win_map(int n) {
    if (n < 2048) return n;
    if (n < 6144) { int t = n - 2048; const int h = t >= 2048 ? 1 : 0; t -= h * 2048; return 2048 + (t >> 7) * 256 + h * 128 + (t & 127); }
    if (n < 9216) return n;
    int t = n - 9216; const int h = t >= 4096 ? 1 : 0; t -= h * 4096; return 9216 + (t >> 7) * 256 + h * 128 + (t & 127);
}
__host__ __device__ __forceinline__ size_t tiled_off(int n, int kt, int nt) { return ((size_t)(n >> 8) * nt + kt) * 16384 + (size_t)(n & 255) * 64; }
__device__ __forceinline__ void load_gain(const float* g, f32x4 (&gv)[16], int lane) {
    const GAS f32x4* gr = (const GAS f32x4*)g + lane;
#pragma unroll
    for (int j = 0; j < 16; ++j) gv[j] = gr[64 * j];
}
template <bool OUT_BF16, bool TILED = false> __device__ __forceinline__ void rms_row(const float* xrow, const f32x4 (&gv)[16], void* orow, int lane) {
    const GAS f32x4* xr = (const GAS f32x4*)xrow + lane;
    f32x4 v[16]; float s = 0.f;
#pragma unroll
    for (int j = 0; j < 16; ++j) { v[j] = xr[64 * j]; s += (v[j].x * v[j].x + v[j].y * v[j].y) + (v[j].z * v[j].z + v[j].w * v[j].w); }
    const float r = 1.0f / sqrtf(wave_sum(s) * (1.0f / DM) + EPS);
#pragma unroll
    for (int j = 0; j < 16; ++j) { const f32x4 y = (v[j] * r) * gv[j];
        if (OUT_BF16) { v2u w; w.x = cvtpk(y.x, y.y); w.y = cvtpk(y.z, y.w);
            if (TILED) { const int c = 4 * (lane + 64 * j); *(GAS v2u*)((bf16*)orow + (size_t)(c >> 6) * 16384 + (c & 63)) = w; } else ((GAS v2u*)orow)[lane + 64 * j] = w; }
        else ((GAS f32x4*)orow)[lane + 64 * j] = y; }
}

__device__ __forceinline__ void load_row(const float* xrow, f32x4 (&v)[16], int lane) {
    const GAS f32x4* xr = (const GAS f32x4*)xrow + lane;
#pragma unroll
    for (int j = 0; j < 16; ++j) v[j] = __builtin_nontemporal_load(xr + 64 * j);
}
__device__ __forceinline__ void rms_row_pre_tiled(const f32x4 (&v)[16], const f32x4 (&gv)[16], bf16* orow, int lane) {
    float s = 0.f;
#pragma unroll
    for (int j = 0; j < 16; ++j) s += (v[j].x * v[j].x + v[j].y * v[j].y) + (v[j].z * v[j].z + v[j].w * v[j].w);
    const float r = 1.0f / sqrtf(wave_sum(s) * (1.0f / DM) + EPS);
#pragma unroll
    for (int j = 0; j < 16; ++j) { const f32x4 y = (v[j] * r) * gv[j]; v2u w; w.x = cvtpk(y.x, y.y); w.y = cvtpk(y.z, y.w); const int c = 4 * (lane + 64 * j);
        *(GAS v2u*)(orow + (size_t)(c >> 6) * 16384 + (c & 63)) = w; }
}
__device__ __forceinline__ void rms_raw_row(const float* xrow, const f32x4 (&gv)[16], bf16* orow, float* rstat, int lane) {
    const GAS f32x4* xr = (const GAS f32x4*)xrow + lane;
    f32x4 v[16]; float s = 0.f;
#pragma unroll
    for (int j = 0; j < 16; ++j) { v[j] = xr[64 * j]; s += (v[j].x * v[j].x + v[j].y * v[j].y) + (v[j].z * v[j].z + v[j].w * v[j].w); }
    const float r = 1.0f / sqrtf(wave_sum(s) * (1.0f / DM) + EPS);
    if (lane == 0) *(GAS float*)rstat = r;
#pragma unroll
    for (int j = 0; j < 16; ++j) { const f32x4 y = v[j] * gv[j]; v2u w; w.x = cvtpk(y.x, y.y); w.y = cvtpk(y.z, y.w); const int c = 4 * (lane + 64 * j);
        *(GAS v2u*)(orow + (size_t)(c >> 6) * 16384 + (c & 63)) = w; }
}
__device__ __forceinline__ float row16_sum(float v) {
    v += __builtin_bit_cast(float, __builtin_amdgcn_update_dpp(0, __builtin_bit_cast(int, v), 0xB1, 0xF, 0xF, false));
    v += __builtin_bit_cast(float, __builtin_amdgcn_update_dpp(0, __builtin_bit_cast(int, v), 0x4E, 0xF, 0xF, false));
    v += __builtin_bit_cast(float, __builtin_amdgcn_update_dpp(0, __builtin_bit_cast(int, v), 0x141, 0xF, 0xF, false));
    v += __builtin_bit_cast(float, __builtin_amdgcn_update_dpp(0, __builtin_bit_cast(int, v), 0x140, 0xF, 0xF, false));
    return v;
}
__device__ __forceinline__ int crow(int r, int hi) { return (r & 3) + 8 * (r >> 2) + 4 * hi; }
__device__ __forceinline__ void attn_prompt_task(int t, const bf16* Q, const bf16* KB, const bf16* VT, bf16* AO, const float* sinks, const LAS float* biasT, int lane) {
    const int g = t & 3, i32 = (t >> 2) & 63, kvh = (t >> 8) & 7, b = t >> 11, head = kvh * 4 + g;
    const int r32 = lane & 31, hi = lane >> 5;
    const int rowbase = b * SEQ, t0 = i32 * 32;
    const int kb_lo = (t0 >= 128) ? 0 : ((128 - t0) >> 5);
    bf16x8 qf[4];
    { const bf16* qp = Q + (size_t)(rowbase + t0 + r32) * 2048 + head * 64 + hi * 8;
#pragma unroll
      for (int ks = 0; ks < 4; ++ks) qf[ks] = *(const GAS bf16x8*)(qp + ks * 16); }
    f32x16 s[5];
    bf16x8 kf[5][4];
#pragma unroll
    for (int kb = 0; kb < 5; ++kb) if (kb >= kb_lo) {
        const bf16* kp = KB + (size_t)(rowbase + t0 - 128 + 32 * kb + r32) * KVW + kvh * 64 + hi * 8;
#pragma unroll
        for (int ks = 0; ks < 4; ++ks) kf[kb][ks] = *(const GAS bf16x8*)(kp + ks * 16);
    }
#pragma unroll
    for (int kb = 0; kb < 5; ++kb) {
#pragma unroll
        for (int r = 0; r < 16; ++r) s[kb][r] = 0.f;
        if (kb >= kb_lo) {
#pragma unroll
            for (int ks = 0; ks < 4; ++ks) s[kb] = __builtin_amdgcn_mfma_f32_32x32x16_bf16(kf[kb][ks], qf[ks], s[kb], 0, 0, 0);
        }
    }
    __builtin_amdgcn_sched_barrier(0);
    v2u vl[5][2][2], vh[5][2][2];
#pragma unroll
    for (int kb = 0; kb < 5; ++kb) if (kb >= kb_lo) {
#pragma unroll
        for (int sx = 0; sx < 2; ++sx) { const int tk = rowbase + t0 - 128 + 32 * kb + 16 * sx;
#pragma unroll
            for (int db = 0; db < 2; ++db) { const bf16* vp = VT + (size_t)(kvh * 64 + db * 32 + r32) * MPAD + tk + 4 * hi;
                vl[kb][sx][db] = *(const GAS v2u*)vp; vh[kb][sx][db] = *(const GAS v2u*)(vp + 8); } }
    }
    const LAS float* bt = biasT + head * BIAS_LD;
    const float sink = *(const GAS float*)(sinks + head);
    float mx = sink;
#pragma unroll
    for (int kb = 0; kb < 5; ++kb)
#pragma unroll
        for (int r = 0; r < 16; ++r) {
            const int dist = r32 + 128 - 32 * kb - crow(r, hi);
            const bool valid = (kb >= kb_lo) && dist >= 0 && dist <= 128;
            const int dc = dist < 0 ? 0 : (dist > 128 ? 128 : dist);
            float v = s[kb][r] * 0.125f + bt[dc];
            v = valid ? v : -INFINITY;
            s[kb][r] = v; mx = fmaxf(mx, v);
        }
    mx = fmaxf(mx, __shfl_xor(mx, 32));
    float sum = 0.f;
#pragma unroll
    for (int kb = 0; kb < 5; ++kb)
#pragma unroll
        for (int r = 0; r < 16; ++r) { const float e = ex2((s[kb][r] - mx) * LOG2E); s[kb][r] = e; sum += e; }
    sum += __shfl_xor(sum, 32);
    const float inv = 1.0f / (sum + ex2((sink - mx) * LOG2E));
    f32x16 o[2];
#pragma unroll
    for (int r = 0; r < 16; ++r) { o[0][r] = 0.f; o[1][r] = 0.f; }
#pragma unroll
    for (int kb = 0; kb < 5; ++kb) if (kb >= kb_lo) {
#pragma unroll
        for (int sx = 0; sx < 2; ++sx) {
            v4u pw; pw.x = cvtpk(s[kb][8 * sx + 0], s[kb][8 * sx + 1]); pw.y = cvtpk(s[kb][8 * sx + 2], s[kb][8 * sx + 3]); pw.z = cvtpk(s[kb][8 * sx + 4], s[kb][8 * sx + 5]); pw.w = cvtpk(s[kb][8 * sx + 6], s[kb][8 * sx + 7]);
            const bf16x8 pb = __builtin_bit_cast(bf16x8, pw);
#pragma unroll
            for (int db = 0; db < 2; ++db) {
                v4u vw; vw.x = vl[kb][sx][db].x; vw.y = vl[kb][sx][db].y; vw.z = vh[kb][sx][db].x; vw.w = vh[kb][sx][db].y;
                o[db] = __builtin_amdgcn_mfma_f32_32x32x16_bf16(__builtin_bit_cast(bf16x8, vw), pb, o[db], 0, 0, 0);
            }
        }
    }
    bf16* op = AO + (size_t)(rowbase + t0 + r32) * 4096 + 2048 + head * 64 + 4 * hi;
#pragma unroll
    for (int db = 0; db < 2; ++db)
#pragma unroll
        for (int rg = 0; rg < 4; ++rg) { v2u w; w.x = cvtpk(o[db][4 * rg] * inv, o[db][4 * rg + 1] * inv); w.y = cvtpk(o[db][4 * rg + 2] * inv, o[db][4 * rg + 3] * inv);
            *(GAS v2u*)(op + db * 32 + 8 * rg) = w; }
}
template <bool copy_win> __device__ __forceinline__ void attn_sample_task(int t, const bf16* Q, const float* sk, const float* sv, float* out, bf16* AO, const float* sinks, const LAS float* biasT, LAS float* sc, int lane) {
    const int kvh = t & 7, b = t >> 3;
    const int kq = lane >> 4, d4 = lane & 15;
    float qv[4][4];
#pragma unroll
    for (int g = 0; g < 4; ++g) { const v2u w = *(const GAS v2u*)(Q + (size_t)(ROWS_P + b) * 2048 + (kvh * 4 + g) * 64 + 4 * d4);
        qv[g][0] = blo(w.x) * 0.125f; qv[g][1] = bhi(w.x) * 0.125f; qv[g][2] = blo(w.y) * 0.125f; qv[g][3] = bhi(w.y) * 0.125f; }
    const size_t woff = (size_t)b * 128 * 512 + kvh * 64 + 4 * d4;
#pragma unroll 1
    for (int i0 = 0; i0 < 33; i0 += 17) {
        f32x4 kv[17];
#pragma unroll
        for (int u = 0; u < 17; ++u) { const int j = 4 * (i0 + u) + kq; kv[u] = (f32x4){0.f, 0.f, 0.f, 0.f};
            if (j < 128) kv[u] = __builtin_nontemporal_load((const GAS f32x4*)(sk + woff + (size_t)j * 512)); else if (j == 128) kv[u] = ldg4f(out + O_SK + woff + (size_t)127 * 512); }
#pragma unroll
        for (int u = 0; u < 17; ++u) { const int j = 4 * (i0 + u) + kq;
            if (copy_win && j >= 1 && j < 128) __builtin_nontemporal_store(kv[u], (GAS f32x4*)(out + O_SK + woff + (size_t)(j - 1) * 512));
#pragma unroll
            for (int g = 0; g < 4; ++g) { float p = (qv[g][0] * kv[u][0] + qv[g][1] * kv[u][1]) + (qv[g][2] * kv[u][2] + qv[g][3] * kv[u][3]);
                p = row16_sum(p);
                if (d4 == 0 && j <= 128) sc[g * BIAS_LD + j] = p + biasT[(kvh * 4 + g) * BIAS_LD + (128 - j)]; } }
    }
    asm volatile("s_waitcnt lgkmcnt(0)" ::: "memory");
    float inv[4];
#pragma unroll
    for (int g = 0; g < 4; ++g) {
        const float sink = *(const GAS float*)(sinks + kvh * 4 + g);
        const float v0 = sc[g * BIAS_LD + lane], v1 = sc[g * BIAS_LD + 64 + lane], v2 = (lane == 0) ? sc[g * BIAS_LD + 128] : -INFINITY;
        const float m = fmaxf(wave_max(fmaxf(fmaxf(v0, v1), v2)), sink);
        const float e0 = ex2((v0 - m) * LOG2E), e1 = ex2((v1 - m) * LOG2E), e2 = (lane == 0) ? ex2((v2 - m) * LOG2E) : 0.f;
        inv[g] = 1.0f / (wave_sum(e0 + e1 + e2) + ex2((sink - m) * LOG2E));
        sc[g * BIAS_LD + lane] = e0; sc[g * BIAS_LD + 64 + lane] = e1; if (lane == 0) sc[g * BIAS_LD + 128] = e2;
    }
    asm volatile("s_waitcnt lgkmcnt(0)" ::: "memory");
    float acc[4][4];
#pragma unroll
    for (int g = 0; g < 4; ++g)
#pragma unroll
        for (int e = 0; e < 4; ++e) acc[g][e] = 0.f;
#pragma unroll 1
    for (int i0 = 0; i0 < 33; i0 += 17) {
        f32x4 vv[17];
#pragma unroll
        for (int u = 0; u < 17; ++u) { const int j = 4 * (i0 + u) + kq; vv[u] = (f32x4){0.f, 0.f, 0.f, 0.f};
            if (j < 128) vv[u] = __builtin_nontemporal_load((const GAS f32x4*)(sv + woff + (size_t)j * 512)); else if (j == 128) vv[u] = ldg4f(out + O_SV + woff + (size_t)127 * 512); }
#pragma unroll
        for (int u = 0; u < 17; ++u) { const int j = 4 * (i0 + u) + kq;
            if (copy_win && j >= 1 && j < 128) __builtin_nontemporal_store(vv[u], (GAS f32x4*)(out + O_SV + woff + (size_t)(j - 1) * 512));
            if (j <= 128) {
#pragma unroll
                for (int g = 0; g < 4; ++g) { const float p = sc[g * BIAS_LD + j];
#pragma unroll
                    for (int e = 0; e < 4; ++e) acc[g][e] += p * vv[u][e]; }
            } }
    }
#pragma unroll
    for (int g = 0; g < 4; ++g)
#pragma unroll
        for (int e = 0; e < 4; ++e) { acc[g][e] += __shfl_xor(acc[g][e], 16); acc[g][e] += __shfl_xor(acc[g][e], 32); }
    if (kq == 0) {
#pragma unroll
        for (int g = 0; g < 4; ++g) { v2u w; w.x = cvtpk(acc[g][0] * inv[g], acc[g][1] * inv[g]); w.y = cvtpk(acc[g][2] * inv[g], acc[g][3] * inv[g]);
            *(GAS v2u*)(AO + (size_t)(ROWS_P + b) * 4096 + 2048 + (kvh * 4 + g) * 64 + 4 * d4) = w; }
    }
    asm volatile("s_waitcnt lgkmcnt(0)" ::: "memory");
}
__device__ __forceinline__ void conv_row(int row, const bf16* CB, const bf16* UU, bf16* AO, const float* cw, const float* st, float* out, int lane) {
    const bool samp = row >= ROWS_P; const int tl = row & (SEQ - 1);
    v4u a0[4], ac[4], a1[4], a2[4]; f32x4 s1[4][2], s2[4][2];
#pragma unroll
    for (int j = 0; j < 4; ++j) { const int c = 8 * lane + 512 * j;
        a0[j] = ldg16(UU + (size_t)row * 2048 + c); ac[j] = ldg16(CB + (size_t)row * 2048 + c); a1[j] = (v4u){0u, 0u, 0u, 0u}; a2[j] = (v4u){0u, 0u, 0u, 0u};
        if (!samp) { if (tl >= 1) a1[j] = ldg16(UU + (size_t)(row - 1) * 2048 + c); if (tl >= 2) a2[j] = ldg16(UU + (size_t)(row - 2) * 2048 + c); }
        else { const int b = row - ROWS_P; const float* p2 = st + ((size_t)b * 2 + 0) * 2048 + c; const float* p1 = st + ((size_t)b * 2 + 1) * 2048 + c;
            s2[j][0] = ldg4f(p2); s2[j][1] = ldg4f(p2 + 4); s1[j][0] = ldg4f(p1); s1[j][1] = ldg4f(p1 + 4); } }
#pragma unroll
    for (int j = 0; j < 4; ++j) { const int c = 8 * lane + 512 * j;
        float u0[8], u1[8], u2[8], cbv[8], w0[8], w1[8], w2[8];
        unpack8(a0[j], u0); unpack8(ac[j], cbv);
        if (!samp) { unpack8(a1[j], u1); unpack8(a2[j], u2); }
        else { const int b = row - ROWS_P;
#pragma unroll
            for (int e = 0; e < 4; ++e) { u1[e] = s1[j][0][e]; u1[4 + e] = s1[j][1][e]; u2[e] = s2[j][0][e]; u2[4 + e] = s2[j][1][e]; }
            st8f(out + O_SC + ((size_t)b * 2 + 0) * 2048 + c, u1); }
        ld8f(cw + c, w0); ld8f(cw + 2048 + c, w1); ld8f(cw + 4096 + c, w2);
        float a[8];
#pragma unroll
        for (int e = 0; e < 8; ++e) a[e] = cbv[e] * ((w0[e] * u2[e] + w1[e] * u1[e]) + w2[e] * u0[e]);
        v4u w; w.x = cvtpk(a[0], a[1]); w.y = cvtpk(a[2], a[3]); w.z = cvtpk(a[4], a[5]); w.w = cvtpk(a[6], a[7]);
        *(GAS v4u*)(AO + (size_t)row * 4096 + c) = w; }
}
__device__ __forceinline__ void conv_run8(int r0, const bf16* CB, const bf16* UU, bf16* AO, const float* cw, int lane) {
    const bool head = (r0 & (SEQ - 1)) == 0;
#pragma unroll 1
    for (int j = 0; j < 4; ++j) { const int c = 8 * lane + 512 * j;
        v4u u[10], cb[8];
        u[0] = (v4u){0u, 0u, 0u, 0u}; u[1] = (v4u){0u, 0u, 0u, 0u};
        if (!head) { u[0] = ldg16(UU + (size_t)(r0 - 2) * 2048 + c); u[1] = ldg16(UU + (size_t)(r0 - 1) * 2048 + c); }
#pragma unroll
        for (int i = 0; i < 8; ++i) { u[2 + i] = ldg16(UU + (size_t)(r0 + i) * 2048 + c); cb[i] = ldg16(CB + (size_t)(r0 + i) * 2048 + c); }
        float w0[8], w1[8], w2[8], p2[8], p1[8];
        ld8f(cw + c, w0); ld8f(cw + 2048 + c, w1); ld8f(cw + 4096 + c, w2);
        unpack8(u[0], p2); unpack8(u[1], p1);
#pragma unroll
        for (int i = 0; i < 8; ++i) { float u0[8], cbv[8], a[8];
            unpack8(u[2 + i], u0); unpack8(cb[i], cbv);
#pragma unroll
            for (int e = 0; e < 8; ++e) a[e] = cbv[e] * ((w0[e] * p2[e] + w1[e] * p1[e]) + w2[e] * u0[e]);
            v4u w; w.x = cvtpk(a[0], a[1]); w.y = cvtpk(a[2], a[3]); w.z = cvtpk(a[4], a[5]); w.w = cvtpk(a[6], a[7]);
            *(GAS v4u*)(AO + (size_t)(r0 + i) * 4096 + c) = w;
#pragma unroll
            for (int e = 0; e < 8; ++e) { p2[e] = p1[e]; p1[e] = u0[e]; } }
    }
}
__device__ __forceinline__ float silu_mul(float gc, float u) { return gc * __builtin_amdgcn_rcpf(1.0f + ex2(-gc * LOG2E)) * u; }
__device__ __forceinline__ void ffn_act_block(int task, const bf16* G, const bf16* U, bf16* F, const float* cw, const float* cbias, const float* st, float* out, int lane) {
    const int ch = task % 22, rb = task / 22, c = ch * 512 + lane * 8;
    if (c >= DFF) return;
    float w0[8], w1[8], w2[8], bb[8];
    ld8f(cw + c, w0); ld8f(cw + DFF + c, w1); ld8f(cw + 2 * DFF + c, w2); ld8f(cbias + c, bb);
    const int row0 = rb * 32;
    if (rb < ROWS_P / 32) {
        float g1[8], g2[8];
        if ((row0 & (SEQ - 1)) != 0) { unpack8(ldg16(G + (size_t)(row0 - 1) * DFF + c), g1); unpack8(ldg16(G + (size_t)(row0 - 2) * DFF + c), g2); }
        else {
#pragma unroll
            for (int e = 0; e < 8; ++e) { g1[e] = 0.f; g2[e] = 0.f; } }
        for (int r0 = 0; r0 < 32; r0 += 8) {
            v4u gw_[8], uw_[8];
#pragma unroll
            for (int r = 0; r < 8; ++r) { gw_[r] = ldg16(G + (size_t)(row0 + r0 + r) * DFF + c); uw_[r] = ldg16(U + (size_t)(row0 + r0 + r) * DFF + c); }
#pragma unroll
            for (int r = 0; r < 8; ++r) { float g0[8], uv[8], f[8]; unpack8(gw_[r], g0); unpack8(uw_[r], uv);
#pragma unroll
                for (int e = 0; e < 8; ++e) { f[e] = silu_mul(((w0[e] * g2[e] + w1[e] * g1[e]) + w2[e] * g0[e]) + bb[e], uv[e]); g2[e] = g1[e]; g1[e] = g0[e]; }
                v4u w; w.x = cvtpk(f[0], f[1]); w.y = cvtpk(f[2], f[3]); w.z = cvtpk(f[4], f[5]); w.w = cvtpk(f[6], f[7]);
                *(GAS v4u*)(F + (size_t)(row0 + r0 + r) * DFF + c) = w; }
        }
    } else {
        for (int r0 = 0; r0 < 32; r0 += 4) {
            v4u gw_[4], uw_[4]; float s0[4][8], s1[4][8];
#pragma unroll
            for (int r = 0; r < 4; ++r) { const int row = row0 + r0 + r, b = row - ROWS_P; gw_[r] = ldg16(G + (size_t)row * DFF + c); uw_[r] = ldg16(U + (size_t)row * DFF + c);
                ld8f(st + ((size_t)b * 2 + 0) * DFF + c, s0[r]); ld8f(st + ((size_t)b * 2 + 1) * DFF + c, s1[r]); }
#pragma unroll
            for (int r = 0; r < 4; ++r) { const int row = row0 + r0 + r, b = row - ROWS_P; float g0[8], uv[8], f[8]; unpack8(gw_[r], g0); unpack8(uw_[r], uv);
                st8f(out + O_SF + ((size_t)b * 2 + 0) * DFF + c, s1[r]);
#pragma unroll
                for (int e = 0; e < 8; ++e) f[e] = silu_mul(((w0[e] * s0[r][e] + w1[e] * s1[r][e]) + w2[e] * g0[e]) + bb[e], uv[e]);
                v4u w; w.x = cvtpk(f[0], f[1]); w.y = cvtpk(f[2], f[3]); w.z = cvtpk(f[4], f[5]); w.w = cvtpk(f[6], f[7]);
                *(GAS v4u*)(F + (size_t)row * DFF + c) = w; }
        }
    }
}

template <int NB, int NR, bool PIPE>
__device__ __forceinline__ void skinny_ksplit(f32x4 (&acc)[NB * NR], const bf16* A  , int lda, int ags  ,
                                              const bf16* const (&brow)[NB]  , int bgs  , int gfirst, int gstride, int gcount, int rot, int fr, int fq) {
    const bf16* a0 = A + (size_t)fr * lda + 16 * fq;
    auto ld = [&](int i, bf16x8 (&a)[NR][2], bf16x8 (&b)[NB][2]) {
        int ii = i + rot; if (ii >= gcount) ii -= gcount;
        const int gi = gfirst + gstride * ii; const size_t ka_ = (size_t)gi * ags, kb_ = (size_t)gi * bgs;
#pragma unroll
        for (int j = 0; j < NB; ++j) { b[j][0] = *(const GAS bf16x8*)(brow[j] + 16 * fq + kb_); b[j][1] = *(const GAS bf16x8*)(brow[j] + 16 * fq + kb_ + 8); }
#pragma unroll
        for (int rg = 0; rg < NR; ++rg) { a[rg][0] = *(const GAS bf16x8*)(a0 + (size_t)(16 * rg) * lda + ka_); a[rg][1] = *(const GAS bf16x8*)(a0 + (size_t)(16 * rg) * lda + ka_ + 8); }
    };
    auto mm = [&](const bf16x8 (&a)[NR][2], const bf16x8 (&b)[NB][2]) {
#pragma unroll
        for (int u = 0; u < 2; ++u)
#pragma unroll
            for (int j = 0; j < NB; ++j)
#pragma unroll
                for (int rg = 0; rg < NR; ++rg) acc[j * NR + rg] = __builtin_amdgcn_mfma_f32_16x16x32_bf16(b[j][u], a[rg][u], acc[j * NR + rg], 0, 0, 0);
    };
    if constexpr (PIPE) {
        bf16x8 a0s[NR][2], b0s[NB][2], a1s[NR][2], b1s[NB][2];
        if (gcount > 0) ld(0, a0s, b0s);
#pragma unroll 1
        for (int i = 0; i < gcount; i += 2) {
            if (i + 1 < gcount) ld(i + 1, a1s, b1s);
            mm(a0s, b0s);
            if (i + 1 < gcount) { if (i + 2 < gcount) ld(i + 2, a0s, b0s); mm(a1s, b1s); }
        }
    } else {
#pragma unroll 1
        for (int i = 0; i < gcount; ++i) { bf16x8 a[NR][2], b[NB][2]; ld(i, a, b); mm(a, b); }
    }
}
__device__ __forceinline__ void skinny_reduce(const f32x4 (&acc)[8], LAS f32x4* red, int wave, int lane, f32x4& lo, f32x4& hi) {
#pragma unroll
    for (int rg = 0; rg < 8; ++rg) red[(wave * 8 + rg) * 64 + lane] = acc[rg];
    __syncthreads();
    lo = (red[(0 * 8 + wave) * 64 + lane] + red[(1 * 8 + wave) * 64 + lane]) + (red[(2 * 8 + wave) * 64 + lane] + red[(3 * 8 + wave) * 64 + lane]);
    hi = (red[(4 * 8 + wave) * 64 + lane] + red[(5 * 8 + wave) * 64 + lane]) + (red[(6 * 8 + wave) * 64 + lane] + red[(7 * 8 + wave) * 64 + lane]);
    __syncthreads();
}
__device__ __forceinline__ f32x4 unpack4(const v2u w) { return (f32x4){blo(w.x), bhi(w.x), blo(w.y), bhi(w.y)}; }
__device__ __forceinline__ v2u pack4(const f32x4 v) { v2u w; w.x = cvtpk(v[0], v[1]); w.y = cvtpk(v[2], v[3]); return w; }

constexpr bool P1_HOLE_COPY = false;
#ifndef P6_BNT
#define P6_BNT false
#endif
constexpr int P6_SAMPLE_TILES = 64;
struct OrderXcd {
    int nN, E, G, c, x, r, Rm, nfull; bool xm;
    __device__ void init(int nN_, int E_, int G_, int c_) { nN = nN_; E = E_; G = G_; c = c_; x = c_ & 7; r = c_ >> 3; Rm = (nN_ + 7) >> 3; nfull = nN_ - 8 * (Rm - 1); xm = (G_ == 256); }
    __device__ bool next(int i, pg8::Unit& u) const {
        if (!xm) { const long Lx = (long)i * G + c; if (Lx < 32L * nN) { u.pm = (int)(Lx / nN); u.pn = (int)(Lx % nN); return true; } if (Lx - 32L * nN < E) { u.pm = 32; u.pn = (int)(Lx - 32L * nN); return true; } return false; }
        if (i >= Rm) return false;
        const int pn = 8 * i + (r >> 2);
        if (pn < nN) { u.pm = 4 * x + (r & 3); u.pn = pn; return true; }
        const int sidx = x + 8 * ((r & 3) + 4 * ((r >> 2) - nfull));
        if (sidx < E) { u.pm = 32; u.pn = sidx; return true; }
        return false; }
    __device__ __forceinline__ void a_ready(const pg8::Unit&) const {}
    __device__ __forceinline__ void done(const pg8::Unit&) const {}
};
struct OrderSame { int n; __device__ bool next(int i, pg8::Unit& u) const { if (i >= n) return false; u.pm = 0; u.pn = 0; return true; }
    __device__ __forceinline__ void a_ready(const pg8::Unit&) const {} __device__ __forceinline__ void done(const pg8::Unit&) const {} };
struct OrderSlices { int np, G, c;
    __device__ bool next(int i, pg8::Unit& u) const {
        const long id = (long)i * G + c; if (id >= 256) return false;
        const int sl = (int)id & 15, p0 = (np * sl) >> 4, p1 = (np * (sl + 1)) >> 4;
        u.pm = 32; u.pn = (int)id >> 4; u.kn = 2 * p0 + ((2 * (p1 - p0)) << 16); return true; }
    __device__ __forceinline__ void a_ready(const pg8::Unit&) const {}
    __device__ __forceinline__ void done(const pg8::Unit&) const {}
};
#ifndef PH_MASK
#define PH_MASK 0x3ff
#endif
#define PH(k) ((PH_MASK >> (k)) & 1)
#ifndef REP_MASK
#define REP_MASK 0
#endif
#define REPN(k) (((REP_MASK >> (k)) & 1) ? 2 : 1)
struct Args { const float* in[21]; float* out; unsigned char* ws; };
__global__ void __launch_bounds__(NWAVES * 64, 2) mega_fwd(Args args) {
    extern __shared__ __attribute__((aligned(16))) unsigned char lds[];
    LAS unsigned char* L = (LAS unsigned char*)lds;
    volatile LAS unsigned* MISC = (volatile LAS unsigned*)(L + MISC_OFF);
    const int tid = threadIdx.x;
#define PHASE_IDS() int tid_p_ = threadIdx.x; asm volatile("" : "+v"(tid_p_)); const int lane = tid_p_ & 63, wave = __builtin_amdgcn_readfirstlane(tid_p_ >> 6), gw = vcu * NWAVES + wave; (void)lane; (void)gw
    const int G = gridDim.x, bx = blockIdx.x;
    const int vcu = (G % 8 == 0) ? (bx % 8) * (G / 8) + bx / 8 : bx;
    const int NGW = G * NWAVES;
    unsigned char* ws = args.ws; float* out = args.out;
#define INP(k) (args.in[k])
#define WSB(off) ((bf16*)(ws + (off)))
    gu32* ctl = (gu32*)(ws + WS_CTL);
    for (int u = tid; u < (LDS_BYTES - LDSCTL_OFF) / 4; u += NWAVES * 64) ((LAS unsigned*)(L + LDSCTL_OFF))[u] = 0u;
    __syncthreads();
    XcdBarrier bar = xcd_barrier_post((unsigned*)(ctl + CW_BAR), MISC + 8);
#ifdef PROBE_PHASES
    unsigned long long pt0_ = 0, probe_acc_ = 0;
#ifdef PROBE_P2SUB
#define PTS(k) do { if (PROBE_P2SUB == (k)) pt0_ = __builtin_amdgcn_s_memrealtime(); } while (0)
#define PTE(k) do { if (PROBE_P2SUB == (k)) probe_acc_ += __builtin_amdgcn_s_memrealtime() - pt0_; } while (0)
#else
#define PTS(k)
#define PTE(k)
#endif
#define PT_BEGIN(k) do { if ((PROBE_PHASES >> (k)) & 1) pt0_ = __builtin_amdgcn_s_memrealtime(); } while (0)
#define PT_END(k) do { if ((PROBE_PHASES >> (k)) & 1) probe_acc_ += __builtin_amdgcn_s_memrealtime() - pt0_; } while (0)
#else
#define PT_BEGIN(k)
#define PT_END(k)
#define PTS(k)
#define PTE(k)
#endif
#ifdef PROBE_CLOCK
    unsigned long long probe_dc_ = 0, probe_dr_ = 1;
#endif

#define SCR() ((LAS float*)(L + RING_OFF + wave * 16384))
        constexpr int I0 = 64 * 544, I1 = 32 * 128, I3 = 64 * 128, I4 = 64 * 344, I6 = 172 * 128;
        constexpr int NITEMS = I0 + 2 * I1 + I3 + 2 * I4 + I6;
        auto decode = [&](int it) -> P0Ref {
            int r = (it < NITEMS - I0) ? it + I0 : it - (NITEMS - I0);
            if (r < I0) { const int kb = r / 544, nb = r % 544; return P0Ref{INP(7) + (size_t)(64 * kb) * INW + 32 * nb, WSB(WS_WIN) + tiled_off(win_map(32 * nb), kb, 64), INW}; } r -= I0;
            if (r < I1) { const int kb = r / 128, nb = r % 128; return P0Ref{INP(9) + (size_t)(64 * kb) * DM + 32 * nb, WSB(WS_WAB) + tiled_off(32 * nb, kb, 64), DM}; } r -= I1;
            if (r < I1) { const int kb = r / 128, nb = r % 128; return P0Ref{INP(10) + (size_t)(64 * kb) * DM + 32 * nb, WSB(WS_WAB) + tiled_off(32 * nb, 32 + kb, 64), DM}; } r -= I1;
            if (r < I3) { const int kb = r / 128, nb = r % 128; return P0Ref{INP(12) + (size_t)(64 * kb) * DM + 32 * nb, WSB(WS_WO) + tiled_off(32 * nb, kb, 64), DM}; } r -= I3;
            if (r < I4) { const int kb = r / 344, nb = r % 344; return P0Ref{INP(14) + (size_t)(64 * kb) * DFF + 32 * nb, WSB(WS_WGU) + tiled_off(((32 * nb) >> 7) * 256 + ((32 * nb) & 127), kb, 64), DFF}; } r -= I4;
            if (r < I4) { const int kb = r / 344, nb = r % 344; return P0Ref{INP(15) + (size_t)(64 * kb) * DFF + 32 * nb, WSB(WS_WGU) + tiled_off(((32 * nb) >> 7) * 256 + 128 + ((32 * nb) & 127), kb, 64), DFF}; } r -= I4;
            const int kb = r / 128, nb = r % 128; return P0Ref{INP(18) + (size_t)(64 * kb) * DM + 32 * nb, WSB(WS_WD) + tiled_off(32 * nb, kb, 172), DM};
        };
    const int p1_units = (MPAD / 256) * (INW / 256), p1_hole = (p1_units % G) ? G - (p1_units % G) : 0;
    const int DEFER = 0;
    constexpr int R_AB0 = 0, R_AB1 = 2 * I1, R_O1 = R_AB1 + I3, R_GU1 = R_O1 + 2 * I4, R_D1 = R_GU1 + I6, R_IN1 = NITEMS;
    static_assert(R_D1 == NITEMS - I0, "item ranges");
#define CONVERT_RANGE(FIRST, LAST, SCRP) do { const int f_ = (FIRST), l_ = (LAST); if (f_ + gw < l_) { P0Ref cur = decode(f_ + gw); f32x4 va[8], vb[8]; p0_load(cur, va, lane); \
        for (int it = f_ + gw; it < l_; it += NGW) { const int nx = it + NGW; P0Ref nr = cur; if (nx < l_) { nr = decode(nx); p0_load(nr, vb, lane); } p0_store(cur, va, (SCRP), lane); \
            _Pragma("unroll") for (int i = 0; i < 8; ++i) va[i] = vb[i]; cur = nr; } } } while (0)
    PT_BEGIN(0);
    for (int rep_ = 0; rep_ < REPN(0); ++rep_) {
    if (PH(0)) {
        PHASE_IDS();
        f32x4 g1v[16]; load_gain(INP(6), g1v, lane);
        {
            f32x4 va[16], vb[16];
            if (gw < ROWS_R) load_row(gw < ROWS_P ? INP(0) + (size_t)gw * DM : INP(1) + (size_t)(gw - ROWS_P) * DM, va, lane);
#pragma unroll 1
            for (int m = gw; m < MPAD; m += NGW) {
                const int mn = m + NGW;
                if (mn < ROWS_R) load_row(mn < ROWS_P ? INP(0) + (size_t)mn * DM : INP(1) + (size_t)(mn - ROWS_P) * DM, vb, lane);
                if (m < ROWS_R) rms_row_pre_tiled(va, g1v, WSB(WS_XN) + tiled_off(m, 0, 64), lane);
                else {
#pragma unroll
                    for (int j = 0; j < 8; ++j) { const int c = 8 * (lane + 64 * j); *(GAS v4u*)(WSB(WS_XN) + tiled_off(m, c >> 6, 64) + (c & 63)) = (v4u){0u, 0u, 0u, 0u}; } }
#pragma unroll
                for (int j = 0; j < 16; ++j) va[j] = vb[j];
            }
        }
        CONVERT_RANGE(R_D1, R_IN1, SCR());
    }
    xcd_barrier(bar);
    }
    PT_END(0);

    PT_BEGIN(1);
    for (int rep_ = 0; rep_ < REPN(1); ++rep_) {
    if (PH(1)) {
        PHASE_IDS();
        pg8::Gemm g{WSB(WS_XN), WSB(WS_WIN), MPAD, INW, DM}; OrderXcd S; S.init(INW / 256, INW / 256, G, bx);
        pg8::EpiProj E{WSB(WS_CB), WSB(WS_UU), WSB(WS_Q), WSB(WS_K), WSB(WS_VT), WSB(WS_RAT), WSB(WS_SGB), out, (LAS bf16*)(L + XCH_OFF)};
#if defined(PROBE_CLOCK) && PROBE_CLOCK == 1
        const unsigned long long pc0_ = __builtin_amdgcn_s_memtime(), pr0_ = __builtin_amdgcn_s_memrealtime();
#endif
        pg8::gemm_phase<pg8::EpiProj, OrderXcd, false, true, true, true, false, false, true>(L + RING_OFF, g, S, E);
#if defined(PROBE_CLOCK) && PROBE_CLOCK == 1
        probe_dc_ = __builtin_amdgcn_s_memtime() - pc0_; probe_dr_ = __builtin_amdgcn_s_memrealtime() - pr0_;
#endif
        if (P1_HOLE_COPY && G == 256 && ((bx >> 3) >> 2) >= 4) {
            const int sidx = (bx & 7) + 8 * (((bx >> 3) & 3) + 4 * (((bx >> 3) >> 2) - 4));
            if (sidx >= INW / 256) { const int h = sidx - INW / 256, nh = 128 - INW / 256;
                for (int blk = h; blk < 256; blk += nh) { const int tensor = blk >> 7, b = blk & 127;
                    const GAS f32x4* src = (const GAS f32x4*)((tensor ? INP(3) : INP(2)) + ((size_t)b * 128 + 1) * 512); GAS f32x4* dst = (GAS f32x4*)(out + (tensor ? O_SV : O_SK) + (size_t)b * 128 * 512);
#pragma unroll 1
                    for (int i0 = threadIdx.x; i0 < 127 * 128; i0 += 8 * 512) {
                        const int ia = i0, ib = min(i0 + 512, 127 * 128 - 1), ic = min(i0 + 1024, 127 * 128 - 1), id = min(i0 + 1536, 127 * 128 - 1), ie = min(i0 + 2048, 127 * 128 - 1), ig = min(i0 + 2560, 127 * 128 - 1), ih = min(i0 + 3072, 127 * 128 - 1), ii = min(i0 + 3584, 127 * 128 - 1);
                        const f32x4 va = src[ia], vb = src[ib], vc = src[ic], vd = src[id], ve = src[ie], vg = src[ig], vh = src[ih], vi = src[ii];
                        dst[ia] = va; dst[ib] = vb; dst[ic] = vc; dst[id] = vd; dst[ie] = ve; dst[ig] = vg; dst[ih] = vh; dst[ii] = vi; } } } }
        if (DEFER && bx >= G - p1_hole) {
            const int hw = (bx - (G - p1_hole)) * NWAVES + wave, nhw = p1_hole * NWAVES, first = NITEMS - DEFER;
            if (first + hw < NITEMS) {
                P0Ref cur = decode(first + hw); f32x4 va[8], vb[8];
                p0_load(cur, va, lane);
                for (int it = first + hw; it < NITEMS; it += nhw) {
                    const int nx = it + nhw; P0Ref nr = cur;
                    if (nx < NITEMS) { nr = decode(nx); p0_load(nr, vb, lane); }
                    p0_store(cur, va, SCR(), lane);
#pragma unroll
                    for (int i = 0; i < 8; ++i) va[i] = vb[i];
                    cur = nr;
                }
            }
        }
#ifdef PROBE_P1_NULL
#ifdef PROBE_SAME
        { pg8::EpiNull EN{(float*)(ws + WS_CTL + 512)}; OrderSame SS{9}; pg8::gemm_phase<pg8::EpiNull, OrderSame, true, true, true, true>(L + RING_OFF, g, SS, EN); }
#else
        { pg8::EpiNull EN{(float*)(ws + WS_CTL + 512)}; pg8::gemm_phase<pg8::EpiNull, OrderXcd, true, true, true, true>(L + RING_OFF, g, S, EN); }
#endif
#endif
    }
    xcd_barrier(bar);
    }
    PT_END(1);

    PT_BEGIN(2);
    for (int rep_ = 0; rep_ < REPN(2); ++rep_) {
    if (PH(2)) {
        PHASE_IDS();
        LAS float* biasT = (LAS float*)(L + RING_OFF);
        PTS(1);
        for (int i = tid; i < 32 * 129; i += NWAVES * 64) { const int h = i / 129, d = i - h * 129;
            int bk = d;
            if (d >= 16) { bk = 16 + (int)(log2f((float)d * 0.0625f) * (16.0f / 3.0f)); bk = bk > 31 ? 31 : bk; }
            biasT[h * BIAS_LD + d] = *(const GAS float*)(INP(19) + bk * 32 + h); }
        __syncthreads();
        LAS float* sc = (LAS float*)(L + SCR_OFF + wave * SCR_WAVE);
        if (wave >= 4) CONVERT_RANGE(R_AB0, R_AB1, (LAS float*)(L + 61440 + wave * 8448));
        for (int t = gw; t < 4 * 8 * 64 * 4; t += NGW) attn_prompt_task(t, WSB(WS_Q), WSB(WS_K), WSB(WS_VT), WSB(WS_AO), INP(11), biasT, lane);
        PTE(1); PTS(2);
        if (P1_HOLE_COPY && G == 256) { for (int t = NGW - 1 - gw; t < 128 * 8; t += NGW) attn_sample_task<false>(t, WSB(WS_Q), INP(2), INP(3), out, WSB(WS_AO), INP(11), biasT, sc, lane); }
        else { for (int t = NGW - 1 - gw; t < 128 * 8; t += NGW) attn_sample_task<true>(t, WSB(WS_Q), INP(2), INP(3), out, WSB(WS_AO), INP(11), biasT, sc, lane); }
        { const int cwn = NGW > 128 * 8 ? NGW - 128 * 8 : NGW;
          if (gw < cwn) {
            for (int run = gw; run < ROWS_P / 8; run += cwn) conv_run8(8 * run, WSB(WS_CB), WSB(WS_UU), WSB(WS_AO), INP(8), lane);
            for (int m = ROWS_P + gw; m < ROWS_R; m += cwn) conv_row(m, WSB(WS_CB), WSB(WS_UU), WSB(WS_AO), INP(8), INP(4), out, lane); } }
        PTE(2); PTS(3);
        if (wave < 4) CONVERT_RANGE(R_AB0, R_AB1, (LAS float*)(L + 61440 + wave * 8448));
        PTE(3);
#ifdef PROBE_P2A
        for (int t = gw; t < 4 * 8 * 64 * 4; t += NGW) attn_prompt_task(t, WSB(WS_Q), WSB(WS_K), WSB(WS_VT), WSB(WS_AO), INP(11), biasT, lane);
#endif
#ifdef PROBE_P2S
        for (int t = NGW - 1 - gw; t < 128 * 8; t += NGW) attn_sample_task<true>(t, WSB(WS_Q), INP(2), INP(3), out, WSB(WS_AO), INP(11), biasT, sc, lane);
#endif
    }
    xcd_barrier(bar);
    }
    PT_END(2);

    PT_BEGIN(3);
    for (int rep_ = 0; rep_ < REPN(3); ++rep_) {
    if (PH(3)) {
        PHASE_IDS();
        pg8::Gemm g{WSB(WS_AO), WSB(WS_WAB), ROWS_P, DM, DM}; OrderXcd S; S.init(DM / 256, 0, G, bx);
        pg8::EpiMerged E{WSB(WS_RAT), WSB(WS_SGB), WSB(WS_MG)};
        pg8::gemm_phase<pg8::EpiMerged, OrderXcd, true, true, false, true>(L + RING_OFF, g, S, E);
        { const int fr = lane & 15, fq = lane >> 4;
#ifdef PROBE_SK2
          for (int rp_ = 0; rp_ < 2; ++rp_)
#endif
          for (int t = vcu; t < 2 * (DM / 32); t += G) { const int cp = t >> 1, rh = t & 1;
            f32x4 acc[8];
#pragma unroll
            for (int q = 0; q < 8; ++q) acc[q] = (f32x4){0.f, 0.f, 0.f, 0.f};
            const bf16* const bp[2] = {WSB(WS_WAB) + tiled_off(32 * cp + fr, 0, 64), WSB(WS_WAB) + tiled_off(32 * cp + 16 + fr, 0, 64)};
            const size_t o = (size_t)(ROWS_P + 64 * rh + 16 * (wave & 3) + fr) * DM + 32 * cp + 16 * (wave >> 2) + 4 * fq;
            const v2u rat_ = *(const GAS v2u*)(WSB(WS_RAT) + o), sgb_ = *(const GAS v2u*)(WSB(WS_SGB) + o);
            skinny_ksplit<2, 4, true>(acc, WSB(WS_AO) + (size_t)(ROWS_P + 64 * rh) * DM, DM, 64, bp, 16384, (wave >> 2) * 32 + (wave & 3), 4, 8, vcu & 7, fr, fq);
            f32x4 lo, hi; skinny_reduce(acc, (LAS f32x4*)(L + RING_OFF), wave, lane, lo, hi);
            *(GAS v2u*)(WSB(WS_MG) + o) = pack4((lo * unpack4(rat_) + hi) * unpack4(sgb_));
          } }
        CONVERT_RANGE(R_AB1, R_O1, SCR());
    }
    xcd_barrier(bar);
    }
    PT_END(3);

    PT_BEGIN(4);
    for (int rep_ = 0; rep_ < REPN(4); ++rep_) {
    if (PH(4)) {
        PHASE_IDS();
        pg8::Gemm g{WSB(WS_MG), WSB(WS_WO), ROWS_P, DM, DM}; OrderXcd S; S.init(DM / 256, 0, G, bx);
        pg8::EpiResidB<false> E{INP(0), WSB(WS_X1), WSB(WS_XN), INP(13), (float*)(ws + WS_PART1)};
        pg8::gemm_phase<pg8::EpiResidB<false>, OrderXcd, true, true, false, true>(L + RING_OFF, g, S, E);
        { OrderSlices S2{DM / 128, G, bx}; pg8::EpiSlab E2{(float*)(ws + WS_SLAB4), DM / 128};
          pg8::gemm_phase<pg8::EpiSlab, OrderSlices, false, true, false, true, false, true>(L + RING_OFF, g, S2, E2); }
    }
    xcd_barrier(bar);
    }
    PT_END(4);

    PT_BEGIN(5);
    for (int rep_ = 0; rep_ < REPN(5); ++rep_) {
    if (PH(5)) { PHASE_IDS();
        for (int m0 = gw; m0 < ROWS_P; m0 += 4 * NGW) { f32x4 p[4];
#pragma unroll
            for (int i = 0; i < 4; ++i) { const int m = m0 + i * NGW; p[i] = (f32x4){0.f, 0.f, 0.f, 0.f}; if (m < ROWS_P) p[i] = *(const GAS f32x4*)((const float*)(ws + WS_PART1) + (size_t)m * 256 + 4 * lane); }
#pragma unroll
            for (int i = 0; i < 4; ++i) { const int m = m0 + i * NGW; const float ss = wave_sum((p[i].x + p[i].y) + (p[i].z + p[i].w)); if (m < ROWS_P && lane == 0) *(GAS float*)((float*)(ws + WS_RSTAT) + m) = 1.0f / sqrtf(ss * (1.0f / DM) + EPS); } }
        for (int r = bx; r < ROWS_R - ROWS_P; r += G) {
            const int c = 512 * wave + 8 * lane;
            const float* sl = (const float*)(ws + WS_SLAB4) + (size_t)r * DM + c;
            f32x4 a0 = ldg4f(INP(1) + (size_t)r * DM + c), a1 = ldg4f(INP(1) + (size_t)r * DM + c + 4);
#pragma unroll
            for (int h = 0; h < 2; ++h) { f32x4 t0[8], t1[8];
#pragma unroll
                for (int q = 0; q < 8; ++q) { t0[q] = ldg4f(sl + (size_t)(8 * h + q) * 128 * DM); t1[q] = ldg4f(sl + (size_t)(8 * h + q) * 128 * DM + 4); }
#pragma unroll
                for (int q = 0; q < 8; ++q) { a0 += t0[q]; a1 += t1[q]; } }
            float* xo = (float*)(ws + WS_X1) + (size_t)(ROWS_P + r) * DM + c;
            *(GAS f32x4*)xo = a0; *(GAS f32x4*)(xo + 4) = a1;
            const float ssw = wave_sum(((a0.x * a0.x + a0.y * a0.y) + (a0.z * a0.z + a0.w * a0.w)) + ((a1.x * a1.x + a1.y * a1.y) + (a1.z * a1.z + a1.w * a1.w)));
            LAS float* red = (LAS float*)(L + RING_OFF);
            if (lane == 0) red[wave] = ssw;
            __syncthreads();
            const float tot = ((red[0] + red[1]) + (red[2] + red[3])) + ((red[4] + red[5]) + (red[6] + red[7]));
            __syncthreads();
            if (wave == 0 && lane == 0) *(GAS float*)((float*)(ws + WS_RSTAT) + ROWS_P + r) = 1.0f / sqrtf(tot * (1.0f / DM) + EPS);
            const f32x4 y0 = a0 * ldg4f(INP(13) + c), y1 = a1 * ldg4f(INP(13) + c + 4);
            v4u w; w.x = cvtpk(y0.x, y0.y); w.y = cvtpk(y0.z, y0.w); w.z = cvtpk(y1.x, y1.y); w.w = cvtpk(y1.z, y1.w);
            *(GAS v4u*)(WSB(WS_XN) + tiled_off(ROWS_P + r, c >> 6, 64) + (c & 63)) = w;
        }
        CONVERT_RANGE(R_O1, R_GU1, SCR());
    }
    xcd_barrier(bar);
    }
    PT_END(5);

    PT_BEGIN(6);
    for (int rep_ = 0; rep_ < REPN(6); ++rep_) {
    if (PH(6)) {
        PHASE_IDS();
        pg8::Gemm g{WSB(WS_XN), WSB(WS_WGU), MPAD, 2 * DFF, DM}; OrderXcd S; S.init(2 * DFF / 256, P6_SAMPLE_TILES, G, bx);
        pg8::EpiGateUpF E{WSB(WS_F), (float*)(ws + WS_SIDEG), (float*)(ws + WS_SIDEU), INP(16), INP(17), INP(5), out, (LAS float*)(L + XCH_OFF), (const float*)(ws + WS_RSTAT)};
#if defined(PROBE_CLOCK) && PROBE_CLOCK == 6
        const unsigned long long pc6_ = __builtin_amdgcn_s_memtime(), pr6_ = __builtin_amdgcn_s_memrealtime();
#endif
        pg8::gemm_phase<pg8::EpiGateUpF, OrderXcd, true, true, true, true, P6_BNT>(L + RING_OFF, g, S, E);
#if defined(PROBE_CLOCK) && PROBE_CLOCK == 6
        probe_dc_ = __builtin_amdgcn_s_memtime() - pc6_; probe_dr_ = __builtin_amdgcn_s_memrealtime() - pr6_;
#endif
        { const int fr = lane & 15, fq = lane >> 4; LAS f32x4* red = (LAS f32x4*)(L + RING_OFF);
          for (int t = vcu; t < 2 * ((DFF - P6_SAMPLE_TILES * 128) / 16); t += G) { const int j = t >> 1, rh = t & 1;
            const int ch = P6_SAMPLE_TILES * 128 + 16 * j, nrow = (ch >> 7) * 256 + (ch & 127) + fr;
            f32x4 acc[8];
#pragma unroll
            for (int q = 0; q < 8; ++q) acc[q] = (f32x4){0.f, 0.f, 0.f, 0.f};
            const bf16* const bp[2] = {WSB(WS_WGU) + tiled_off(nrow, 0, 64), WSB(WS_WGU) + tiled_off(nrow + 128, 0, 64)};
            skinny_ksplit<2, 4, true>(acc, WSB(WS_XN) + tiled_off(ROWS_P + 64 * rh, 0, 64), 64, 16384, bp, 16384, wave, 8, 8, vcu & 7, fr, fq);
#pragma unroll
            for (int q = 0; q < 8; ++q) red[(wave * 8 + q) * 64 + lane] = acc[q];
            __syncthreads();
            if (wave < 4) {
                f32x4 gv = (f32x4){0.f, 0.f, 0.f, 0.f}, uv = (f32x4){0.f, 0.f, 0.f, 0.f};
#pragma unroll
                for (int ww = 0; ww < 8; ++ww) { gv += red[(ww * 8 + wave) * 64 + lane]; uv += red[(ww * 8 + 4 + wave) * 64 + lane]; }
                const size_t b = 64 * rh + 16 * wave + fr; const int c = ch + 4 * fq;
                { const float rs = *(const GAS float*)((const float*)(ws + WS_RSTAT) + ROWS_P + b); gv *= rs; uv *= rs; }
                const f32x4 s0 = ldg4f(INP(5) + (b * 2 + 0) * DFF + c), s1 = ldg4f(INP(5) + (b * 2 + 1) * DFF + c);
                const f32x4 gc = ((ldg4f(INP(16) + c) * s0 + ldg4f(INP(16) + DFF + c) * s1) + ldg4f(INP(16) + 2 * DFF + c) * gv) + ldg4f(INP(17) + c);
                *(GAS f32x4*)(out + O_SF + (b * 2 + 0) * DFF + c) = s1; *(GAS f32x4*)(out + O_SF + (b * 2 + 1) * DFF + c) = gv;
                *(GAS v2u*)(WSB(WS_F) + (ROWS_P + b) * DFF + c) = pack4((f32x4){silu_mul(gc[0], uv[0]), silu_mul(gc[1], uv[1]), silu_mul(gc[2], uv[2]), silu_mul(gc[3], uv[3])});
            }
            __syncthreads();
          } }
    }
    xcd_barrier(bar);
    }
    PT_END(6);

    PT_BEGIN(7);
    for (int rep_ = 0; rep_ < REPN(7); ++rep_) {
    if (PH(7)) { PHASE_IDS(); for (int idx = gw * 64 + lane; idx < 32 * 2 * (DFF / 8); idx += NGW * 64) {
        const int c = 8 * (idx % (DFF / 8)), rr = (idx / (DFF / 8)) & 1, pm = idx / (2 * (DFF / 8));
        if ((pm & 7) != 0) {
            const float* sg = (const float*)(ws + WS_SIDEG); const float* su = (const float*)(ws + WS_SIDEU);
            float g0[8], gm1[8], gm2[8], uv[8], w0[8], w1[8], w2[8], bb[8], f[8];
            ld8f(sg + ((size_t)pm * 4 + rr) * DFF + c, g0); ld8f(su + ((size_t)pm * 2 + rr) * DFF + c, uv);
            ld8f(rr == 0 ? sg + ((size_t)(pm - 1) * 4 + 3) * DFF + c : sg + ((size_t)pm * 4 + 0) * DFF + c, gm1);
            ld8f(rr == 0 ? sg + ((size_t)(pm - 1) * 4 + 2) * DFF + c : sg + ((size_t)(pm - 1) * 4 + 3) * DFF + c, gm2);
            ld8f(INP(16) + c, w0); ld8f(INP(16) + DFF + c, w1); ld8f(INP(16) + 2 * DFF + c, w2); ld8f(INP(17) + c, bb);
#pragma unroll
            for (int e = 0; e < 8; ++e) f[e] = silu_mul(((w0[e] * gm2[e] + w1[e] * gm1[e]) + w2[e] * g0[e]) + bb[e], uv[e]);
            v4u w; w.x = cvtpk(f[0], f[1]); w.y = cvtpk(f[2], f[3]); w.z = cvtpk(f[4], f[5]); w.w = cvtpk(f[6], f[7]);
            *(GAS v4u*)(WSB(WS_F) + ((size_t)pm * 256 + rr) * DFF + c) = w;
        }
    }     CONVERT_RANGE(R_GU1, R_D1, SCR());
    }
    xcd_barrier(bar);
    }
    PT_END(7);

    PT_BEGIN(8);
    if (PH(8)) {
        PHASE_IDS();
        pg8::Gemm g{WSB(WS_F), WSB(WS_WD), ROWS_P, DM, DFF}; OrderXcd S; S.init(DM / 256, 0, G, bx);
        pg8::EpiResidB<true> E{WSB(WS_X1), WSB(WS_X1) + (size_t)ROWS_P * DM, nullptr, nullptr, (float*)(ws + WS_PART2)};
        pg8::gemm_phase<pg8::EpiResidB<true>, OrderXcd, true, true, false, true>(L + RING_OFF, g, S, E);
        { OrderSlices S2{DFF / 128, G, bx}; pg8::EpiSlab E2{(float*)(ws + WS_SLAB), DFF / 128};
          pg8::gemm_phase<pg8::EpiSlab, OrderSlices, false, true, false, true, false, true>(L + RING_OFF, g, S2, E2); }
    }
    xcd_barrier(bar);
    PT_END(8);

    PT_BEGIN(9);
    if (PH(9)) { PHASE_IDS();
        const GAS f32x4* gr = (const GAS f32x4*)INP(20); f32x4 g[16];
#pragma unroll
        for (int j = 0; j < 8; ++j) { const int q = 2 * (lane + 64 * j); g[2 * j] = gr[q]; g[2 * j + 1] = gr[q + 1]; }
        v4u w[8]; f32x4 p4 = (f32x4){0.f, 0.f, 0.f, 0.f};
        if (gw < ROWS_P) { const GAS v4u* xr = (const GAS v4u*)(WSB(WS_X1) + (size_t)(ROWS_P + gw) * DM) + lane;
#pragma unroll
            for (int j = 0; j < 8; ++j) w[j] = xr[64 * j];
            p4 = *(const GAS f32x4*)((const float*)(ws + WS_PART2) + (size_t)gw * 256 + 4 * lane); }
#pragma unroll 1
        for (int m = gw; m < ROWS_P; m += NGW) {
            const int mn = m + NGW; v4u wn[8]; f32x4 pn = (f32x4){0.f, 0.f, 0.f, 0.f};
#pragma unroll
            for (int j = 0; j < 8; ++j) wn[j] = (v4u){0u, 0u, 0u, 0u};
            if (mn < ROWS_P) { const GAS v4u* xr = (const GAS v4u*)(WSB(WS_X1) + (size_t)(ROWS_P + mn) * DM) + lane;
#pragma unroll
                for (int j = 0; j < 8; ++j) wn[j] = xr[64 * j];
                pn = *(const GAS f32x4*)((const float*)(ws + WS_PART2) + (size_t)mn * 256 + 4 * lane); }
            const float r = 1.0f / sqrtf(wave_sum((p4.x + p4.y) + (p4.z + p4.w)) * (1.0f / DM) + EPS);
            GAS f32x4* orow = (GAS f32x4*)(out + O_YP + (size_t)m * DM);
#pragma unroll
            for (int j = 0; j < 8; ++j) { float x[8]; unpack8(w[j], x); const int q = 2 * (lane + 64 * j); const f32x4 g0 = g[2 * j], g1 = g[2 * j + 1];
                orow[q] = (f32x4){(x[0] * r) * g0.x, (x[1] * r) * g0.y, (x[2] * r) * g0.z, (x[3] * r) * g0.w}; orow[q + 1] = (f32x4){(x[4] * r) * g1.x, (x[5] * r) * g1.y, (x[6] * r) * g1.z, (x[7] * r) * g1.w}; }
#pragma unroll
            for (int j = 0; j < 8; ++j) w[j] = wn[j];
            p4 = pn;
        }
        for (int r = bx; r < ROWS_R - ROWS_P; r += G) {
            const int c = 512 * wave + 8 * lane;
            const float* xr = (const float*)(ws + WS_X1) + (size_t)(ROWS_P + r) * DM + c; const float* sl = (const float*)(ws + WS_SLAB) + (size_t)r * DM + c;
            f32x4 a0 = ldg4f(xr), a1 = ldg4f(xr + 4);
#pragma unroll
            for (int h = 0; h < 2; ++h) { f32x4 t0[8], t1[8];
#pragma unroll
                for (int q = 0; q < 8; ++q) { t0[q] = ldg4f(sl + (size_t)(8 * h + q) * 128 * DM); t1[q] = ldg4f(sl + (size_t)(8 * h + q) * 128 * DM + 4); }
#pragma unroll
                for (int q = 0; q < 8; ++q) { a0 += t0[q]; a1 += t1[q]; } }
            const float ssw = wave_sum(((a0.x * a0.x + a0.y * a0.y) + (a0.z * a0.z + a0.w * a0.w)) + ((a1.x * a1.x + a1.y * a1.y) + (a1.z * a1.z + a1.w * a1.w)));
            LAS float* red = (LAS float*)(L + RING_OFF);
            if (lane == 0) red[wave] = ssw;
            __syncthreads();
            const float tot = ((red[0] + red[1]) + (red[2] + red[3])) + ((red[4] + red[5]) + (red[6] + red[7]));
            __syncthreads();
            const float rr = 1.0f / sqrtf(tot * (1.0f / DM) + EPS);
            const f32x4 g0 = ldg4f(INP(20) + c), g1 = ldg4f(INP(20) + c + 4);
            float* yo = out + O_YS + (size_t)r * DM + c;
            *(GAS f32x4*)yo = (a0 * rr) * g0; *(GAS f32x4*)(yo + 4) = (a1 * rr) * g1;
        }
    }
    PT_END(9);
#ifdef PROBE_PHASES
#ifndef PROBE_BLOCK
#define PROBE_BLOCK 0
#endif
    if (blockIdx.x == PROBE_BLOCK) { const unsigned long long t0_ = __builtin_amdgcn_s_memrealtime(); while (__builtin_amdgcn_s_memrealtime() - t0_ < probe_acc_) __builtin_amdgcn_s_sleep(8); }
#endif
#ifdef PROBE_CLOCK
    if (blockIdx.x == 0) {
#ifdef PROBE_CYCLES
        const unsigned long long want = probe_dc_ * 20ull / 576ull, t0_ = __builtin_amdgcn_s_memrealtime();
#else
        const unsigned long long want = probe_dc_ * 5000ull / probe_dr_, t0_ = __builtin_amdgcn_s_memrealtime();
#endif
        while (__builtin_amdgcn_s_memrealtime() - t0_ < want) __builtin_amdgcn_s_sleep(8);
    }
#endif
}

extern "C" void kernel_launch(void* const* d_in, const int* in_sizes, int n_in, void* d_out, int out_size, void* d_ws, size_t ws_size, hipStream_t stream) {
    static int grid = 0;
    if (grid == 0) {
        if (n_in != 21 || in_sizes[0] != ROWS_P * DM || (size_t)out_size != O_END || ws_size < WS_END) {
            fprintf(stderr, "kernel_launch: built for 21 inputs, x_prompt of %d floats, %zu outputs, >= %zu bytes of workspace; got n_in %d, in0 %d, out %d, ws %zu; nothing launched\n", ROWS_P * DM, (size_t)O_END, (size_t)WS_END, n_in, n_in > 0 ? in_sizes[0] : -1, out_size, ws_size);
            grid = -1; return; }
        int dev = 0, cus = 0, per_cu = 0;
        if (hipGetDevice(&dev) != hipSuccess || hipDeviceGetAttribute(&cus, hipDeviceAttributeMultiprocessorCount, dev) != hipSuccess) { fprintf(stderr, "kernel_launch: hipGetDevice / hipDeviceGetAttribute failed; nothing launched\n"); grid = -1; return; }
        if (hipFuncSetAttribute((const void*)mega_fwd, hipFuncAttributeMaxDynamicSharedMemorySize, LDS_BYTES) != hipSuccess) { fprintf(stderr, "kernel_launch: hipFuncSetAttribute failed; nothing launched\n"); grid = -1; return; }
        if (hipOccupancyMaxActiveBlocksPerMultiprocessor(&per_cu, (const void*)mega_fwd, NWAVES * 64, LDS_BYTES) != hipSuccess || per_cu < 1)
            fprintf(stderr, "kernel_launch: note: the occupancy query reports %d workgroups per CU\n", per_cu);
        (void)hipGetLastError();
        grid = cus;
    }
    if (grid < 0) return;
    if (hipMemsetAsync((char*)d_ws + WS_CTL, 0, CTL_ZERO_BYTES, stream) != hipSuccess) { fprintf(stderr, "kernel_launch: hipMemsetAsync failed; nothing launched\n"); return; }
    Args a{};
    for (int i = 0; i < 21; ++i) a.in[i] = (const float*)d_in[i];
    a.out = (float*)d_out; a.ws = (unsigned char*)d_ws;
    hipLaunchKernelGGL(mega_fwd, dim3(grid), dim3(NWAVES * 64), LDS_BYTES, stream, a);
    const hipError_t le = hipPeekAtLastError();
    if (le != hipSuccess) fprintf(stderr, "kernel_launch: launch failed: %s (grid %d x %d threads, %d B LDS)\n", hipGetErrorName(le), grid, NWAVES * 64, LDS_BYTES);
}
```

```cpp
#include <hip/hip_runtime.h>
#include <cstdio>
#include <cstdint>
#include <cmath>
namespace pg8 {
#define PG8_LAS __attribute__((address_space(3)))
typedef unsigned short bf16_t;
typedef short bf16x8 __attribute__((ext_vector_type(8)));
typedef float f32x4 __attribute__((ext_vector_type(4)));
typedef unsigned u32x4 __attribute__((ext_vector_type(4)));
constexpr int BM = 256, BK = 64, HALF = 128, HTB = HALF * BK * 2  , STAGE_BYTES = 8 * HTB, NXCD = 8, WGM = 8;

__host__ __device__ __forceinline__ int lds_byte(int r, int c) { const int st = (r >> 4) * 2 + (c >> 5), rr = r & 15, cc = c & 31, ob = rr * 64 + cc * 2; return st * 1024 + (ob ^ (((ob >> 9) & 1) << 5)); }
__host__ __device__ __forceinline__ void stage_rc(int b, int& R, int& C) { const int st = b / 1024, sb = b % 1024, swz = sb ^ (((sb >> 9) & 1) << 5); R = (st >> 1) * 16 + swz / 64; C = (st & 1) * 32 + (swz % 64) / 2; }
__host__ __device__ __forceinline__ int perm32(int rho) { const int n = rho >> 4, i = rho & 15; return 8 * (i >> 2) + 4 * n + (i & 3); }

struct Unit { int pm, pn, kn; };
struct Gemm { const bf16_t* A; const bf16_t* Bt; int M, N, K; };

struct StaticOrder {
    int nM, nN, nwg, G, c;
    __host__ __device__ void init(int M, int N, int G_, int c_) { nM = M / BM; nN = N / BM; nwg = nM * nN; G = G_; c = c_; }
    __host__ __device__ bool next(int i, Unit& u) const {
        const long L = (long)i * G + c; if (L >= nwg) return false;
        int wgid = (int)L; { const int q = nwg / NXCD, r = nwg % NXCD, xcd = wgid % NXCD, off = wgid / NXCD; wgid = (xcd < r ? xcd * (q + 1) : r * (q + 1) + (xcd - r) * q) + off; }
        const int nig = WGM * nN, gid = wgid / nig, fm = gid * WGM, gsz = (nM - fm) < WGM ? (nM - fm) : WGM;
        u.pm = fm + ((wgid % nig) % gsz); u.pn = (wgid % nig) / gsz; return true;
    }
    __device__ __forceinline__ void a_ready(const Unit&) const {}
    __device__ __forceinline__ void done(const Unit&) const {}
};

__device__ __forceinline__ unsigned cvt_pk_bf16(float lo, float hi) { unsigned r; asm volatile("v_cvt_pk_bf16_f32 %0, %1, %2" : "=v"(r) : "v"(lo), "v"(hi)); return r; }
typedef float f32x2 __attribute__((ext_vector_type(2)));

#define PG8_GAS __attribute__((address_space(1)))
constexpr int ROWS_P = 8192, ROWS_R = 8320, ROWS_PAD = 8448, PAN_S = 32;
constexpr size_t O_YP = 0, O_YS = 33554432, O_PK = 34078720, O_PV = 34340864, O_PC = 34603008, O_PF = 34619392, O_SK = 34707456, O_SV = 43096064, O_SC = 51484672, O_SF = 52008960, O_END = 54827008;

__device__ __forceinline__ u32x4 pack8(const f32x4 a, const f32x4 b) { u32x4 w; w.x = cvt_pk_bf16(a[0], a[1]); w.y = cvt_pk_bf16(a[2], a[3]); w.z = cvt_pk_bf16(b[0], b[1]); w.w = cvt_pk_bf16(b[2], b[3]); return w; }
__device__ __forceinline__ float bf_lo(unsigned w) { return __uint_as_float(w << 16); }
__device__ __forceinline__ float bf_hi(unsigned w) { return __uint_as_float(w & 0xffff0000u); }
__device__ __forceinline__ void st16(void* p, u32x4 v) { *(PG8_GAS u32x4*)p = v; }
__device__ __forceinline__ void st16f(float* p, f32x4 v) { *(PG8_GAS f32x4*)p = v; }
__device__ __forceinline__ u32x4 ld16(const void* p) { return *(const PG8_GAS u32x4*)p; }
__device__ __forceinline__ f32x4 ld16f(const float* p) { return *(const PG8_GAS f32x4*)p; }
__device__ __forceinline__ u32x4 ld16nt(const void* p) { return __builtin_nontemporal_load((const PG8_GAS u32x4*)p); }
__device__ __forceinline__ f32x4 ld16fnt(const float* p) { return __builtin_nontemporal_load((const PG8_GAS f32x4*)p); }
__device__ __forceinline__ void st16nt(void* p, u32x4 v) { __builtin_nontemporal_store(v, (PG8_GAS u32x4*)p); }
__device__ __forceinline__ float fast_exp(float x) { return __builtin_amdgcn_exp2f(x * 1.4426950408889634f); }

struct EpiProj {
    static constexpr bool PERM = true, AFTER_DRAIN = false, MIDK = false;
    bf16_t *CB, *UU, *Q, *KB, *VT, *RAT, *SGB; float* out; PG8_LAS bf16_t* vt_lds;
    __device__ __forceinline__ void mid(f32x4 (&)[2][2][4][2], const Unit&, int, int, int, int) const {}
    __device__ __forceinline__ void operator()(const f32x4 (&acc)[2][2][4][2], const Unit& u, int wr, int wc, int fr, int fq) const {
        const int pn = u.pn, pm = u.pm;
        const int rbase = pm * BM + wr * 64 + fr;
        const int cl = wc * 32 + 8 * fq;
        const int nai = (pm == PAN_S) ? 1 : 2;
        const bool winp = ((pm & 7) == 7) && (pm < PAN_S);
        if (pn < 8 || (pn >= 24 && pn < 34)) {
            bf16_t* base; int ld, c0;
            if (pn < 8) { base = CB; ld = 2048; c0 = pn * 256; }
            else if (pn < 32) { base = Q; ld = 2048; c0 = (pn - 24) * 256; }
            else { base = KB; ld = 512; c0 = (pn - 32) * 256; }
#pragma unroll
            for (int ai = 0; ai < 2; ++ai) if (ai < nai)
#pragma unroll
                for (int m = 0; m < 4; ++m) { const int row = rbase + ai * HALF + m * 16;
#pragma unroll
                    for (int bj = 0; bj < 2; ++bj) st16nt(base + (size_t)row * ld + c0 + bj * HALF + cl, pack8(acc[ai][bj][m][0], acc[ai][bj][m][1])); }
            if (pn >= 32) {
                if (pm == PAN_S) {
#pragma unroll
                    for (int m = 0; m < 4; ++m) { const int b = rbase + m * 16 - ROWS_P;
#pragma unroll
                        for (int bj = 0; bj < 2; ++bj) { float* d = out + O_SK + ((size_t)b * 128 + 127) * 512 + c0 + bj * HALF + cl; st16f(d, acc[0][bj][m][0]); st16f(d + 4, acc[0][bj][m][1]); } }
                } else if (winp) {
#pragma unroll
                    for (int m = 0; m < 4; ++m) { const int row = rbase + HALF + m * 16, b = row >> 11, j = (row & 2047) - 1920;
#pragma unroll
                        for (int bj = 0; bj < 2; ++bj) { float* d = out + O_PK + ((size_t)b * 128 + j) * 512 + c0 + bj * HALF + cl; st16f(d, acc[1][bj][m][0]); st16f(d + 4, acc[1][bj][m][1]); } }
                }
            }
        } else if (pn < 24) {
            const int c0 = (pn - 8) * 128 + cl;
#pragma unroll
            for (int ai = 0; ai < 2; ++ai) if (ai < nai)
#pragma unroll
                for (int m = 0; m < 4; ++m) { const int row = rbase + ai * HALF + m * 16;
                    const f32x4 u0 = acc[ai][0][m][0] * acc[ai][1][m][0], u1 = acc[ai][0][m][1] * acc[ai][1][m][1];
                    st16nt(UU + (size_t)row * 2048 + c0, pack8(u0, u1));
                    if (pm == PAN_S) { float* d = out + O_SC + ((size_t)(row - ROWS_P) * 2 + 1) * 2048 + c0; st16f(d, u0); st16f(d + 4, u1); }
                    else if (winp && ai == 1 && m == 3 && wr == 1 && fr >= 14) { float* d = out + O_PC + ((size_t)(row >> 11) * 2 + (fr - 14)) * 2048 + c0; st16f(d, u0); st16f(d + 4, u1); }
                }
        } else if (pn < 36) {
            const int c0 = (pn - 34) * 256;
            if (pm < PAN_S) {
                PG8_LAS bf16_t* T = vt_lds + (wr * 4 + wc) * 512;
                const int l = fr + 16 * fq, rch = l >> 1, rh = l & 1;
#pragma unroll
                for (int ai = 0; ai < 2; ++ai)
#pragma unroll
                    for (int m = 0; m < 4; ++m)
#pragma unroll
                        for (int bj = 0; bj < 2; ++bj) {
#pragma unroll
                            for (int n = 0; n < 2; ++n) { const f32x4 v = acc[ai][bj][m][n]; const unsigned w0 = cvt_pk_bf16(v[0], v[1]), w1 = cvt_pk_bf16(v[2], v[3]);
                                PG8_LAS bf16_t* t = T + (8 * fq + 4 * n) * 16 + ((fr & 3) | ((fr & 4) << 1) | ((fr & 8) >> 1));
                                t[0] = (bf16_t)(w0 & 0xffffu); t[16] = (bf16_t)(w0 >> 16); t[32] = (bf16_t)(w1 & 0xffffu); t[48] = (bf16_t)(w1 >> 16); }
                            asm volatile("" ::: "memory");
                            const u32x4 tv = *(const PG8_LAS u32x4*)(T + rch * 16 + 8 * rh);
                            asm volatile("" ::: "memory");
                            st16nt(VT + (size_t)(c0 + bj * HALF + wc * 32 + rch) * ROWS_PAD + pm * BM + ai * HALF + wr * 64 + m * 16 + 8 * rh, tv); }
            }
            if (pm == PAN_S) {
#pragma unroll
                for (int m = 0; m < 4; ++m) { const int b = rbase + m * 16 - ROWS_P;
#pragma unroll
                    for (int bj = 0; bj < 2; ++bj) { float* d = out + O_SV + ((size_t)b * 128 + 127) * 512 + c0 + bj * HALF + cl; st16f(d, acc[0][bj][m][0]); st16f(d + 4, acc[0][bj][m][1]); } }
            } else if (winp) {
#pragma unroll
                for (int m = 0; m < 4; ++m) { const int row = rbase + HALF + m * 16, b = row >> 11, j = (row & 2047) - 1920;
#pragma unroll
                    for (int bj = 0; bj < 2; ++bj) { float* d = out + O_PV + ((size_t)b * 128 + j) * 512 + c0 + bj * HALF + cl; st16f(d, acc[1][bj][m][0]); st16f(d + 4, acc[1][bj][m][1]); } }
            }
        } else {
            const int c0 = (pn - 36) * 128 + cl;
#pragma unroll
            for (int ai = 0; ai < 2; ++ai) if (ai < nai)
#pragma unroll
                for (int m = 0; m < 4; ++m) { const int row = rbase + ai * HALF + m * 16;
                    f32x4 rt[2], sb[2];
#pragma unroll
                    for (int n = 0; n < 2; ++n)
#pragma unroll
                        for (int e = 0; e < 4; ++e) { const float ea = 1.0f + fast_exp(-acc[ai][0][m][n][e]), eb = 1.0f + fast_exp(-acc[ai][1][m][n][e]);
                            sb[n][e] = __builtin_amdgcn_rcpf(eb); rt[n][e] = eb * __builtin_amdgcn_rcpf(ea); }
                    st16nt(RAT + (size_t)row * 4096 + c0, pack8(rt[0], rt[1])); st16nt(SGB + (size_t)row * 4096 + c0, pack8(sb[0], sb[1])); }
        }
    }
};

struct EpiMerged {
    static constexpr bool PERM = true, AFTER_DRAIN = false, MIDK = true;
    const bf16_t *RAT, *SGB; bf16_t* MG;
    __device__ __forceinline__ void scale(f32x4 (&acc)[2][2][4][2], const bf16_t* S, const Unit& u, int wr, int wc, int fr, int fq) const {
        int rbase = u.pm * BM + wr * 64 + fr; const int c0 = u.pn * BM + wc * 32 + 8 * fq, nai = (u.pm == PAN_S) ? 1 : 2;
        asm volatile("" : "+v"(rbase));
        u32x4 r[2][4][2];
#pragma unroll
        for (int ai = 0; ai < 2; ++ai) if (ai < nai)
#pragma unroll
            for (int m = 0; m < 4; ++m)
#pragma unroll
                for (int bj = 0; bj < 2; ++bj) r[ai][m][bj] = ld16nt(S + (size_t)(rbase + ai * HALF + m * 16) * 4096 + c0 + bj * HALF);
#pragma unroll
        for (int ai = 0; ai < 2; ++ai) if (ai < nai)
#pragma unroll
            for (int m = 0; m < 4; ++m)
#pragma unroll
                for (int bj = 0; bj < 2; ++bj) { const u32x4 q = r[ai][m][bj];
                    acc[ai][bj][m][0] *= (f32x4){bf_lo(q.x), bf_hi(q.x), bf_lo(q.y), bf_hi(q.y)}; acc[ai][bj][m][1] *= (f32x4){bf_lo(q.z), bf_hi(q.z), bf_lo(q.w), bf_hi(q.w)}; }
    }
    __device__ __forceinline__ void mid(f32x4 (&acc)[2][2][4][2], const Unit& u, int wr, int wc, int fr, int fq) const { scale(acc, RAT, u, wr, wc, fr, fq); }
    __device__ __forceinline__ void operator()(f32x4 (&acc)[2][2][4][2], const Unit& u, int wr, int wc, int fr, int fq) const {
        scale(acc, SGB, u, wr, wc, fr, fq);
        const int rbase = u.pm * BM + wr * 64 + fr, c0 = u.pn * BM + wc * 32 + 8 * fq, nai = (u.pm == PAN_S) ? 1 : 2;
#pragma unroll
        for (int ai = 0; ai < 2; ++ai) if (ai < nai)
#pragma unroll
            for (int m = 0; m < 4; ++m) { const int row = rbase + ai * HALF + m * 16;
#pragma unroll
                for (int bj = 0; bj < 2; ++bj) st16(MG + (size_t)row * 4096 + c0 + bj * HALF, pack8(acc[ai][bj][m][0], acc[ai][bj][m][1])); }
    }
};

template <bool BASE_BF16> struct EpiResidB {
    static constexpr bool PERM = true, AFTER_DRAIN = false, MIDK = false;
    const void* base; bf16_t* Xo; bf16_t* XN2; const float* g2; float* part;
    __device__ __forceinline__ void mid(f32x4 (&)[2][2][4][2], const Unit&, int, int, int, int) const {}
    __device__ __forceinline__ void operator()(const f32x4 (&acc)[2][2][4][2], const Unit& u, int wr, int wc, int fr, int fq) const {
        const int rbase = u.pm * BM + wr * 64 + fr, c0 = u.pn * BM + wc * 32 + 8 * fq;
        f32x4 gv[2][2];
        if (XN2) {
#pragma unroll
            for (int bj = 0; bj < 2; ++bj)
#pragma unroll
                for (int n = 0; n < 2; ++n) gv[bj][n] = ld16f(g2 + c0 + bj * HALF + 4 * n); }
        u32x4 wb[2][4][2];
        if (BASE_BF16) {
#pragma unroll
            for (int ai = 0; ai < 2; ++ai)
#pragma unroll
                for (int m = 0; m < 4; ++m)
#pragma unroll
                    for (int bj = 0; bj < 2; ++bj) wb[ai][m][bj] = ld16nt((const bf16_t*)base + (size_t)(rbase + ai * HALF + m * 16) * 4096 + c0 + bj * HALF); }
#pragma unroll
        for (int ai = 0; ai < 2; ++ai) {
            f32x4 xb[4][2][2];
            if (!BASE_BF16) {
#pragma unroll
                for (int m = 0; m < 4; ++m)
#pragma unroll
                    for (int bj = 0; bj < 2; ++bj) { const size_t o = (size_t)(rbase + ai * HALF + m * 16) * 4096 + c0 + bj * HALF; xb[m][bj][0] = ld16fnt((const float*)base + o); xb[m][bj][1] = ld16fnt((const float*)base + o + 4); } }
#pragma unroll
            for (int m = 0; m < 4; ++m) { const int row = rbase + ai * HALF + m * 16; f32x4 xo[2][2]; float ss = 0.f;
#pragma unroll
                for (int bj = 0; bj < 2; ++bj) {
                    if (BASE_BF16) { const u32x4 w = wb[ai][m][bj];
                        xo[bj][0] = (f32x4){bf_lo(w.x), bf_hi(w.x), bf_lo(w.y), bf_hi(w.y)} + acc[ai][bj][m][0]; xo[bj][1] = (f32x4){bf_lo(w.z), bf_hi(w.z), bf_lo(w.w), bf_hi(w.w)} + acc[ai][bj][m][1]; }
                    else { xo[bj][0] = xb[m][bj][0] + acc[ai][bj][m][0]; xo[bj][1] = xb[m][bj][1] + acc[ai][bj][m][1]; } }
#pragma unroll
                for (int bj = 0; bj < 2; ++bj) { st16(Xo + (size_t)row * 4096 + c0 + bj * HALF, pack8(xo[bj][0], xo[bj][1]));
#pragma unroll
                    for (int n = 0; n < 2; ++n) ss += (xo[bj][n][0] * xo[bj][n][0] + xo[bj][n][1] * xo[bj][n][1]) + (xo[bj][n][2] * xo[bj][n][2] + xo[bj][n][3] * xo[bj][n][3]);
                    if (XN2) { const int c = c0 + bj * HALF; st16(XN2 + ((size_t)(row >> 8) * 64 + (c >> 6)) * 16384 + (size_t)(row & 255) * 64 + (c & 63), pack8(xo[bj][0] * gv[bj][0], xo[bj][1] * gv[bj][1])); } }
                *(PG8_GAS float*)(part + (size_t)row * 256 + 16 * u.pn + 4 * wc + fq) = ss; }
            asm volatile("" ::: "memory"); }
    }
};

struct EpiGateUpF {
    static constexpr bool PERM = true, AFTER_DRAIN = false, MIDK = false;
    bf16_t* F; float* sideG; float* sideU; const float* cw; const float* cbias; const float* st; float* out; PG8_LAS float* xch; const float* rstat;
    __device__ __forceinline__ void mid(f32x4 (&)[2][2][4][2], const Unit&, int, int, int, int) const {}
    static __device__ __forceinline__ float rot1(float x, int idx) { return __builtin_bit_cast(float, __builtin_amdgcn_ds_bpermute(idx, __builtin_bit_cast(int, x))); }
    static __device__ __forceinline__ f32x4 rot(const f32x4 v, int idx) {
        const float a = rot1(v.x, idx), b = rot1(v.y, idx), c = rot1(v.z, idx), d = rot1(v.w, idx);
        return (f32x4){a, b, c, d}; }
    static __device__ __forceinline__ f32x4 silu_mul4(const f32x4 gc, const f32x4 u) { f32x4 r;
#pragma unroll
        for (int e = 0; e < 4; ++e) r[e] = gc[e] * __builtin_amdgcn_rcpf(1.0f + __builtin_amdgcn_exp2f(-gc[e] * 1.4426950408889634f)) * u[e];
        return r; }
    __device__ __forceinline__ void operator()(f32x4 (&acc)[2][2][4][2], const Unit& u, int wr, int wc, int fr, int fq) const {
        const int pn = u.pn, pm = u.pm;
        const int cl = wc * 32 + 8 * fq, c0 = pn * 128 + cl;
        const int rbase = pm * BM + wr * 64 + fr;
        f32x4 w0[2], w1[2], w2[2], bb[2];
#pragma unroll
        for (int n = 0; n < 2; ++n) { w0[n] = ld16f(cw + c0 + 4 * n); w1[n] = ld16f(cw + 11008 + c0 + 4 * n); w2[n] = ld16f(cw + 2 * 11008 + c0 + 4 * n); bb[n] = ld16f(cbias + c0 + 4 * n); }
        {
            float rs[2][4];
#pragma unroll
            for (int ai = 0; ai < 2; ++ai)
#pragma unroll
                for (int m = 0; m < 4; ++m) rs[ai][m] = *(const PG8_GAS float*)(rstat + pm * BM + wr * 64 + fr + ai * HALF + m * 16);
#pragma unroll
            for (int ai = 0; ai < 2; ++ai)
#pragma unroll
                for (int bj = 0; bj < 2; ++bj)
#pragma unroll
                    for (int m = 0; m < 4; ++m)
#pragma unroll
                        for (int n = 0; n < 2; ++n) acc[ai][bj][m][n] *= rs[ai][m];
        }
        if (pm == PAN_S) {
            f32x4 s0[4][2], s1[4][2];
#pragma unroll
            for (int m = 0; m < 4; ++m)
#pragma unroll
                for (int n = 0; n < 2; ++n) { const int b = rbase + m * 16 - ROWS_P; s0[m][n] = ld16f(st + ((size_t)b * 2 + 0) * 11008 + c0 + 4 * n); s1[m][n] = ld16f(st + ((size_t)b * 2 + 1) * 11008 + c0 + 4 * n); }
#pragma unroll
            for (int m = 0; m < 4; ++m) { const int b = rbase + m * 16 - ROWS_P; f32x4 f[2];
#pragma unroll
                for (int n = 0; n < 2; ++n) { const f32x4 g = acc[0][0][m][n];
                    st16f(out + O_SF + ((size_t)b * 2 + 0) * 11008 + c0 + 4 * n, s1[m][n]); st16f(out + O_SF + ((size_t)b * 2 + 1) * 11008 + c0 + 4 * n, g);
                    f[n] = silu_mul4(((w0[n] * s0[m][n] + w1[n] * s1[m][n]) + w2[n] * g) + bb[n], acc[0][1][m][n]); }
                st16nt(F + (size_t)(rbase + m * 16) * 11008 + c0, pack8(f[0], f[1])); }
            asm volatile("s_waitcnt lgkmcnt(0)" ::: "memory"); __builtin_amdgcn_s_barrier(); asm volatile("" ::: "memory");
            return;
        }
        if (fr >= 14) {
#pragma unroll
            for (int ai = 0; ai < 2; ++ai)
#pragma unroll
                for (int n = 0; n < 2; ++n) *(PG8_LAS f32x4*)(xch + ((ai * 2 + wr) * 2 + (fr - 14)) * 128 + cl + 4 * n) = acc[ai][0][3][n];
        }
        asm volatile("s_waitcnt lgkmcnt(0)" ::: "memory"); __builtin_amdgcn_s_barrier(); asm volatile("" ::: "memory");
        const int lane_ = fr + 16 * fq, i1 = ((lane_ & 48) | ((fr + 15) & 15)) << 2, i2 = ((lane_ & 48) | ((fr + 14) & 15)) << 2;
        const bool winp = ((pm & 7) == 7);
#pragma unroll
        for (int ai = 0; ai < 2; ++ai) {
            f32x4 c1[2], c2[2];
            if (ai == 0 && wr == 0) {
#pragma unroll
                for (int n = 0; n < 2; ++n) { c1[n] = (f32x4){0.f, 0.f, 0.f, 0.f}; c2[n] = (f32x4){0.f, 0.f, 0.f, 0.f}; }
            } else {
                const int sa = (wr == 1) ? ai : ai - 1, sw = (wr == 1) ? 0 : 1;
#pragma unroll
                for (int n = 0; n < 2; ++n) { const f32x4 l2 = *(const PG8_LAS f32x4*)(xch + ((sa * 2 + sw) * 2 + 0) * 128 + cl + 4 * n), l1 = *(const PG8_LAS f32x4*)(xch + ((sa * 2 + sw) * 2 + 1) * 128 + cl + 4 * n);
                    c1[n] = l1; c2[n] = (fr == 0) ? l2 : l1; }
            }
#pragma unroll
            for (int m = 0; m < 4; ++m) { const int row = rbase + ai * HALF + m * 16; f32x4 f[2];
#pragma unroll
                for (int n = 0; n < 2; ++n) { const f32x4 g = acc[ai][0][m][n], r1 = rot(g, i1), r2 = rot(g, i2);
                    f32x4 p1, p2;
#pragma unroll
                    for (int e = 0; e < 4; ++e) { p1[e] = (fr >= 1) ? r1[e] : c1[n][e]; p2[e] = (fr >= 2) ? r2[e] : c2[n][e]; }
                    c1[n] = r1; c2[n] = r2;
                    f[n] = silu_mul4(((w0[n] * p2 + w1[n] * p1) + w2[n] * g) + bb[n], acc[ai][1][m][n]); }
                st16nt(F + (size_t)row * 11008 + c0, pack8(f[0], f[1]));
                if (ai == 0 && m == 0 && wr == 0 && fr < 2) {
#pragma unroll
                    for (int n = 0; n < 2; ++n) { st16f(sideG + ((size_t)pm * 4 + fr) * 11008 + c0 + 4 * n, acc[0][0][0][n]); st16f(sideU + ((size_t)pm * 2 + fr) * 11008 + c0 + 4 * n, acc[0][1][0][n]); } }
                if (ai == 1 && m == 3 && wr == 1 && fr >= 14) {
#pragma unroll
                    for (int n = 0; n < 2; ++n) { st16f(sideG + ((size_t)pm * 4 + 2 + (fr - 14)) * 11008 + c0 + 4 * n, acc[1][0][3][n]);
                        if (winp) st16f(out + O_PF + ((size_t)(row >> 11) * 2 + (fr - 14)) * 11008 + c0 + 4 * n, acc[1][0][3][n]); } }
            }
        }
    }
};

struct EpiSlab {
    static constexpr bool PERM = true, AFTER_DRAIN = false, MIDK = false;
    float* slab; int np;
    __device__ __forceinline__ void mid(f32x4 (&)[2][2][4][2], const Unit&, int, int, int, int) const {}
    __device__ __forceinline__ void operator()(const f32x4 (&acc)[2][2][4][2], const Unit& u, int wr, int wc, int fr, int fq) const {
        const int sl = (8 * (u.kn & 0xffff) + np - 1) / np;
        float* sp = slab + ((size_t)sl * 128 + wr * 64 + fr) * 4096 + u.pn * BM + wc * 32 + 8 * fq;
#pragma unroll
        for (int m = 0; m < 4; ++m)
#pragma unroll
            for (int bj = 0; bj < 2; ++bj) { st16f(sp + (size_t)(m * 16) * 4096 + bj * HALF, acc[0][bj][m][0]); st16f(sp + (size_t)(m * 16) * 4096 + bj * HALF + 4, acc[0][bj][m][1]); }
    }
};
struct EpiNull {
    static constexpr bool PERM = true, AFTER_DRAIN = false, MIDK = false;
    float* sink;
    __device__ __forceinline__ void mid(f32x4 (&)[2][2][4][2], const Unit&, int, int, int, int) const {}
    __device__ __forceinline__ void operator()(const f32x4 (&acc)[2][2][4][2], const Unit& u, int wr, int wc, int fr, int fq) const {
        f32x4 s = acc[0][0][0][0];
#pragma unroll
        for (int ai = 0; ai < 2; ++ai)
#pragma unroll
            for (int bj = 0; bj < 2; ++bj)
#pragma unroll
                for (int m = 0; m < 4; ++m)
#pragma unroll
                    for (int n = 0; n < 2; ++n) s += acc[ai][bj][m][n];
        if (s[0] == 123456.789f && s[1] == 1.f && s[2] == 2.f && s[3] == 3.f) *(PG8_GAS float*)sink = s[0];
    }
};
template <class Epi, class Sched, bool ALIGN_EPI = false, bool SP2 = false, bool TA = false, bool TB = false, bool BNT = false, bool VARK = false, bool SKIP32 = false>
__device__ __forceinline__ void gemm_phase(PG8_LAS unsigned char* lds, const Gemm g, const Sched& S, const Epi& E) {
    int tid_ = threadIdx.x; asm volatile("" : "+v"(tid_));
    const int tid = tid_, wid = __builtin_amdgcn_readfirstlane(tid >> 6), lane = tid & 63, wr = wid >> 2, wc = wid & 3, fr = lane & 15, fq = lane >> 4;
    const int K = g.K, nt = K / BK;
    unsigned voffA[2], voffB[2];
#pragma unroll
    for (int i = 0; i < 2; ++i) { int R, C; stage_rc(tid * 16 + i * 8192, R, C); const int Rb = Epi::PERM ? ((R & ~31) + perm32(R & 31)) : R;
        voffA[i] = (unsigned)(R * (TA ? BK : K) + C) * 2u; voffB[i] = (unsigned)(Rb * (TB ? BK : K) + C) * 2u; }
    const size_t kstepA = TA ? (size_t)BM * BK * 2 : (size_t)(BK * 2), kstepB = TB ? (size_t)BM * BK * 2 : (size_t)(BK * 2);
    const size_t hstepA = TA ? (size_t)HALF * BK * 2 : (size_t)HALF * K * 2, hstepB = TB ? (size_t)HALF * BK * 2 : (size_t)HALF * K * 2;
    const size_t tstepA = (size_t)BM * K * 2, tstepB = (size_t)BM * K * 2;
    const unsigned ldsw = (unsigned)wid * 1024u;
    const int aoff = lds_byte(wr * 64 + fr, fq * 8), boff = lds_byte(wc * 32 + fr, fq * 8);
#define PG8_SA(b, h) (((b) * 2 + (h)) * HTB)
#define PG8_SB(b, h) ((4 + (b) * 2 + (h)) * HTB)
#define PG8_STAGE(bufoff, gbase, voff) do { _Pragma("unroll") for (int _i = 0; _i < 2; ++_i) \
        __builtin_amdgcn_global_load_lds((const unsigned*)((const char*)(gbase) + (voff)[_i]), (PG8_LAS unsigned*)(lds + (bufoff) + ldsw + _i * 8192), 16, 0, 0); } while (0)
#define PG8_STAGEB(bufoff, gbase, voff) do { if constexpr (BNT) { _Pragma("unroll") for (int _i = 0; _i < 2; ++_i) \
        __builtin_amdgcn_global_load_lds((const unsigned*)((const char*)(gbase) + (voff)[_i]), (PG8_LAS unsigned*)(lds + (bufoff) + ldsw + _i * 8192), 16, 0, 2); } else PG8_STAGE(bufoff, gbase, voff); } while (0)
#define PG8_LDA(dst, b, h) do { _Pragma("unroll") for (int m = 0; m < 4; ++m) _Pragma("unroll") for (int k = 0; k < 2; ++k) dst[m][k] = *(const PG8_LAS bf16x8*)(lds + PG8_SA(b, h) + aoff + m * 2048 + k * 1024); } while (0)
#define PG8_LDB(dst, b, h) do { _Pragma("unroll") for (int n = 0; n < 2; ++n) _Pragma("unroll") for (int k = 0; k < 2; ++k) dst[n][k] = *(const PG8_LAS bf16x8*)(lds + PG8_SB(b, h) + boff + n * 2048 + k * 1024); } while (0)
#ifdef PG8_STATIC_PRIO
#define PG8_MMA(ai, bj, At, Bt) do { _Pragma("unroll") for (int m = 0; m < 4; ++m) _Pragma("unroll") for (int n = 0; n < 2; ++n) _Pragma("unroll") for (int k = 0; k < 2; ++k) \
        acc[ai][bj][m][n] = __builtin_amdgcn_mfma_f32_16x16x32_bf16(Bt[n][k], At[m][k], acc[ai][bj][m][n], 0, 0, 0); } while (0)
#else
#define PG8_MMA(ai, bj, At, Bt) do { __builtin_amdgcn_s_setprio(1); _Pragma("unroll") for (int m = 0; m < 4; ++m) _Pragma("unroll") for (int n = 0; n < 2; ++n) _Pragma("unroll") for (int k = 0; k < 2; ++k) \
        acc[ai][bj][m][n] = __builtin_amdgcn_mfma_f32_16x16x32_bf16(Bt[n][k], At[m][k], acc[ai][bj][m][n], 0, 0, 0); __builtin_amdgcn_s_setprio(0); } while (0)
#endif
#define PG8_WAIT_V(n) asm volatile("s_waitcnt vmcnt(" #n ")" ::: "memory")
#define PG8_WAIT_L(n) asm volatile("s_waitcnt lgkmcnt(" #n ")" ::: "memory")
#define PG8_BAR __builtin_amdgcn_s_barrier()
#define PG8_SCHED __builtin_amdgcn_sched_barrier(0)
    Unit cur, nxt; int ui = 0;
    if (!S.next(0, cur)) return;
#ifdef PG8_STATIC_PRIO
    if (wr == 1) __builtin_amdgcn_s_setprio(1);
#endif
    f32x4 acc[2][2][4][2];
#pragma unroll
    for (int a = 0; a < 2; ++a)
#pragma unroll
        for (int b = 0; b < 2; ++b)
#pragma unroll
            for (int m = 0; m < 4; ++m)
#pragma unroll
                for (int n = 0; n < 2; ++n) acc[a][b][m][n] = (f32x4){0.f, 0.f, 0.f, 0.f};
    bf16x8 At[4][2], B0[2][2], B1[2][2];
    const char* cA = (const char*)g.A + (size_t)cur.pm * tstepA + (VARK ? (size_t)(cur.kn & 0xffff) * kstepA : (size_t)0); const char* cB = (const char*)g.Bt + (size_t)cur.pn * tstepB + (VARK ? (size_t)(cur.kn & 0xffff) * kstepB : (size_t)0);
    S.a_ready(cur);
    if constexpr (SP2) {
        PG8_STAGEB(PG8_SB(0, 0), cB, voffB); PG8_STAGEB(PG8_SB(0, 1), cB + hstepB, voffB); PG8_STAGE(PG8_SA(0, 0), cA, voffA); PG8_STAGE(PG8_SA(0, 1), cA + hstepA, voffA);
        if (wr == 1) PG8_BAR;
        PG8_WAIT_V(2); PG8_BAR;
        PG8_STAGEB(PG8_SB(1, 0), cB + kstepB, voffB); PG8_STAGE(PG8_SA(1, 0), cA + kstepA, voffA); PG8_STAGEB(PG8_SB(1, 1), cB + hstepB + kstepB, voffB);
        PG8_WAIT_V(6); PG8_BAR;
    } else {
        PG8_STAGEB(PG8_SB(0, 0), cB, voffB); PG8_STAGE(PG8_SA(0, 0), cA, voffA); PG8_STAGEB(PG8_SB(0, 1), cB + hstepB, voffB); PG8_STAGE(PG8_SA(0, 1), cA + hstepA, voffA);
        if (wr == 1) PG8_BAR;
        PG8_WAIT_V(4); PG8_BAR;
        PG8_STAGEB(PG8_SB(1, 0), cB + kstepB, voffB); PG8_STAGE(PG8_SA(1, 0), cA + kstepA, voffA); PG8_STAGEB(PG8_SB(1, 1), cB + hstepB + kstepB, voffB);
        PG8_WAIT_V(6); PG8_BAR;
    }
    for (;;) {
        const bool has_next = S.next(ui + 1, nxt);
        const char* nA = has_next ? (const char*)g.A + (size_t)nxt.pm * tstepA + (VARK ? (size_t)(nxt.kn & 0xffff) * kstepA : (size_t)0) : cA; const char* nB = has_next ? (const char*)g.Bt + (size_t)nxt.pn * tstepB + (VARK ? (size_t)(nxt.kn & 0xffff) * kstepB : (size_t)0) : cB;
        const int ntu = VARK ? (cur.kn >> 16) : nt;
        const bool fullm = !(VARK || SKIP32) || cur.pm < 32;
        for (int t = 0; t < ntu; t += 2) {
            if constexpr (Epi::MIDK) { if (t == (nt >> 1)) E.mid(acc, cur, wr, wc, fr, fq); }
            const bool last = (t == ntu - 2);
            const char* a1 = cA + (size_t)(t + 1) * kstepA;
            const char* a2 = last ? nA : cA + (size_t)(t + 2) * kstepA; const char* b2 = last ? nB : cB + (size_t)(t + 2) * kstepB;
            const char* a3 = a2 + kstepA; const char* b3 = b2 + kstepB;
            if (last && has_next) S.a_ready(nxt);
            if constexpr (SP2) {
            PG8_LDB(B0, 0, 0); PG8_LDB(B1, 0, 1); PG8_SCHED; PG8_LDA(At, 0, 0); PG8_STAGE(PG8_SA(1, 1), a1 + hstepA, voffA);
            PG8_WAIT_V(8); PG8_WAIT_L(0); PG8_BAR; PG8_MMA(0, 0, At, B0); PG8_MMA(0, 1, At, B1); PG8_BAR; PG8_SCHED;
            PG8_LDA(At, 0, 1); PG8_STAGEB(PG8_SB(0, 0), b2, voffB); PG8_STAGEB(PG8_SB(0, 1), b2 + hstepB, voffB); PG8_STAGE(PG8_SA(0, 0), a2, voffA);
            PG8_WAIT_V(8); PG8_WAIT_L(0); PG8_BAR; if (fullm) { PG8_MMA(1, 0, At, B0); PG8_MMA(1, 1, At, B1); } PG8_BAR; PG8_SCHED;
            PG8_LDB(B0, 1, 0); PG8_LDB(B1, 1, 1); PG8_SCHED; PG8_LDA(At, 1, 0); PG8_STAGE(PG8_SA(0, 1), a2 + hstepA, voffA);
            PG8_WAIT_V(8); PG8_WAIT_L(0); PG8_BAR; PG8_MMA(0, 0, At, B0); PG8_MMA(0, 1, At, B1); PG8_BAR; PG8_SCHED;
            PG8_LDA(At, 1, 1); PG8_STAGEB(PG8_SB(1, 0), b3, voffB); PG8_STAGEB(PG8_SB(1, 1), b3 + hstepB, voffB); PG8_STAGE(PG8_SA(1, 0), a3, voffA);
            PG8_WAIT_V(8); PG8_WAIT_L(0); PG8_BAR; if (fullm) { PG8_MMA(1, 0, At, B0); PG8_MMA(1, 1, At, B1); } PG8_BAR; PG8_SCHED;
            } else {
            PG8_LDB(B0, 0, 0); PG8_SCHED; PG8_LDA(At, 0, 0); PG8_STAGE(PG8_SA(1, 1), a1 + hstepA, voffA);
            PG8_WAIT_L(8); PG8_BAR; PG8_WAIT_L(0); PG8_MMA(0, 0, At, B0); PG8_BAR; PG8_SCHED;
            PG8_LDB(B1, 0, 1); PG8_STAGEB(PG8_SB(0, 0), b2, voffB);
            PG8_BAR; PG8_WAIT_L(0); PG8_MMA(0, 1, At, B1); PG8_BAR;
            PG8_LDA(At, 0, 1); PG8_STAGE(PG8_SA(0, 0), a2, voffA);
            PG8_BAR; PG8_WAIT_L(0); PG8_MMA(1, 0, At, B0); PG8_BAR; PG8_SCHED;
            PG8_STAGEB(PG8_SB(0, 1), b2 + hstepB, voffB);
            PG8_WAIT_V(6); PG8_BAR; PG8_MMA(1, 1, At, B1); PG8_BAR;
            PG8_LDB(B0, 1, 0); PG8_SCHED; PG8_LDA(At, 1, 0); PG8_STAGE(PG8_SA(0, 1), a2 + hstepA, voffA);
            PG8_WAIT_L(8); PG8_BAR; PG8_WAIT_L(0); PG8_MMA(0, 0, At, B0); PG8_BAR; PG8_SCHED;
            PG8_LDB(B1, 1, 1); PG8_STAGEB(PG8_SB(1, 0), b3, voffB);
            PG8_BAR; PG8_WAIT_L(0); PG8_MMA(0, 1, At, B1); PG8_BAR;
            PG8_LDA(At, 1, 1); PG8_STAGE(PG8_SA(1, 0), a3, voffA);
            PG8_BAR; PG8_WAIT_L(0); PG8_MMA(1, 0, At, B0); PG8_BAR; PG8_SCHED;
            PG8_STAGEB(PG8_SB(1, 1), b3 + hstepB, voffB);
            PG8_WAIT_V(6); PG8_BAR; PG8_MMA(1, 1, At, B1); PG8_BAR;
            }
        }
        if constexpr (ALIGN_EPI) { if (wr == 0) PG8_BAR; }
        if constexpr (!Epi::AFTER_DRAIN) { E(acc, cur, wr, wc, fr, fq); S.done(cur); }
        if (!has_next) break;
#pragma unroll
        for (int a = 0; a < 2; ++a)
#pragma unroll
            for (int b = 0; b < 2; ++b)
#pragma unroll
                for (int m = 0; m < 4; ++m)
#pragma unroll
                    for (int n = 0; n < 2; ++n) acc[a][b][m][n] = (f32x4){0.f, 0.f, 0.f, 0.f};
        cur = nxt; cA = nA; cB = nB; ++ui;
        if constexpr (ALIGN_EPI) { if (wr == 1) PG8_BAR; }
    }
#ifdef PG8_STATIC_PRIO
    __builtin_amdgcn_s_setprio(0);
#endif
    PG8_WAIT_V(0);
    if constexpr (!ALIGN_EPI) { if (wr == 0) PG8_BAR; }
    PG8_BAR;
    if constexpr (Epi::AFTER_DRAIN) { E.fused(acc, cur, wr, wc, fr, fq, lds, wid, lane); S.done(cur); }
#undef PG8_SA
#undef PG8_SB
#undef PG8_STAGE
#undef PG8_STAGEB
#undef PG8_LDA
#undef PG8_LDB
#undef PG8_MMA
#undef PG8_WAIT_V
#undef PG8_WAIT_L
#undef PG8_BAR
#undef PG8_SCHED
}
}
#define GAS __attribute__((address_space(1)))
#define LAS __attribute__((address_space(3)))
typedef unsigned short bf16;
typedef unsigned v4u __attribute__((ext_vector_type(4)));
typedef float f32x4 __attribute__((ext_vector_type(4)));
typedef short bf16x8 __attribute__((ext_vector_type(8)));
typedef GAS unsigned gu32;
typedef GAS unsigned long long gu64;
#define RLX_AGENT __ATOMIC_RELAXED, __HIP_MEMORY_SCOPE_AGENT
#define LDS_WAIT() asm volatile("s_waitcnt lgkmcnt(0)" ::: "memory")
#define VM_WAIT() asm volatile("s_waitcnt vmcnt(0)" ::: "memory")
__device__ __forceinline__ unsigned long long rt() { return __builtin_amdgcn_s_memrealtime(); }
__device__ __forceinline__ unsigned f2bf(float f) { unsigned u = __builtin_bit_cast(unsigned, f); return (u + 0x7fffu + ((u >> 16) & 1u)) >> 16; }
__device__ __forceinline__ unsigned pk2(float lo, float hi) { return f2bf(lo) | (f2bf(hi) << 16); }

#define XB_TMO      128
#define XB_XCNT(j)  (256  + 64 * (j))
#define XB_XSUB(j)  (1280 + 64 * (j))
#define XB_XGEN(j)  (2304 + 64 * (j))
#define XB_TOP      3328
#define XB_TOPGEN   3392
#define XCD_BAR_WORDS 3456
#define XB_SPIN_CAP (1u << 18)

__device__ __forceinline__ unsigned xb_ld(unsigned* p)              { return __hip_atomic_load(p, __ATOMIC_RELAXED, __HIP_MEMORY_SCOPE_AGENT); }
__device__ __forceinline__ unsigned xb_add(unsigned* p, unsigned v) { return __hip_atomic_fetch_add(p, v, __ATOMIC_RELAXED, __HIP_MEMORY_SCOPE_AGENT); }
__device__ __forceinline__ unsigned xb_xcc_id() { return (unsigned)__builtin_amdgcn_s_getreg((3 << 11) | 20) & 0xFu; }
#define XB_SPIN(cond, bar) do { unsigned _sp = 0; while (cond) { __builtin_amdgcn_s_sleep(1); \
    if ((++_sp & 255u) == 0u) { if (xb_ld(&(bar)[XB_TMO])) break; if (_sp > XB_SPIN_CAP) { atomicAdd(&(bar)[XB_TMO], 1u); break; } } } } while (0)

struct XcdBarrier {
    unsigned* bar; unsigned x;
    volatile LAS unsigned* st;
};

__device__ __forceinline__ XcdBarrier xcd_barrier_post(unsigned* bar, volatile LAS unsigned* st) {
    XcdBarrier b; b.bar = bar; b.x = xb_xcc_id(); b.st = st;
    if (threadIdx.x == 0) (void)xb_add(&bar[XB_XCNT(b.x)], 1u);
    return b;
}
__device__ __forceinline__ void xcd_barrier_complete(unsigned* bar, unsigned x, unsigned& nloc, unsigned& nx) {
    const unsigned G = gridDim.x * gridDim.y * gridDim.z;
    unsigned sum, cnt, mine, sp = 0u;
    for (;;) {
        sum = 0u; cnt = 0u; mine = 0u;
#pragma unroll
        for (unsigned j = 0; j < 16; ++j) { const unsigned c = xb_ld(&bar[XB_XCNT(j)]); sum += c; cnt += (c > 0u) ? 1u : 0u; mine = (j == x) ? c : mine; }
        if (sum == G) break;
        __builtin_amdgcn_s_sleep(1);
        if ((++sp & 255u) == 0u) { if (xb_ld(&bar[XB_TMO])) break; if (sp > XB_SPIN_CAP) { atomicAdd(&bar[XB_TMO], 1u); break; } }
    }
    nloc = mine > 0u ? mine : 1u; nx = cnt > 0u ? cnt : 1u;
}

__device__ __forceinline__ void xcd_barrier(const XcdBarrier& b) {
    asm volatile("s_waitcnt vmcnt(0)" ::: "memory");
    __syncthreads();
    if (threadIdx.x == 0) {
        unsigned* bar = b.bar;
        __builtin_amdgcn_s_waitcnt(0);
        unsigned nloc = b.st[0], nx = b.st[1];
        if (nloc == 0u) { xcd_barrier_complete(bar, b.x, nloc, nx); b.st[0] = nloc; b.st[1] = nx; }
        const unsigned old = xb_add(&bar[XB_XSUB(b.x)], 1u);
        const unsigned gen = old / nloc;
        if (old + 1u == (gen + 1u) * nloc) {
            __builtin_amdgcn_fence(__ATOMIC_RELEASE, "agent");
            asm volatile("s_waitcnt vmcnt(0)" ::: "memory");
            const unsigned og = xb_add(&bar[XB_TOP], 1u);
            const unsigned tg = og / nx;
            if (og + 1u == (tg + 1u) * nx) xb_add(&bar[XB_TOPGEN], 1u);
            else XB_SPIN(xb_ld(&bar[XB_TOPGEN]) == tg, bar);
            __builtin_amdgcn_fence(__ATOMIC_ACQUIRE, "agent");
            xb_add(&bar[XB_XGEN(b.x)], 1u);
            asm volatile("s_waitcnt vmcnt(0)" ::: "memory");
        } else {
            XB_SPIN(xb_ld(&bar[XB_XGEN(b.x)]) == gen, bar);
            __builtin_amdgcn_fence(__ATOMIC_ACQUIRE, "agent");
            asm volatile("s_waitcnt vmcnt(0)" ::: "memory");
        }
    }
    __syncthreads();
}


constexpr int NWAVES = 8;
constexpr int DM = 4096, SEQ = 2048, CONVW = 2048, KVW = 512, DFF = 11008, INW = 17408;
constexpr int ROWS_P = pg8::ROWS_P, ROWS_R = pg8::ROWS_R, MPAD = pg8::ROWS_PAD;
constexpr float EPS = 1e-5f, LOG2E = 1.4426950408889634f;
using pg8::O_YP; using pg8::O_YS; using pg8::O_SK; using pg8::O_SV; using pg8::O_SC; using pg8::O_SF; using pg8::O_END;

constexpr size_t MiB = 1u << 20;
constexpr size_t WS_CTL = 0, CTL_ZERO_BYTES = 1 * MiB;
constexpr size_t WS_WGU = 1 * MiB;
constexpr size_t WS_WD  = WS_WGU + (size_t)2 * DFF * DM * 2;
constexpr size_t WS_XN  = WS_WD + (size_t)DM * DFF * 2;
constexpr size_t WS_X1  = WS_XN + (size_t)MPAD * DM * 2;
constexpr size_t WS_A   = WS_X1 + (size_t)MPAD * DM * 4;
constexpr size_t WS_WIN = WS_A;
constexpr size_t WS_WAB = WS_WIN + (size_t)INW * DM * 2;
constexpr size_t WS_WO  = WS_WAB + (size_t)DM * DM * 2;
constexpr size_t WS_CB  = WS_WO + (size_t)DM * DM * 2;
constexpr size_t WS_UU  = WS_CB + (size_t)MPAD * 2048 * 2;
constexpr size_t WS_Q   = WS_UU + (size_t)MPAD * 2048 * 2;
constexpr size_t WS_K   = WS_Q + (size_t)MPAD * 2048 * 2;
constexpr size_t WS_VT  = WS_K + (size_t)MPAD * 512 * 2;
constexpr size_t WS_RAT = WS_VT + (size_t)MPAD * 512 * 2;
constexpr size_t WS_SGB = WS_RAT + (size_t)MPAD * DM * 2;
constexpr size_t WS_AO  = WS_SGB + (size_t)MPAD * DM * 2;
constexpr size_t WS_MG  = WS_AO + (size_t)MPAD * DM * 2;
constexpr size_t WS_A_END = WS_MG + (size_t)MPAD * DM * 2;
constexpr size_t WS_G   = WS_A;
constexpr size_t WS_U   = WS_G + (size_t)MPAD * DFF * 2;
constexpr size_t WS_F   = WS_U + (size_t)MPAD * DFF * 2;
constexpr size_t WS_OV_END = WS_F + (size_t)MPAD * DFF * 2;
constexpr size_t WS_SIDEG = WS_A_END > WS_OV_END ? WS_A_END : WS_OV_END;
constexpr size_t WS_SIDEU = WS_SIDEG + (size_t)32 * 4 * DFF * 4;
constexpr size_t WS_PART1 = WS_SIDEU + (size_t)32 * 2 * DFF * 4;
constexpr size_t WS_PART2 = WS_PART1 + (size_t)ROWS_P * 256 * 4;
constexpr size_t WS_RSTAT = WS_PART2 + (size_t)ROWS_P * 256 * 4;
constexpr size_t WS_END = WS_RSTAT + (size_t)MPAD * 4;
constexpr size_t WS_SLAB4 = WS_WIN;
constexpr size_t WS_SLAB = WS_XN;
constexpr int CW_BAR = 4096;
static_assert((CW_BAR + XCD_BAR_WORDS) * 4 <= (int)CTL_ZERO_BYTES, "control words inside the memset region");

constexpr int RING_OFF = 0, RING_BYTES = 131072;
constexpr int LDSCTL_OFF = RING_BYTES, MISC_OFF = LDSCTL_OFF + 320;
constexpr int LDS_BYTES = 147456;
static_assert(MISC_OFF + 128 <= LDS_BYTES, "LDS map");
constexpr int XCH_OFF = LDSCTL_OFF + 1024;
static_assert(XCH_OFF + 8192 <= LDS_BYTES, "LDS map");
constexpr int BIAS_LD = 132;
constexpr int SCR_OFF = 20480, SCR_WAVE = 4096;

typedef float f32x16 __attribute__((ext_vector_type(16)));
typedef short s16x4 __attribute__((ext_vector_type(4)));
typedef unsigned v2u __attribute__((ext_vector_type(2)));
__device__ __forceinline__ float blo(unsigned w) { return __uint_as_float(w << 16); }
__device__ __forceinline__ float bhi(unsigned w) { return __uint_as_float(w & 0xffff0000u); }
__device__ __forceinline__ void unpack8(const v4u w, float (&f)[8]) { f[0] = blo(w.x); f[1] = bhi(w.x); f[2] = blo(w.y); f[3] = bhi(w.y); f[4] = blo(w.z); f[5] = bhi(w.z); f[6] = blo(w.w); f[7] = bhi(w.w); }
__device__ __forceinline__ v4u ldg16(const void* p) { return *(const GAS v4u*)p; }
__device__ __forceinline__ f32x4 ldg4f(const float* p) { return *(const GAS f32x4*)p; }
__device__ __forceinline__ void ld8f(const float* p, float (&f)[8]) { const f32x4 a = ldg4f(p), b = ldg4f(p + 4); f[0] = a[0]; f[1] = a[1]; f[2] = a[2]; f[3] = a[3]; f[4] = b[0]; f[5] = b[1]; f[6] = b[2]; f[7] = b[3]; }
__device__ __forceinline__ void st8f(float* p, const float (&f)[8]) { *(GAS f32x4*)p = (f32x4){f[0], f[1], f[2], f[3]}; *(GAS f32x4*)(p + 4) = (f32x4){f[4], f[5], f[6], f[7]}; }
__device__ __forceinline__ unsigned cvtpk(float lo, float hi) { return pg8::cvt_pk_bf16(lo, hi); }
__device__ __forceinline__ float ex2(float x) { return __builtin_amdgcn_exp2f(x); }
__device__ __forceinline__ float wave_sum(float v) {
#pragma unroll
    for (int o = 1; o < 64; o <<= 1) v += __shfl_xor(v, o);
    return v;
}
__device__ __forceinline__ float wave_max(float v) {
#pragma unroll
    for (int o = 1; o < 64; o <<= 1) v = fmaxf(v, __shfl_xor(v, o));
    return v;
}

struct P0Ref { const float* src; bf16* dst; int N; };
__device__ __forceinline__ void p0_load(const P0Ref& r, f32x4 (&v)[8], int lane) {
#pragma unroll
#ifdef P0_PLAIN_LOADS
    for (int i = 0; i < 8; ++i) v[i] = *(const GAS f32x4*)(r.src + (size_t)(8 * i + (lane >> 3)) * r.N + 4 * (lane & 7));
#else
    for (int i = 0; i < 8; ++i) v[i] = __builtin_nontemporal_load((const GAS f32x4*)(r.src + (size_t)(8 * i + (lane >> 3)) * r.N + 4 * (lane & 7)));
#endif
}
__device__ __forceinline__ void p0_store(const P0Ref& r, const f32x4 (&v)[8], LAS float* scr, int lane) {
#pragma unroll
    for (int i = 0; i < 8; ++i) { LAS float* w = scr + (8 * i + (lane >> 3)) * 33 + 4 * (lane & 7); w[0] = v[i][0]; w[1] = v[i][1]; w[2] = v[i][2]; w[3] = v[i][3]; }
    LDS_WAIT(); asm volatile("" ::: "memory");
    const int c = lane & 7;
#pragma unroll
    for (int j = 0; j < 4; ++j) { const int n = (lane >> 3) + 8 * j; const LAS float* q = scr + (8 * c) * 33 + n;
        v4u o; o.x = cvtpk(q[0 * 33], q[1 * 33]); o.y = cvtpk(q[2 * 33], q[3 * 33]); o.z = cvtpk(q[4 * 33], q[5 * 33]); o.w = cvtpk(q[6 * 33], q[7 * 33]);
        *(GAS v4u*)(r.dst + (size_t)n * 64 + 8 * c) = o; }
    LDS_WAIT(); asm volatile("" ::: "memory");
}
__host__ __device__ __forceinline__ int win_map(int n) {
    if (n < 2048) return n;
    if (n < 6144) { int t = n - 2048; const int h = t >= 2048 ? 1 : 0; t -= h * 2048; return 2048 + (t >> 7) * 256 + h * 128 + (t & 127); }
    if (n < 9216) return n;
    int t = n - 9216; const int h = t >= 4096 ? 1 : 0; t -= h * 4096; return 9216 + (t >> 7) * 256 + h * 128 + (t & 127);
}
__host__ __device__ __forceinline__ size_t tiled_off(int n, int kt, int nt) { return ((size_t)(n >> 8) * nt + kt) * 16384 + (size_t)(n & 255) * 64; }
__device__ __forceinline__ void load_gain(const float* g, f32x4 (&gv)[16], int lane) {
    const GAS f32x4* gr = (const GAS f32x4*)g + lane;
#pragma unroll
    for (int j = 0; j < 16; ++j) gv[j] = gr[64 * j];
}
template <bool OUT_BF16, bool TILED = false> __device__ __forceinline__ void rms_row(const float* xrow, const f32x4 (&gv)[16], void* orow, int lane) {
    const GAS f32x4* xr = (const GAS f32x4*)xrow + lane;
    f32x4 v[16]; float s = 0.f;
#pragma unroll
    for (int j = 0; j < 16; ++j) { v[j] = xr[64 * j]; s += (v[j].x * v[j].x + v[j].y * v[j].y) + (v[j].z * v[j].z + v[j].w * v[j].w); }
    const float r = 1.0f / sqrtf(wave_sum(s) * (1.0f / DM) + EPS);
#pragma unroll
    for (int j = 0; j < 16; ++j) { const f32x4 y = (v[j] * r) * gv[j];
        if (OUT_BF16) { v2u w; w.x = cvtpk(y.x, y.y); w.y = cvtpk(y.z, y.w);
            if (TILED) { const int c = 4 * (lane + 64 * j); *(GAS v2u*)((bf16*)orow + (size_t)(c >> 6) * 16384 + (c & 63)) = w; } else ((GAS v2u*)orow)[lane + 64 * j] = w; }
        else ((GAS f32x4*)orow)[lane + 64 * j] = y; }
}

__device__ __forceinline__ void load_row(const float* xrow, f32x4 (&v)[16], int lane) {
    const GAS f32x4* xr = (const GAS f32x4*)xrow + lane;
#pragma unroll
    for (int j = 0; j < 16; ++j) v[j] = __builtin_nontemporal_load(xr + 64 * j);
}
__device__ __forceinline__ void rms_row_pre_tiled(const f32x4 (&v)[16], const f32x4 (&gv)[16], bf16* orow, int lane) {
    float s = 0.f;
#pragma unroll
    for (int j = 0; j < 16; ++j) s += (v[j].x * v[j].x + v[j].y * v[j].y) + (v[j].z * v[j].z + v[j].w * v[j].w);
    const float r = 1.0f / sqrtf(wave_sum(s) * (1.0f / DM) + EPS);
#pragma unroll
    for (int j = 0; j < 16; ++j) { const f32x4 y = (v[j] * r) * gv[j]; v2u w; w.x = cvtpk(y.x, y.y); w.y = cvtpk(y.z, y.w); const int c = 4 * (lane + 64 * j);
        *(GAS v2u*)(orow + (size_t)(c >> 6) * 16384 + (c & 63)) = w; }
}
__device__ __forceinline__ void rms_raw_row(const float* xrow, const f32x4 (&gv)[16], bf16* orow, float* rstat, int lane) {
    const GAS f32x4* xr = (const GAS f32x4*)xrow + lane;
    f32x4 v[16]; float s = 0.f;
#pragma unroll
    for (int j = 0; j < 16; ++j) { v[j] = xr[64 * j]; s += (v[j].x * v[j].x + v[j].y * v[j].y) + (v[j].z * v[j].z + v[j].w * v[j].w); }
    const float r = 1.0f / sqrtf(wave_sum(s) * (1.0f / DM) + EPS);
    if (lane == 0) *(GAS float*)rstat = r;
#pragma unroll
    for (int j = 0; j < 16; ++j) { const f32x4 y = v[j] * gv[j]; v2u w; w.x = cvtpk(y.x, y.y); w.y = cvtpk(y.z, y.w); const int c = 4 * (lane + 64 * j);
        *(GAS v2u*)(orow + (size_t)(c >> 6) * 16384 + (c & 63)) = w; }
}
__device__ __forceinline__ float row16_sum(float v) {
    v += __builtin_bit_cast(float, __builtin_amdgcn_update_dpp(0, __builtin_bit_cast(int, v), 0xB1, 0xF, 0xF, false));
    v += __builtin_bit_cast(float, __builtin_amdgcn_update_dpp(0, __builtin_bit_cast(int, v), 0x4E, 0xF, 0xF, false));
    v += __builtin_bit_cast(float, __builtin_amdgcn_update_dpp(0, __builtin_bit_cast(int, v), 0x141, 0xF, 0xF, false));
    v += __builtin_bit_cast(float, __builtin_amdgcn_update_dpp(0, __builtin_bit_cast(int, v), 0x140, 0xF, 0xF, false));
    return v;
}
__device__ __forceinline__ int crow(int r, int hi) { return (r & 3) + 8 * (r >> 2) + 4 * hi; }
__device__ __forceinline__ void attn_prompt_task(int t, const bf16* Q, const bf16* KB, const bf16* VT, bf16* AO, const float* sinks, const LAS float* biasT, int lane) {
    const int g = t & 3, i32 = (t >> 2) & 63, kvh = (t >> 8) & 7, b = t >> 11, head = kvh * 4 + g;
    const int r32 = lane & 31, hi = lane >> 5;
    const int rowbase = b * SEQ, t0 = i32 * 32;
    const int kb_lo = (t0 >= 128) ? 0 : ((128 - t0) >> 5);
    bf16x8 qf[4];
    { const bf16* qp = Q + (size_t)(rowbase + t0 + r32) * 2048 + head * 64 + hi * 8;
#pragma unroll
      for (int ks = 0; ks < 4; ++ks) qf[ks] = *(const GAS bf16x8*)(qp + ks * 16); }
    f32x16 s[5];
    bf16x8 kf[5][4];
#pragma unroll
    for (int kb = 0; kb < 5; ++kb) if (kb >= kb_lo) {
        const bf16* kp = KB + (size_t)(rowbase + t0 - 128 + 32 * kb + r32) * KVW + kvh * 64 + hi * 8;
#pragma unroll
        for (int ks = 0; ks < 4; ++ks) kf[kb][ks] = *(const GAS bf16x8*)(kp + ks * 16);
    }
#pragma unroll
    for (int kb = 0; kb < 5; ++kb) {
#pragma unroll
        for (int r = 0; r < 16; ++r) s[kb][r] = 0.f;
        if (kb >= kb_lo) {
#pragma unroll
            for (int ks = 0; ks < 4; ++ks) s[kb] = __builtin_amdgcn_mfma_f32_32x32x16_bf16(kf[kb][ks], qf[ks], s[kb], 0, 0, 0);
        }
    }
    __builtin_amdgcn_sched_barrier(0);
    v4u vv[5][2][2];
#pragma unroll
    for (int kb = 0; kb < 5; ++kb) if (kb >= kb_lo) {
#pragma unroll
        for (int sx = 0; sx < 2; ++sx) { const int tk = rowbase + t0 - 128 + 32 * kb + 16 * sx;
#pragma unroll
            for (int db = 0; db < 2; ++db) vv[kb][sx][db] = *(const GAS v4u*)(VT + (size_t)(kvh * 64 + db * 32 + r32) * MPAD + tk + 8 * hi); }
    }
    const LAS float* bt = biasT + head * BIAS_LD;
    const float sink = *(const GAS float*)(sinks + head);
    float mx = sink;
#pragma unroll
    for (int kb = 0; kb < 5; ++kb)
#pragma unroll
        for (int r = 0; r < 16; ++r) {
            const int dist = r32 + 128 - 32 * kb - crow(r, hi);
            const bool valid = (kb >= kb_lo) && dist >= 0 && dist <= 128;
            const int dc = dist < 0 ? 0 : (dist > 128 ? 128 : dist);
            float v = s[kb][r] * 0.125f + bt[dc];
            v = valid ? v : -INFINITY;
            s[kb][r] = v; mx = fmaxf(mx, v);
        }
    mx = fmaxf(mx, __shfl_xor(mx, 32));
    float sum = 0.f;
#pragma unroll
    for (int kb = 0; kb < 5; ++kb)
#pragma unroll
        for (int r = 0; r < 16; ++r) { const float e = ex2((s[kb][r] - mx) * LOG2E); s[kb][r] = e; sum += e; }
    sum += __shfl_xor(sum, 32);
    const float inv = 1.0f / (sum + ex2((sink - mx) * LOG2E));
    f32x16 o[2];
#pragma unroll
    for (int r = 0; r < 16; ++r) { o[0][r] = 0.f; o[1][r] = 0.f; }
#pragma unroll
    for (int kb = 0; kb < 5; ++kb) if (kb >= kb_lo) {
#pragma unroll
        for (int sx = 0; sx < 2; ++sx) {
            v4u pw; pw.x = cvtpk(s[kb][8 * sx + 0], s[kb][8 * sx + 1]); pw.y = cvtpk(s[kb][8 * sx + 2], s[kb][8 * sx + 3]); pw.z = cvtpk(s[kb][8 * sx + 4], s[kb][8 * sx + 5]); pw.w = cvtpk(s[kb][8 * sx + 6], s[kb][8 * sx + 7]);
            const bf16x8 pb = __builtin_bit_cast(bf16x8, pw);
#pragma unroll
            for (int db = 0; db < 2; ++db) {
                const v4u vw = vv[kb][sx][db];
                o[db] = __builtin_amdgcn_mfma_f32_32x32x16_bf16(__builtin_bit_cast(bf16x8, vw), pb, o[db], 0, 0, 0);
            }
        }
    }
    bf16* op = AO + (size_t)(rowbase + t0 + r32) * 4096 + 2048 + head * 64 + 4 * hi;
#pragma unroll
    for (int db = 0; db < 2; ++db)
#pragma unroll
        for (int rg = 0; rg < 4; ++rg) { v2u w; w.x = cvtpk(o[db][4 * rg] * inv, o[db][4 * rg + 1] * inv); w.y = cvtpk(o[db][4 * rg + 2] * inv, o[db][4 * rg + 3] * inv);
            *(GAS v2u*)(op + db * 32 + 8 * rg) = w; }
}
template <bool copy_win> __device__ __forceinline__ void attn_sample_task(int t, const bf16* Q, const float* sk, const float* sv, float* out, bf16* AO, const float* sinks, const LAS float* biasT, LAS float* sc, int lane) {
    const int kvh = t & 7, b = t >> 3;
    const int kq = lane >> 4, d4 = lane & 15;
    float qv[4][4];
#pragma unroll
    for (int g = 0; g < 4; ++g) { const v2u w = *(const GAS v2u*)(Q + (size_t)(ROWS_P + b) * 2048 + (kvh * 4 + g) * 64 + 4 * d4);
        qv[g][0] = blo(w.x) * 0.125f; qv[g][1] = bhi(w.x) * 0.125f; qv[g][2] = blo(w.y) * 0.125f; qv[g][3] = bhi(w.y) * 0.125f; }
    const size_t woff = (size_t)b * 128 * 512 + kvh * 64 + 4 * d4;
#pragma unroll 1
    for (int i0 = 0; i0 < 33; i0 += 17) {
        f32x4 kv[17];
#pragma unroll
        for (int u = 0; u < 17; ++u) { const int j = 4 * (i0 + u) + kq; kv[u] = (f32x4){0.f, 0.f, 0.f, 0.f};
            if (j < 128) kv[u] = __builtin_nontemporal_load((const GAS f32x4*)(sk + woff + (size_t)j * 512)); else if (j == 128) kv[u] = ldg4f(out + O_SK + woff + (size_t)127 * 512); }
#pragma unroll
        for (int u = 0; u < 17; ++u) { const int j = 4 * (i0 + u) + kq;
            if (copy_win && j >= 1 && j < 128) __builtin_nontemporal_store(kv[u], (GAS f32x4*)(out + O_SK + woff + (size_t)(j - 1) * 512));
#pragma unroll
            for (int g = 0; g < 4; ++g) { float p = (qv[g][0] * kv[u][0] + qv[g][1] * kv[u][1]) + (qv[g][2] * kv[u][2] + qv[g][3] * kv[u][3]);
                p = row16_sum(p);
                if (d4 == 0 && j <= 128) sc[g * BIAS_LD + j] = p + biasT[(kvh * 4 + g) * BIAS_LD + (128 - j)]; } }
    }
    asm volatile("s_waitcnt lgkmcnt(0)" ::: "memory");
    float inv[4];
#pragma unroll
    for (int g = 0; g < 4; ++g) {
        const float sink = *(const GAS float*)(sinks + kvh * 4 + g);
        const float v0 = sc[g * BIAS_LD + lane], v1 = sc[g * BIAS_LD + 64 + lane], v2 = (lane == 0) ? sc[g * BIAS_LD + 128] : -INFINITY;
        const float m = fmaxf(wave_max(fmaxf(fmaxf(v0, v1), v2)), sink);
        const float e0 = ex2((v0 - m) * LOG2E), e1 = ex2((v1 - m) * LOG2E), e2 = (lane == 0) ? ex2((v2 - m) * LOG2E) : 0.f;
        inv[g] = 1.0f / (wave_sum(e0 + e1 + e2) + ex2((sink - m) * LOG2E));
        sc[g * BIAS_LD + lane] = e0; sc[g * BIAS_LD + 64 + lane] = e1; if (lane == 0) sc[g * BIAS_LD + 128] = e2;
    }
    asm volatile("s_waitcnt lgkmcnt(0)" ::: "memory");
    float acc[4][4];
#pragma unroll
    for (int g = 0; g < 4; ++g)
#pragma unroll
        for (int e = 0; e < 4; ++e) acc[g][e] = 0.f;
#pragma unroll 1
    for (int i0 = 0; i0 < 33; i0 += 17) {
        f32x4 vv[17];
#pragma unroll
        for (int u = 0; u < 17; ++u) { const int j = 4 * (i0 + u) + kq; vv[u] = (f32x4){0.f, 0.f, 0.f, 0.f};
            if (j < 128) vv[u] = __builtin_nontemporal_load((const GAS f32x4*)(sv + woff + (size_t)j * 512)); else if (j == 128) vv[u] = ldg4f(out + O_SV + woff + (size_t)127 * 512); }
#pragma unroll
        for (int u = 0; u < 17; ++u) { const int j = 4 * (i0 + u) + kq;
            if (copy_win && j >= 1 && j < 128) __builtin_nontemporal_store(vv[u], (GAS f32x4*)(out + O_SV + woff + (size_t)(j - 1) * 512));
            if (j <= 128) {
#pragma unroll
                for (int g = 0; g < 4; ++g) { const float p = sc[g * BIAS_LD + j];
#pragma unroll
                    for (int e = 0; e < 4; ++e) acc[g][e] += p * vv[u][e]; }
            } }
    }
#pragma unroll
    for (int g = 0; g < 4; ++g)
#pragma unroll
        for (int e = 0; e < 4; ++e) { acc[g][e] += __shfl_xor(acc[g][e], 16); acc[g][e] += __shfl_xor(acc[g][e], 32); }
    if (kq == 0) {
#pragma unroll
        for (int g = 0; g < 4; ++g) { v2u w; w.x = cvtpk(acc[g][0] * inv[g], acc[g][1] * inv[g]); w.y = cvtpk(acc[g][2] * inv[g], acc[g][3] * inv[g]);
            *(GAS v2u*)(AO + (size_t)(ROWS_P + b) * 4096 + 2048 + (kvh * 4 + g) * 64 + 4 * d4) = w; }
    }
    asm volatile("s_waitcnt lgkmcnt(0)" ::: "memory");
}
__device__ __forceinline__ void conv_row(int row, const bf16* CB, const bf16* UU, bf16* AO, const float* cw, const float* st, float* out, int lane) {
    const bool samp = row >= ROWS_P; const int tl = row & (SEQ - 1);
    v4u a0[4], ac[4], a1[4], a2[4]; f32x4 s1[4][2], s2[4][2];
#pragma unroll
    for (int j = 0; j < 4; ++j) { const int c = 8 * lane + 512 * j;
        a0[j] = ldg16(UU + (size_t)row * 2048 + c); ac[j] = ldg16(CB + (size_t)row * 2048 + c); a1[j] = (v4u){0u, 0u, 0u, 0u}; a2[j] = (v4u){0u, 0u, 0u, 0u};
        if (!samp) { if (tl >= 1) a1[j] = ldg16(UU + (size_t)(row - 1) * 2048 + c); if (tl >= 2) a2[j] = ldg16(UU + (size_t)(row - 2) * 2048 + c); }
        else { const int b = row - ROWS_P; const float* p2 = st + ((size_t)b * 2 + 0) * 2048 + c; const float* p1 = st + ((size_t)b * 2 + 1) * 2048 + c;
            s2[j][0] = ldg4f(p2); s2[j][1] = ldg4f(p2 + 4); s1[j][0] = ldg4f(p1); s1[j][1] = ldg4f(p1 + 4); } }
#pragma unroll
    for (int j = 0; j < 4; ++j) { const int c = 8 * lane + 512 * j;
        float u0[8], u1[8], u2[8], cbv[8], w0[8], w1[8], w2[8];
        unpack8(a0[j], u0); unpack8(ac[j], cbv);
        if (!samp) { unpack8(a1[j], u1); unpack8(a2[j], u2); }
        else { const int b = row - ROWS_P;
#pragma unroll
            for (int e = 0; e < 4; ++e) { u1[e] = s1[j][0][e]; u1[4 + e] = s1[j][1][e]; u2[e] = s2[j][0][e]; u2[4 + e] = s2[j][1][e]; }
            st8f(out + O_SC + ((size_t)b * 2 + 0) * 2048 + c, u1); }
        ld8f(cw + c, w0); ld8f(cw + 2048 + c, w1); ld8f(cw + 4096 + c, w2);
        float a[8];
#pragma unroll
        for (int e = 0; e < 8; ++e) a[e] = cbv[e] * ((w0[e] * u2[e] + w1[e] * u1[e]) + w2[e] * u0[e]);
        v4u w; w.x = cvtpk(a[0], a[1]); w.y = cvtpk(a[2], a[3]); w.z = cvtpk(a[4], a[5]); w.w = cvtpk(a[6], a[7]);
        *(GAS v4u*)(AO + (size_t)row * 4096 + c) = w; }
}
__device__ __forceinline__ void conv_run8(int r0, const bf16* CB, const bf16* UU, bf16* AO, const float* cw, int lane) {
    const bool head = (r0 & (SEQ - 1)) == 0;
#pragma unroll 1
    for (int j = 0; j < 4; ++j) { const int c = 8 * lane + 512 * j;
        v4u u[10], cb[8];
        u[0] = (v4u){0u, 0u, 0u, 0u}; u[1] = (v4u){0u, 0u, 0u, 0u};
        if (!head) { u[0] = ldg16(UU + (size_t)(r0 - 2) * 2048 + c); u[1] = ldg16(UU + (size_t)(r0 - 1) * 2048 + c); }
#pragma unroll
        for (int i = 0; i < 8; ++i) { u[2 + i] = ldg16(UU + (size_t)(r0 + i) * 2048 + c); cb[i] = ldg16(CB + (size_t)(r0 + i) * 2048 + c); }
        float w0[8], w1[8], w2[8], p2[8], p1[8];
        ld8f(cw + c, w0); ld8f(cw + 2048 + c, w1); ld8f(cw + 4096 + c, w2);
        unpack8(u[0], p2); unpack8(u[1], p1);
#pragma unroll
        for (int i = 0; i < 8; ++i) { float u0[8], cbv[8], a[8];
            unpack8(u[2 + i], u0); unpack8(cb[i], cbv);
#pragma unroll
            for (int e = 0; e < 8; ++e) a[e] = cbv[e] * ((w0[e] * p2[e] + w1[e] * p1[e]) + w2[e] * u0[e]);
            v4u w; w.x = cvtpk(a[0], a[1]); w.y = cvtpk(a[2], a[3]); w.z = cvtpk(a[4], a[5]); w.w = cvtpk(a[6], a[7]);
            *(GAS v4u*)(AO + (size_t)(r0 + i) * 4096 + c) = w;
#pragma unroll
            for (int e = 0; e < 8; ++e) { p2[e] = p1[e]; p1[e] = u0[e]; } }
    }
}
__device__ __forceinline__ float silu_mul(float gc, float u) { return gc * __builtin_amdgcn_rcpf(1.0f + ex2(-gc * LOG2E)) * u; }
__device__ __forceinline__ void ffn_act_block(int task, const bf16* G, const bf16* U, bf16* F, const float* cw, const float* cbias, const float* st, float* out, int lane) {
    const int ch = task % 22, rb = task / 22, c = ch * 512 + lane * 8;
    if (c >= DFF) return;
    float w0[8], w1[8], w2[8], bb[8];
    ld8f(cw + c, w0); ld8f(cw + DFF + c, w1); ld8f(cw + 2 * DFF + c, w2); ld8f(cbias + c, bb);
    const int row0 = rb * 32;
    if (rb < ROWS_P / 32) {
        float g1[8], g2[8];
        if ((row0 & (SEQ - 1)) != 0) { unpack8(ldg16(G + (size_t)(row0 - 1) * DFF + c), g1); unpack8(ldg16(G + (size_t)(row0 - 2) * DFF + c), g2); }
        else {
#pragma unroll
            for (int e = 0; e < 8; ++e) { g1[e] = 0.f; g2[e] = 0.f; } }
        for (int r0 = 0; r0 < 32; r0 += 8) {
            v4u gw_[8], uw_[8];
#pragma unroll
            for (int r = 0; r < 8; ++r) { gw_[r] = ldg16(G + (size_t)(row0 + r0 + r) * DFF + c); uw_[r] = ldg16(U + (size_t)(row0 + r0 + r) * DFF + c); }
#pragma unroll
            for (int r = 0; r < 8; ++r) { float g0[8], uv[8], f[8]; unpack8(gw_[r], g0); unpack8(uw_[r], uv);
#pragma unroll
                for (int e = 0; e < 8; ++e) { f[e] = silu_mul(((w0[e] * g2[e] + w1[e] * g1[e]) + w2[e] * g0[e]) + bb[e], uv[e]); g2[e] = g1[e]; g1[e] = g0[e]; }
                v4u w; w.x = cvtpk(f[0], f[1]); w.y = cvtpk(f[2], f[3]); w.z = cvtpk(f[4], f[5]); w.w = cvtpk(f[6], f[7]);
                *(GAS v4u*)(F + (size_t)(row0 + r0 + r) * DFF + c) = w; }
        }
    } else {
        for (int r0 = 0; r0 < 32; r0 += 4) {
            v4u gw_[4], uw_[4]; float s0[4][8], s1[4][8];
#pragma unroll
            for (int r = 0; r < 4; ++r) { const int row = row0 + r0 + r, b = row - ROWS_P; gw_[r] = ldg16(G + (size_t)row * DFF + c); uw_[r] = ldg16(U + (size_t)row * DFF + c);
                ld8f(st + ((size_t)b * 2 + 0) * DFF + c, s0[r]); ld8f(st + ((size_t)b * 2 + 1) * DFF + c, s1[r]); }
#pragma unroll
            for (int r = 0; r < 4; ++r) { const int row = row0 + r0 + r, b = row - ROWS_P; float g0[8], uv[8], f[8]; unpack8(gw_[r], g0); unpack8(uw_[r], uv);
                st8f(out + O_SF + ((size_t)b * 2 + 0) * DFF + c, s1[r]);
#pragma unroll
                for (int e = 0; e < 8; ++e) f[e] = silu_mul(((w0[e] * s0[r][e] + w1[e] * s1[r][e]) + w2[e] * g0[e]) + bb[e], uv[e]);
                v4u w; w.x = cvtpk(f[0], f[1]); w.y = cvtpk(f[2], f[3]); w.z = cvtpk(f[4], f[5]); w.w = cvtpk(f[6], f[7]);
                *(GAS v4u*)(F + (size_t)row * DFF + c) = w; }
        }
    }
}

template <int NB, int NR, bool PIPE>
__device__ __forceinline__ void skinny_ksplit(f32x4 (&acc)[NB * NR], const bf16* A  , int lda, int ags  ,
                                              const bf16* const (&brow)[NB]  , int bgs  , int gfirst, int gstride, int gcount, int rot, int fr, int fq) {
    const bf16* a0 = A + (size_t)fr * lda + 16 * fq;
    auto ld = [&](int i, bf16x8 (&a)[NR][2], bf16x8 (&b)[NB][2]) {
        int ii = i + rot; if (ii >= gcount) ii -= gcount;
        const int gi = gfirst + gstride * ii; const size_t ka_ = (size_t)gi * ags, kb_ = (size_t)gi * bgs;
#pragma unroll
        for (int j = 0; j < NB; ++j) { b[j][0] = *(const GAS bf16x8*)(brow[j] + 16 * fq + kb_); b[j][1] = *(const GAS bf16x8*)(brow[j] + 16 * fq + kb_ + 8); }
#pragma unroll
        for (int rg = 0; rg < NR; ++rg) { a[rg][0] = *(const GAS bf16x8*)(a0 + (size_t)(16 * rg) * lda + ka_); a[rg][1] = *(const GAS bf16x8*)(a0 + (size_t)(16 * rg) * lda + ka_ + 8); }
    };
    auto mm = [&](const bf16x8 (&a)[NR][2], const bf16x8 (&b)[NB][2]) {
#pragma unroll
        for (int u = 0; u < 2; ++u)
#pragma unroll
            for (int j = 0; j < NB; ++j)
#pragma unroll
                for (int rg = 0; rg < NR; ++rg) acc[j * NR + rg] = __builtin_amdgcn_mfma_f32_16x16x32_bf16(b[j][u], a[rg][u], acc[j * NR + rg], 0, 0, 0);
    };
    if constexpr (PIPE) {
        bf16x8 a0s[NR][2], b0s[NB][2], a1s[NR][2], b1s[NB][2];
        if (gcount > 0) ld(0, a0s, b0s);
#pragma unroll 1
        for (int i = 0; i < gcount; i += 2) {
            if (i + 1 < gcount) ld(i + 1, a1s, b1s);
            mm(a0s, b0s);
            if (i + 1 < gcount) { if (i + 2 < gcount) ld(i + 2, a0s, b0s); mm(a1s, b1s); }
        }
    } else {
#pragma unroll 1
        for (int i = 0; i < gcount; ++i) { bf16x8 a[NR][2], b[NB][2]; ld(i, a, b); mm(a, b); }
    }
}
__device__ __forceinline__ void skinny_reduce(const f32x4 (&acc)[8], LAS f32x4* red, int wave, int lane, f32x4& lo, f32x4& hi) {
#pragma unroll
    for (int rg = 0; rg < 8; ++rg) red[(wave * 8 + rg) * 64 + lane] = acc[rg];
    __syncthreads();
    lo = (red[(0 * 8 + wave) * 64 + lane] + red[(1 * 8 + wave) * 64 + lane]) + (red[(2 * 8 + wave) * 64 + lane] + red[(3 * 8 + wave) * 64 + lane]);
    hi = (red[(4 * 8 + wave) * 64 + lane] + red[(5 * 8 + wave) * 64 + lane]) + (red[(6 * 8 + wave) * 64 + lane] + red[(7 * 8 + wave) * 64 + lane]);
    __syncthreads();
}
__device__ __forceinline__ f32x4 unpack4(const v2u w) { return (f32x4){blo(w.x), bhi(w.x), blo(w.y), bhi(w.y)}; }
__device__ __forceinline__ v2u pack4(const f32x4 v) { v2u w; w.x = cvtpk(v[0], v[1]); w.y = cvtpk(v[2], v[3]); return w; }

constexpr bool P1_HOLE_COPY = false;
#ifndef P6_BNT
#define P6_BNT false
#endif
constexpr int P6_SAMPLE_TILES = 64;
struct OrderXcd {
    int nN, E, G, c, x, r, Rm, nfull; bool xm;
    __device__ void init(int nN_, int E_, int G_, int c_) { nN = nN_; E = E_; G = G_; c = c_; x = c_ & 7; r = c_ >> 3; Rm = (nN_ + 7) >> 3; nfull = nN_ - 8 * (Rm - 1); xm = (G_ == 256); }
    __device__ bool next(int i, pg8::Unit& u) const {
        if (!xm) { const long Lx = (long)i * G + c; if (Lx < 32L * nN) { u.pm = (int)(Lx / nN); u.pn = (int)(Lx % nN); return true; } if (Lx - 32L * nN < E) { u.pm = 32; u.pn = (int)(Lx - 32L * nN); return true; } return false; }
        if (i >= Rm) return false;
        const int pn = 8 * i + (r >> 2);
        if (pn < nN) { u.pm = 4 * x + (r & 3); u.pn = pn; return true; }
        const int sidx = x + 8 * ((r & 3) + 4 * ((r >> 2) - nfull));
        if (sidx < E) { u.pm = 32; u.pn = sidx; return true; }
        return false; }
    __device__ __forceinline__ void a_ready(const pg8::Unit&) const {}
    __device__ __forceinline__ void done(const pg8::Unit&) const {}
};
struct OrderSame { int n; __device__ bool next(int i, pg8::Unit& u) const { if (i >= n) return false; u.pm = 0; u.pn = 0; return true; }
    __device__ __forceinline__ void a_ready(const pg8::Unit&) const {} __device__ __forceinline__ void done(const pg8::Unit&) const {} };
struct OrderSlices { int np, G, c;
    __device__ bool next(int i, pg8::Unit& u) const {
        const long id = (long)i * G + c; if (id >= 256) return false;
        const int sl = (int)id & 15, p0 = (np * sl) >> 4, p1 = (np * (sl + 1)) >> 4;
        u.pm = 32; u.pn = (int)id >> 4; u.kn = 2 * p0 + ((2 * (p1 - p0)) << 16); return true; }
    __device__ __forceinline__ void a_ready(const pg8::Unit&) const {}
    __device__ __forceinline__ void done(const pg8::Unit&) const {}
};
#ifndef PH_MASK
#define PH_MASK 0x3ff
#endif
#define PH(k) ((PH_MASK >> (k)) & 1)
#ifndef REP_MASK
#define REP_MASK 0
#endif
#define REPN(k) (((REP_MASK >> (k)) & 1) ? 2 : 1)
struct Args { const float* in[21]; float* out; unsigned char* ws; };
__global__ void __launch_bounds__(NWAVES * 64, 2) mega_fwd(Args args) {
    extern __shared__ __attribute__((aligned(16))) unsigned char lds[];
    LAS unsigned char* L = (LAS unsigned char*)lds;
    volatile LAS unsigned* MISC = (volatile LAS unsigned*)(L + MISC_OFF);
    const int tid = threadIdx.x;
#define PHASE_IDS() int tid_p_ = threadIdx.x; asm volatile("" : "+v"(tid_p_)); const int lane = tid_p_ & 63, wave = __builtin_amdgcn_readfirstlane(tid_p_ >> 6), gw = vcu * NWAVES + wave; (void)lane; (void)gw
    const int G = gridDim.x, bx = blockIdx.x;
    const int vcu = (G % 8 == 0) ? (bx % 8) * (G / 8) + bx / 8 : bx;
    const int NGW = G * NWAVES;
    unsigned char* ws = args.ws; float* out = args.out;
#define INP(k) (args.in[k])
#define WSB(off) ((bf16*)(ws + (off)))
    gu32* ctl = (gu32*)(ws + WS_CTL);
    for (int u = tid; u < (LDS_BYTES - LDSCTL_OFF) / 4; u += NWAVES * 64) ((LAS unsigned*)(L + LDSCTL_OFF))[u] = 0u;
    __syncthreads();
    XcdBarrier bar = xcd_barrier_post((unsigned*)(ctl + CW_BAR), MISC + 8);
#ifdef PROBE_PHASES
    unsigned long long pt0_ = 0, probe_acc_ = 0;
#ifdef PROBE_P2SUB
#define PTS(k) do { if (PROBE_P2SUB == (k)) pt0_ = __builtin_amdgcn_s_memrealtime(); } while (0)
#define PTE(k) do { if (PROBE_P2SUB == (k)) probe_acc_ += __builtin_amdgcn_s_memrealtime() - pt0_; } while (0)
#else
#define PTS(k)
#define PTE(k)
#endif
#define PT_BEGIN(k) do { if ((PROBE_PHASES >> (k)) & 1) pt0_ = __builtin_amdgcn_s_memrealtime(); } while (0)
#define PT_END(k) do { if ((PROBE_PHASES >> (k)) & 1) probe_acc_ += __builtin_amdgcn_s_memrealtime() - pt0_; } while (0)
#else
#define PT_BEGIN(k)
#define PT_END(k)
#define PTS(k)
#define PTE(k)
#endif
#ifdef PROBE_CLOCK
    unsigned long long probe_dc_ = 0, probe_dr_ = 1;
#endif

#define SCR() ((LAS float*)(L + RING_OFF + wave * 16384))
        constexpr int I0 = 64 * 544, I1 = 32 * 128, I3 = 64 * 128, I4 = 64 * 344, I6 = 172 * 128;
        constexpr int NITEMS = I0 + 2 * I1 + I3 + 2 * I4 + I6;
        auto decode = [&](int it) -> P0Ref {
            int r = (it < NITEMS - I0) ? it + I0 : it - (NITEMS - I0);
            if (r < I0) { const int kb = r / 544, nb = r % 544; return P0Ref{INP(7) + (size_t)(64 * kb) * INW + 32 * nb, WSB(WS_WIN) + tiled_off(win_map(32 * nb), kb, 64), INW}; } r -= I0;
            if (r < I1) { const int kb = r / 128, nb = r % 128; return P0Ref{INP(9) + (size_t)(64 * kb) * DM + 32 * nb, WSB(WS_WAB) + tiled_off(32 * nb, kb, 64), DM}; } r -= I1;
            if (r < I1) { const int kb = r / 128, nb = r % 128; return P0Ref{INP(10) + (size_t)(64 * kb) * DM + 32 * nb, WSB(WS_WAB) + tiled_off(32 * nb, 32 + kb, 64), DM}; } r -= I1;
            if (r < I3) { const int kb = r / 128, nb = r % 128; return P0Ref{INP(12) + (size_t)(64 * kb) * DM + 32 * nb, WSB(WS_WO) + tiled_off(32 * nb, kb, 64), DM}; } r -= I3;
            if (r < I4) { const int kb = r / 344, nb = r % 344; return P0Ref{INP(14) + (size_t)(64 * kb) * DFF + 32 * nb, WSB(WS_WGU) + tiled_off(((32 * nb) >> 7) * 256 + ((32 * nb) & 127), kb, 64), DFF}; } r -= I4;
            if (r < I4) { const int kb = r / 344, nb = r % 344; return P0Ref{INP(15) + (size_t)(64 * kb) * DFF + 32 * nb, WSB(WS_WGU) + tiled_off(((32 * nb) >> 7) * 256 + 128 + ((32 * nb) & 127), kb, 64), DFF}; } r -= I4;
            const int kb = r / 128, nb = r % 128; return P0Ref{INP(18) + (size_t)(64 * kb) * DM + 32 * nb, WSB(WS_WD) + tiled_off(32 * nb, kb, 172), DM};
        };
    const int p1_units = (MPAD / 256) * (INW / 256), p1_hole = (p1_units % G) ? G - (p1_units % G) : 0;
    const int DEFER = 0;
    constexpr int R_AB0 = 0, R_AB1 = 2 * I1, R_O1 = R_AB1 + I3, R_GU1 = R_O1 + 2 * I4, R_D1 = R_GU1 + I6, R_IN1 = NITEMS;
    static_assert(R_D1 == NITEMS - I0, "item ranges");
#define CONVERT_RANGE(FIRST, LAST, SCRP) do { const int f_ = (FIRST), l_ = (LAST); if (f_ + gw < l_) { P0Ref cur = decode(f_ + gw); f32x4 va[8], vb[8]; p0_load(cur, va, lane); \
        for (int it = f_ + gw; it < l_; it += NGW) { const int nx = it + NGW; P0Ref nr = cur; if (nx < l_) { nr = decode(nx); p0_load(nr, vb, lane); } p0_store(cur, va, (SCRP), lane); \
            _Pragma("unroll") for (int i = 0; i < 8; ++i) va[i] = vb[i]; cur = nr; } } } while (0)
    PT_BEGIN(0);
    for (int rep_ = 0; rep_ < REPN(0); ++rep_) {
    if (PH(0)) {
        PHASE_IDS();
        f32x4 g1v[16]; load_gain(INP(6), g1v, lane);
        {
            f32x4 va[16], vb[16];
            if (gw < ROWS_R) load_row(gw < ROWS_P ? INP(0) + (size_t)gw * DM : INP(1) + (size_t)(gw - ROWS_P) * DM, va, lane);
#pragma unroll 1
            for (int m = gw; m < MPAD; m += NGW) {
                const int mn = m + NGW;
                if (mn < ROWS_R) load_row(mn < ROWS_P ? INP(0) + (size_t)mn * DM : INP(1) + (size_t)(mn - ROWS_P) * DM, vb, lane);
                if (m < ROWS_R) rms_row_pre_tiled(va, g1v, WSB(WS_XN) + tiled_off(m, 0, 64), lane);
                else {
#pragma unroll
                    for (int j = 0; j < 8; ++j) { const int c = 8 * (lane + 64 * j); *(GAS v4u*)(WSB(WS_XN) + tiled_off(m, c >> 6, 64) + (c & 63)) = (v4u){0u, 0u, 0u, 0u}; } }
#pragma unroll
                for (int j = 0; j < 16; ++j) va[j] = vb[j];
            }
        }
        CONVERT_RANGE(R_D1, R_IN1, SCR());
    }
    xcd_barrier(bar);
    }
    PT_END(0);

    PT_BEGIN(1);
    for (int rep_ = 0; rep_ < REPN(1); ++rep_) {
    if (PH(1)) {
        PHASE_IDS();
        pg8::Gemm g{WSB(WS_XN), WSB(WS_WIN), MPAD, INW, DM}; OrderXcd S; S.init(INW / 256, INW / 256, G, bx);
        pg8::EpiProj E{WSB(WS_CB), WSB(WS_UU), WSB(WS_Q), WSB(WS_K), WSB(WS_VT), WSB(WS_RAT), WSB(WS_SGB), out, (LAS bf16*)(L + XCH_OFF)};
#if defined(PROBE_CLOCK) && PROBE_CLOCK == 1
        const unsigned long long pc0_ = __builtin_amdgcn_s_memtime(), pr0_ = __builtin_amdgcn_s_memrealtime();
#endif
        pg8::gemm_phase<pg8::EpiProj, OrderXcd, false, true, true, true, false, false, true>(L + RING_OFF, g, S, E);
#if defined(PROBE_CLOCK) && PROBE_CLOCK == 1
        probe_dc_ = __builtin_amdgcn_s_memtime() - pc0_; probe_dr_ = __builtin_amdgcn_s_memrealtime() - pr0_;
#endif
        if (P1_HOLE_COPY && G == 256 && ((bx >> 3) >> 2) >= 4) {
            const int sidx = (bx & 7) + 8 * (((bx >> 3) & 3) + 4 * (((bx >> 3) >> 2) - 4));
            if (sidx >= INW / 256) { const int h = sidx - INW / 256, nh = 128 - INW / 256;
                for (int blk = h; blk < 256; blk += nh) { const int tensor = blk >> 7, b = blk & 127;
                    const GAS f32x4* src = (const GAS f32x4*)((tensor ? INP(3) : INP(2)) + ((size_t)b * 128 + 1) * 512); GAS f32x4* dst = (GAS f32x4*)(out + (tensor ? O_SV : O_SK) + (size_t)b * 128 * 512);
#pragma unroll 1
                    for (int i0 = threadIdx.x; i0 < 127 * 128; i0 += 8 * 512) {
                        const int ia = i0, ib = min(i0 + 512, 127 * 128 - 1), ic = min(i0 + 1024, 127 * 128 - 1), id = min(i0 + 1536, 127 * 128 - 1), ie = min(i0 + 2048, 127 * 128 - 1), ig = min(i0 + 2560, 127 * 128 - 1), ih = min(i0 + 3072, 127 * 128 - 1), ii = min(i0 + 3584, 127 * 128 - 1);
                        const f32x4 va = src[ia], vb = src[ib], vc = src[ic], vd = src[id], ve = src[ie], vg = src[ig], vh = src[ih], vi = src[ii];
                        dst[ia] = va; dst[ib] = vb; dst[ic] = vc; dst[id] = vd; dst[ie] = ve; dst[ig] = vg; dst[ih] = vh; dst[ii] = vi; } } } }
        if (DEFER && bx >= G - p1_hole) {
            const int hw = (bx - (G - p1_hole)) * NWAVES + wave, nhw = p1_hole * NWAVES, first = NITEMS - DEFER;
            if (first + hw < NITEMS) {
                P0Ref cur = decode(first + hw); f32x4 va[8], vb[8];
                p0_load(cur, va, lane);
                for (int it = first + hw; it < NITEMS; it += nhw) {
                    const int nx = it + nhw; P0Ref nr = cur;
                    if (nx < NITEMS) { nr = decode(nx); p0_load(nr, vb, lane); }
                    p0_store(cur, va, SCR(), lane);
#pragma unroll
                    for (int i = 0; i < 8; ++i) va[i] = vb[i];
                    cur = nr;
                }
            }
        }
#ifdef PROBE_P1_NULL
#ifdef PROBE_SAME
        { pg8::EpiNull EN{(float*)(ws + WS_CTL + 512)}; OrderSame SS{9}; pg8::gemm_phase<pg8::EpiNull, OrderSame, true, true, true, true>(L + RING_OFF, g, SS, EN); }
#else
        { pg8::EpiNull EN{(float*)(ws + WS_CTL + 512)}; pg8::gemm_phase<pg8::EpiNull, OrderXcd, true, true, true, true>(L + RING_OFF, g, S, EN); }
#endif
#endif
    }
    xcd_barrier(bar);
    }
    PT_END(1);

    PT_BEGIN(2);
    for (int rep_ = 0; rep_ < REPN(2); ++rep_) {
    if (PH(2)) {
        PHASE_IDS();
        LAS float* biasT = (LAS float*)(L + RING_OFF);
        PTS(1);
        for (int i = tid; i < 32 * 129; i += NWAVES * 64) { const int h = i / 129, d = i - h * 129;
            int bk = d;
            if (d >= 16) { bk = 16 + (int)(log2f((float)d * 0.0625f) * (16.0f / 3.0f)); bk = bk > 31 ? 31 : bk; }
            biasT[h * BIAS_LD + d] = *(const GAS float*)(INP(19) + bk * 32 + h); }
        __syncthreads();
        LAS float* sc = (LAS float*)(L + SCR_OFF + wave * SCR_WAVE);
        if (wave >= 4) CONVERT_RANGE(R_AB0, R_AB1, (LAS float*)(L + 61440 + wave * 8448));
        for (int t = gw; t < 4 * 8 * 64 * 4; t += NGW) attn_prompt_task(t, WSB(WS_Q), WSB(WS_K), WSB(WS_VT), WSB(WS_AO), INP(11), biasT, lane);
        PTE(1); PTS(2);
        if (P1_HOLE_COPY && G == 256) { for (int t = NGW - 1 - gw; t < 128 * 8; t += NGW) attn_sample_task<false>(t, WSB(WS_Q), INP(2), INP(3), out, WSB(WS_AO), INP(11), biasT, sc, lane); }
        else { for (int t = NGW - 1 - gw; t < 128 * 8; t += NGW) attn_sample_task<true>(t, WSB(WS_Q), INP(2), INP(3), out, WSB(WS_AO), INP(11), biasT, sc, lane); }
        { const int cwn = NGW > 128 * 8 ? NGW - 128 * 8 : NGW;
          if (gw < cwn) {
            for (int run = gw; run < ROWS_P / 8; run += cwn) conv_run8(8 * run, WSB(WS_CB), WSB(WS_UU), WSB(WS_AO), INP(8), lane);
            for (int m = ROWS_P + gw; m < ROWS_R; m += cwn) conv_row(m, WSB(WS_CB), WSB(WS_UU), WSB(WS_AO), INP(8), INP(4), out, lane); } }
        PTE(2); PTS(3);
        if (wave < 4) CONVERT_RANGE(R_AB0, R_AB1, (LAS float*)(L + 61440 + wave * 8448));
        PTE(3);
#ifdef PROBE_P2A
        for (int t = gw; t < 4 * 8 * 64 * 4; t += NGW) attn_prompt_task(t, WSB(WS_Q), WSB(WS_K), WSB(WS_VT), WSB(WS_AO), INP(11), biasT, lane);
#endif
#ifdef PROBE_P2S
        for (int t = NGW - 1 - gw; t < 128 * 8; t += NGW) attn_sample_task<true>(t, WSB(WS_Q), INP(2), INP(3), out, WSB(WS_AO), INP(11), biasT, sc, lane);
#endif
    }
    xcd_barrier(bar);
    }
    PT_END(2);

    PT_BEGIN(3);
    for (int rep_ = 0; rep_ < REPN(3); ++rep_) {
    if (PH(3)) {
        PHASE_IDS();
        pg8::Gemm g{WSB(WS_AO), WSB(WS_WAB), ROWS_P, DM, DM}; OrderXcd S; S.init(DM / 256, 0, G, bx);
        pg8::EpiMerged E{WSB(WS_RAT), WSB(WS_SGB), WSB(WS_MG)};
        pg8::gemm_phase<pg8::EpiMerged, OrderXcd, true, true, false, true>(L + RING_OFF, g, S, E);
        { const int fr = lane & 15, fq = lane >> 4;
#ifdef PROBE_SK2
          for (int rp_ = 0; rp_ < 2; ++rp_)
#endif
          for (int t = vcu; t < 2 * (DM / 32); t += G) { const int cp = t >> 1, rh = t & 1;
            f32x4 acc[8];
#pragma unroll
            for (int q = 0; q < 8; ++q) acc[q] = (f32x4){0.f, 0.f, 0.f, 0.f};
            const bf16* const bp[2] = {WSB(WS_WAB) + tiled_off(32 * cp + fr, 0, 64), WSB(WS_WAB) + tiled_off(32 * cp + 16 + fr, 0, 64)};
            const size_t o = (size_t)(ROWS_P + 64 * rh + 16 * (wave & 3) + fr) * DM + 32 * cp + 16 * (wave >> 2) + 4 * fq;
            const v2u rat_ = *(const GAS v2u*)(WSB(WS_RAT) + o), sgb_ = *(const GAS v2u*)(WSB(WS_SGB) + o);
            skinny_ksplit<2, 4, true>(acc, WSB(WS_AO) + (size_t)(ROWS_P + 64 * rh) * DM, DM, 64, bp, 16384, (wave >> 2) * 32 + (wave & 3), 4, 8, vcu & 7, fr, fq);
            f32x4 lo, hi; skinny_reduce(acc, (LAS f32x4*)(L + RING_OFF), wave, lane, lo, hi);
            *(GAS v2u*)(WSB(WS_MG) + o) = pack4((lo * unpack4(rat_) + hi) * unpack4(sgb_));
          } }
        CONVERT_RANGE(R_AB1, R_O1, SCR());
    }
    xcd_barrier(bar);
    }
    PT_END(3);

    PT_BEGIN(4);
    for (int rep_ = 0; rep_ < REPN(4); ++rep_) {
    if (PH(4)) {
        PHASE_IDS();
        pg8::Gemm g{WSB(WS_MG), WSB(WS_WO), ROWS_P, DM, DM}; OrderXcd S; S.init(DM / 256, 0, G, bx);
        pg8::EpiResidB<false> E{INP(0), WSB(WS_X1), WSB(WS_XN), INP(13), (float*)(ws + WS_PART1)};
        pg8::gemm_phase<pg8::EpiResidB<false>, OrderXcd, true, true, false, true>(L + RING_OFF, g, S, E);
        { OrderSlices S2{DM / 128, G, bx}; pg8::EpiSlab E2{(float*)(ws + WS_SLAB4), DM / 128};
          pg8::gemm_phase<pg8::EpiSlab, OrderSlices, false, true, false, true, false, true>(L + RING_OFF, g, S2, E2); }
    }
    xcd_barrier(bar);
    }
    PT_END(4);

    PT_BEGIN(5);
    for (int rep_ = 0; rep_ < REPN(5); ++rep_) {
    if (PH(5)) { PHASE_IDS();
        for (int m0 = gw; m0 < ROWS_P; m0 += 4 * NGW) { f32x4 p[4];
#pragma unroll
            for (int i = 0; i < 4; ++i) { const int m = m0 + i * NGW; p[i] = (f32x4){0.f, 0.f, 0.f, 0.f}; if (m < ROWS_P) p[i] = *(const GAS f32x4*)((const float*)(ws + WS_PART1) + (size_t)m * 256 + 4 * lane); }
#pragma unroll
            for (int i = 0; i < 4; ++i) { const int m = m0 + i * NGW; const float ss = wave_sum((p[i].x + p[i].y) + (p[i].z + p[i].w)); if (m < ROWS_P && lane == 0) *(GAS float*)((float*)(ws + WS_RSTAT) + m) = 1.0f / sqrtf(ss * (1.0f / DM) + EPS); } }
        for (int r = bx; r < ROWS_R - ROWS_P; r += G) {
            const int c = 512 * wave + 8 * lane;
            const float* sl = (const float*)(ws + WS_SLAB4) + (size_t)r * DM + c;
            f32x4 a0 = ldg4f(INP(1) + (size_t)r * DM + c), a1 = ldg4f(INP(1) + (size_t)r * DM + c + 4);
#pragma unroll
            for (int h = 0; h < 2; ++h) { f32x4 t0[8], t1[8];
#pragma unroll
                for (int q = 0; q < 8; ++q) { t0[q] = ldg4f(sl + (size_t)(8 * h + q) * 128 * DM); t1[q] = ldg4f(sl + (size_t)(8 * h + q) * 128 * DM + 4); }
#pragma unroll
                for (int q = 0; q < 8; ++q) { a0 += t0[q]; a1 += t1[q]; } }
            float* xo = (float*)(ws + WS_X1) + (size_t)(ROWS_P + r) * DM + c;
            *(GAS f32x4*)xo = a0; *(GAS f32x4*)(xo + 4) = a1;
            const float ssw = wave_sum(((a0.x * a0.x + a0.y * a0.y) + (a0.z * a0.z + a0.w * a0.w)) + ((a1.x * a1.x + a1.y * a1.y) + (a1.z * a1.z + a1.w * a1.w)));
            LAS float* red = (LAS float*)(L + RING_OFF);
            if (lane == 0) red[wave] = ssw;
            __syncthreads();
            const float tot = ((red[0] + red[1]) + (red[2] + red[3])) + ((red[4] + red[5]) + (red[6] + red[7]));
            __syncthreads();
            if (wave == 0 && lane == 0) *(GAS float*)((float*)(ws + WS_RSTAT) + ROWS_P + r) = 1.0f / sqrtf(tot * (1.0f / DM) + EPS);
            const f32x4 y0 = a0 * ldg4f(INP(13) + c), y1 = a1 * ldg4f(INP(13) + c + 4);
            v4u w; w.x = cvtpk(y0.x, y0.y); w.y = cvtpk(y0.z, y0.w); w.z = cvtpk(y1.x, y1.y); w.w = cvtpk(y1.z, y1.w);
            *(GAS v4u*)(WSB(WS_XN) + tiled_off(ROWS_P + r, c >> 6, 64) + (c & 63)) = w;
        }
        CONVERT_RANGE(R_O1, R_GU1, SCR());
    }
    xcd_barrier(bar);
    }
    PT_END(5);

    PT_BEGIN(6);
    for (int rep_ = 0; rep_ < REPN(6); ++rep_) {
    if (PH(6)) {
        PHASE_IDS();
        pg8::Gemm g{WSB(WS_XN), WSB(WS_WGU), MPAD, 2 * DFF, DM}; OrderXcd S; S.init(2 * DFF / 256, P6_SAMPLE_TILES, G, bx);
        pg8::EpiGateUpF E{WSB(WS_F), (float*)(ws + WS_SIDEG), (float*)(ws + WS_SIDEU), INP(16), INP(17), INP(5), out, (LAS float*)(L + XCH_OFF), (const float*)(ws + WS_RSTAT)};
#if defined(PROBE_CLOCK) && PROBE_CLOCK == 6
        const unsigned long long pc6_ = __builtin_amdgcn_s_memtime(), pr6_ = __builtin_amdgcn_s_memrealtime();
#endif
        pg8::gemm_phase<pg8::EpiGateUpF, OrderXcd, true, true, true, true, P6_BNT>(L + RING_OFF, g, S, E);
#if defined(PROBE_CLOCK) && PROBE_CLOCK == 6
        probe_dc_ = __builtin_amdgcn_s_memtime() - pc6_; probe_dr_ = __builtin_amdgcn_s_memrealtime() - pr6_;
#endif
        { const int fr = lane & 15, fq = lane >> 4; LAS f32x4* red = (LAS f32x4*)(L + RING_OFF);
          for (int t = vcu; t < 2 * ((DFF - P6_SAMPLE_TILES * 128) / 16); t += G) { const int j = t >> 1, rh = t & 1;
            const int ch = P6_SAMPLE_TILES * 128 + 16 * j, nrow = (ch >> 7) * 256 + (ch & 127) + fr;
            f32x4 acc[8];
#pragma unroll
            for (int q = 0; q < 8; ++q) acc[q] = (f32x4){0.f, 0.f, 0.f, 0.f};
            const bf16* const bp[2] = {WSB(WS_WGU) + tiled_off(nrow, 0, 64), WSB(WS_WGU) + tiled_off(nrow + 128, 0, 64)};
            skinny_ksplit<2, 4, true>(acc, WSB(WS_XN) + tiled_off(ROWS_P + 64 * rh, 0, 64), 64, 16384, bp, 16384, wave, 8, 8, vcu & 7, fr, fq);
#pragma unroll
            for (int q = 0; q < 8; ++q) red[(wave * 8 + q) * 64 + lane] = acc[q];
            __syncthreads();
            if (wave < 4) {
                f32x4 gv = (f32x4){0.f, 0.f, 0.f, 0.f}, uv = (f32x4){0.f, 0.f, 0.f, 0.f};
#pragma unroll
                for (int ww = 0; ww < 8; ++ww) { gv += red[(ww * 8 + wave) * 64 + lane]; uv += red[(ww * 8 + 4 + wave) * 64 + lane]; }
                const size_t b = 64 * rh + 16 * wave + fr; const int c = ch + 4 * fq;
                { const float rs = *(const GAS float*)((const float*)(ws + WS_RSTAT) + ROWS_P + b); gv *= rs; uv *= rs; }
                const f32x4 s0 = ldg4f(INP(5) + (b * 2 + 0) * DFF + c), s1 = ldg4f(INP(5) + (b * 2 + 1) * DFF + c);
                const f32x4 gc = ((ldg4f(INP(16) + c) * s0 + ldg4f(INP(16) + DFF + c) * s1) + ldg4f(INP(16) + 2 * DFF + c) * gv) + ldg4f(INP(17) + c);
                *(GAS f32x4*)(out + O_SF + (b * 2 + 0) * DFF + c) = s1; *(GAS f32x4*)(out + O_SF + (b * 2 + 1) * DFF + c) = gv;
                *(GAS v2u*)(WSB(WS_F) + (ROWS_P + b) * DFF + c) = pack4((f32x4){silu_mul(gc[0], uv[0]), silu_mul(gc[1], uv[1]), silu_mul(gc[2], uv[2]), silu_mul(gc[3], uv[3])});
            }
            __syncthreads();
          } }
    }
    xcd_barrier(bar);
    }
    PT_END(6);

    PT_BEGIN(7);
    for (int rep_ = 0; rep_ < REPN(7); ++rep_) {
    if (PH(7)) { PHASE_IDS(); for (int idx = gw * 64 + lane; idx < 32 * 2 * (DFF / 8); idx += NGW * 64) {
        const int c = 8 * (idx % (DFF / 8)), rr = (idx / (DFF / 8)) & 1, pm = idx / (2 * (DFF / 8));
        if ((pm & 7) != 0) {
            const float* sg = (const float*)(ws + WS_SIDEG); const float* su = (const float*)(ws + WS_SIDEU);
            float g0[8], gm1[8], gm2[8], uv[8], w0[8], w1[8], w2[8], bb[8], f[8];
            ld8f(sg + ((size_t)pm * 4 + rr) * DFF + c, g0); ld8f(su + ((size_t)pm * 2 + rr) * DFF + c, uv);
            ld8f(rr == 0 ? sg + ((size_t)(pm - 1) * 4 + 3) * DFF + c : sg + ((size_t)pm * 4 + 0) * DFF + c, gm1);
            ld8f(rr == 0 ? sg + ((size_t)(pm - 1) * 4 + 2) * DFF + c : sg + ((size_t)(pm - 1) * 4 + 3) * DFF + c, gm2);
            ld8f(INP(16) + c, w0); ld8f(INP(16) + DFF + c, w1); ld8f(INP(16) + 2 * DFF + c, w2); ld8f(INP(17) + c, bb);
#pragma unroll
            for (int e = 0; e < 8; ++e) f[e] = silu_mul(((w0[e] * gm2[e] + w1[e] * gm1[e]) + w2[e] * g0[e]) + bb[e], uv[e]);
            v4u w; w.x = cvtpk(f[0], f[1]); w.y = cvtpk(f[2], f[3]); w.z = cvtpk(f[4], f[5]); w.w = cvtpk(f[6], f[7]);
            *(GAS v4u*)(WSB(WS_F) + ((size_t)pm * 256 + rr) * DFF + c) = w;
        }
    }     CONVERT_RANGE(R_GU1, R_D1, SCR());
    }
    xcd_barrier(bar);
    }
    PT_END(7);

    PT_BEGIN(8);
    if (PH(8)) {
        PHASE_IDS();
        pg8::Gemm g{WSB(WS_F), WSB(WS_WD), ROWS_P, DM, DFF}; OrderXcd S; S.init(DM / 256, 0, G, bx);
        pg8::EpiResidB<true> E{WSB(WS_X1), WSB(WS_X1) + (size_t)ROWS_P * DM, nullptr, nullptr, (float*)(ws + WS_PART2)};
        pg8::gemm_phase<pg8::EpiResidB<true>, OrderXcd, true, true, false, true>(L + RING_OFF, g, S, E);
        { OrderSlices S2{DFF / 128, G, bx}; pg8::EpiSlab E2{(float*)(ws + WS_SLAB), DFF / 128};
          pg8::gemm_phase<pg8::EpiSlab, OrderSlices, false, true, false, true, false, true>(L + RING_OFF, g, S2, E2); }
    }
    xcd_barrier(bar);
    PT_END(8);

    PT_BEGIN(9);
    if (PH(9)) { PHASE_IDS();
        const GAS f32x4* gr = (const GAS f32x4*)INP(20); f32x4 g[16];
#pragma unroll
        for (int j = 0; j < 8; ++j) { const int q = 2 * (lane + 64 * j); g[2 * j] = gr[q]; g[2 * j + 1] = gr[q + 1]; }
        v4u w[8]; f32x4 p4 = (f32x4){0.f, 0.f, 0.f, 0.f};
        if (gw < ROWS_P) { const GAS v4u* xr = (const GAS v4u*)(WSB(WS_X1) + (size_t)(ROWS_P + gw) * DM) + lane;
#pragma unroll
            for (int j = 0; j < 8; ++j) w[j] = xr[64 * j];
            p4 = *(const GAS f32x4*)((const float*)(ws + WS_PART2) + (size_t)gw * 256 + 4 * lane); }
#pragma unroll 1
        for (int m = gw; m < ROWS_P; m += NGW) {
            const int mn = m + NGW; v4u wn[8]; f32x4 pn = (f32x4){0.f, 0.f, 0.f, 0.f};
#pragma unroll
            for (int j = 0; j < 8; ++j) wn[j] = (v4u){0u, 0u, 0u, 0u};
            if (mn < ROWS_P) { const GAS v4u* xr = (const GAS v4u*)(WSB(WS_X1) + (size_t)(ROWS_P + mn) * DM) + lane;
#pragma unroll
                for (int j = 0; j < 8; ++j) wn[j] = xr[64 * j];
                pn = *(const GAS f32x4*)((const float*)(ws + WS_PART2) + (size_t)mn * 256 + 4 * lane); }
            const float r = 1.0f / sqrtf(wave_sum((p4.x + p4.y) + (p4.z + p4.w)) * (1.0f / DM) + EPS);
            GAS f32x4* orow = (GAS f32x4*)(out + O_YP + (size_t)m * DM);
#pragma unroll
            for (int j = 0; j < 8; ++j) { float x[8]; unpack8(w[j], x); const int q = 2 * (lane + 64 * j); const f32x4 g0 = g[2 * j], g1 = g[2 * j + 1];
                orow[q] = (f32x4){(x[0] * r) * g0.x, (x[1] * r) * g0.y, (x[2] * r) * g0.z, (x[3] * r) * g0.w}; orow[q + 1] = (f32x4){(x[4] * r) * g1.x, (x[5] * r) * g1.y, (x[6] * r) * g1.z, (x[7] * r) * g1.w}; }
#pragma unroll
            for (int j = 0; j < 8; ++j) w[j] = wn[j];
            p4 = pn;
        }
        for (int r = bx; r < ROWS_R - ROWS_P; r += G) {
            const int c = 512 * wave + 8 * lane;
            const float* xr = (const float*)(ws + WS_X1) + (size_t)(ROWS_P + r) * DM + c; const float* sl = (const float*)(ws + WS_SLAB) + (size_t)r * DM + c;
            f32x4 a0 = ldg4f(xr), a1 = ldg4f(xr + 4);
#pragma unroll
            for (int h = 0; h < 2; ++h) { f32x4 t0[8], t1[8];
#pragma unroll
                for (int q = 0; q < 8; ++q) { t0[q] = ldg4f(sl + (size_t)(8 * h + q) * 128 * DM); t1[q] = ldg4f(sl + (size_t)(8 * h + q) * 128 * DM + 4); }
#pragma unroll
                for (int q = 0; q < 8; ++q) { a0 += t0[q]; a1 += t1[q]; } }
            const float ssw = wave_sum(((a0.x * a0.x + a0.y * a0.y) + (a0.z * a0.z + a0.w * a0.w)) + ((a1.x * a1.x + a1.y * a1.y) + (a1.z * a1.z + a1.w * a1.w)));
            LAS float* red = (LAS float*)(L + RING_OFF);
            if (lane == 0) red[wave] = ssw;
            __syncthreads();
            const float tot = ((red[0] + red[1]) + (red[2] + red[3])) + ((red[4] + red[5]) + (red[6] + red[7]));
            __syncthreads();
            const float rr = 1.0f / sqrtf(tot * (1.0f / DM) + EPS);
            const f32x4 g0 = ldg4f(INP(20) + c), g1 = ldg4f(INP(20) + c + 4);
            float* yo = out + O_YS + (size_t)r * DM + c;
            *(GAS f32x4*)yo = (a0 * rr) * g0; *(GAS f32x4*)(yo + 4) = (a1 * rr) * g1;
        }
    }
    PT_END(9);
#ifdef PROBE_PHASES
#ifndef PROBE_BLOCK
#define PROBE_BLOCK 0
#endif
    if (blockIdx.x == PROBE_BLOCK) { const unsigned long long t0_ = __builtin_amdgcn_s_memrealtime(); while (__builtin_amdgcn_s_memrealtime() - t0_ < probe_acc_) __builtin_amdgcn_s_sleep(8); }
#endif
#ifdef PROBE_CLOCK
    if (blockIdx.x == 0) {
#ifdef PROBE_CYCLES
        const unsigned long long want = probe_dc_ * 20ull / 576ull, t0_ = __builtin_amdgcn_s_memrealtime();
#else
        const unsigned long long want = probe_dc_ * 5000ull / probe_dr_, t0_ = __builtin_amdgcn_s_memrealtime();
#endif
        while (__builtin_amdgcn_s_memrealtime() - t0_ < want) __builtin_amdgcn_s_sleep(8);
    }
#endif
}

extern "C" void kernel_launch(void* const* d_in, const int* in_sizes, int n_in, void* d_out, int out_size, void* d_ws, size_t ws_size, hipStream_t stream) {
    static int grid = 0;
    if (grid == 0) {
        if (n_in != 21 || in_sizes[0] != ROWS_P * DM || (size_t)out_size != O_END || ws_size < WS_END) {
            fprintf(stderr, "kernel_launch: built for 21 inputs, x_prompt of %d floats, %zu outputs, >= %zu bytes of workspace; got n_in %d, in0 %d, out %d, ws %zu; nothing launched\n", ROWS_P * DM, (size_t)O_END, (size_t)WS_END, n_in, n_in > 0 ? in_sizes[0] : -1, out_size, ws_size);
            grid = -1; return; }
        int dev = 0, cus = 0, per_cu = 0;
        if (hipGetDevice(&dev) != hipSuccess || hipDeviceGetAttribute(&cus, hipDeviceAttributeMultiprocessorCount, dev) != hipSuccess) { fprintf(stderr, "kernel_launch: hipGetDevice / hipDeviceGetAttribute failed; nothing launched\n"); grid = -1; return; }
        if (hipFuncSetAttribute((const void*)mega_fwd, hipFuncAttributeMaxDynamicSharedMemorySize, LDS_BYTES) != hipSuccess) { fprintf(stderr, "kernel_launch: hipFuncSetAttribute failed; nothing launched\n"); grid = -1; return; }
        if (hipOccupancyMaxActiveBlocksPerMultiprocessor(&per_cu, (const void*)mega_fwd, NWAVES * 64, LDS_BYTES) != hipSuccess || per_cu < 1)
            fprintf(stderr, "kernel_launch: note: the occupancy query reports %d workgroups per CU\n", per_cu);
        (void)hipGetLastError();
        grid = cus;
    }
    if (grid < 0) return;
    if (hipMemsetAsync((char*)d_ws + WS_CTL, 0, CTL_ZERO_BYTES, stream) != hipSuccess) { fprintf(stderr, "kernel_launch: hipMemsetAsync failed; nothing launched\n"); return; }
    Args a{};
    for (int i = 0; i < 21; ++i) a.in[i] = (const float*)d_in[i];
    a.out = (float*)d_out; a.ws = (unsigned char*)d_ws;
    hipLaunchKernelGGL(mega_fwd, dim3(grid), dim3(NWAVES * 64), LDS_BYTES, stream, a);
    const hipError_t le = hipPeekAtLastError();
    if (le != hipSuccess) fprintf(stderr, "kernel_launch: launch failed: %s (grid %d x %d threads, %d B LDS)\n", hipGetErrorName(le), grid, NWAVES * 64, LDS_BYTES);
}
```
